# Optimizing an MI355X kernel written in HIP

```python
import math
import jax
import jax.numpy as jnp
from jax import lax
import numpy as np

D_MODEL = 1024
BATCH = 8
SEQ = 4096
DEPTH = 4

CTX_LEN = 256
GRID_W = 64
NORM_EPS = 1e-6

DA_QK_DIM = 64
DA_V_DIM = 2 * DA_QK_DIM
DA_WIDTH = D_MODEL // 2
DA_HEADS = DA_WIDTH // DA_V_DIM
DA_QK_COLS = DA_HEADS * 2 * DA_QK_DIM
DA_COLS = 2 * DA_QK_COLS + DA_WIDTH
DA_QBLOCK = 128
ROPE_THETA = 10000.0

RW_HEAD_DIM = 64
RW_WIDTH = D_MODEL // 4
RW_HEADS = RW_WIDTH // RW_HEAD_DIM
RW_DECAY_RANK = 32
RW_ICL_RANK = 32
RW_GATE_RANK = 64
RW_DECAY_SCALE = 0.606531
RW_GN_EPS = 64e-5
RW_COLS = 3 * RW_WIDTH + 2 * RW_DECAY_RANK + 2 * RW_ICL_RANK + RW_GATE_RANK

ML_HEAD_DIM = 64
ML_WIDTH = D_MODEL - DA_WIDTH - RW_WIDTH
ML_HEADS = ML_WIDTH // ML_HEAD_DIM
ML_CHUNK = 128
ML_COLS = 4 * ML_WIDTH + 4 * ML_HEADS

IN_COLS = DA_COLS + RW_COLS + ML_COLS
MIX_WIDTH = DA_WIDTH + RW_WIDTH + ML_WIDTH

N_GROUPS = 4
EXPERTS_PER_GROUP = 8
N_EXPERTS = N_GROUPS * EXPERTS_PER_GROUP
TOP_K = 2
EXPERT_HIDDEN = D_MODEL // 2
MOE_BLOCK = 256

kernel_name = 'hybrid_diffattn_rwkv7_mlstm_hmoe_dit'


def rms_norm(x, g):
    xf = x.astype(jnp.float32)
    y = xf * lax.rsqrt(jnp.mean(xf * xf, axis=-1, keepdims=True) + NORM_EPS)
    return (y * g.astype(jnp.float32)).astype(x.dtype)


def layer_norm_nogain(y, eps):
    mu = jnp.mean(y, axis=-1, keepdims=True)
    var = jnp.mean(jnp.square(y - mu), axis=-1, keepdims=True)
    return (y - mu) * lax.rsqrt(var + eps)


def split_heads(u, h, d):
    return u.reshape(u.shape[:-1] + (h, d))


def neighbour_mean(z):
    zp = jnp.pad(z, ((0, 0), (1, 1), (0, 0)))
    return 0.5 * (zp[:, :-2] + zp[:, 2:])


def dwconv3(z, w, b):
    zp = jnp.pad(z, ((0, 0), (1, 1), (0, 0)))
    return zp[:, :-2] * w[0] + zp[:, 1:-1] * w[1] + zp[:, 2:] * w[2] + b


def axial_rope(u, row, col):
    half = DA_QK_DIM // 2
    nf = half // 2
    inv = ROPE_THETA ** (-jnp.arange(nf, dtype=jnp.float32) / nf)

    def rot(v, pos):
        ang = pos[:, None] * inv
        cos = jnp.cos(ang)[None, :, None, None, :]
        sin = jnp.sin(ang)[None, :, None, None, :]
        v1, v2 = v[..., :nf], v[..., nf:]
        return jnp.concatenate([v1 * cos - v2 * sin, v1 * sin + v2 * cos], axis=-1)

    uf = u.astype(jnp.float32)
    return jnp.concatenate([rot(uf[..., :half], row), rot(uf[..., half:], col)], axis=-1).astype(u.dtype)


def diff_attention(q, k, v, lam):
    B, Tq = q.shape[:2]
    nb = Tq // DA_QBLOCK
    qb = jnp.moveaxis(q.reshape((B, nb, DA_QBLOCK) + q.shape[2:]), 1, 0)
    scale = DA_QK_DIM ** -0.5

    def block(qi):
        s = jnp.einsum('bqhmd,bkhmd->bhmqk', qi, k).astype(jnp.float32) * scale
        p = jax.nn.softmax(s, axis=-1)
        a = p[:, :, 0] - lam * p[:, :, 1]
        return jnp.einsum('bhqk,bkhe->bqhe', a, v.astype(jnp.float32))

    o = lax.map(block, qb)
    return jnp.moveaxis(o, 0, 1).reshape((B, Tq) + o.shape[3:])


def da_heads(z):
    B, T = z.shape[:2]
    q = z[..., :DA_QK_COLS].reshape(B, T, DA_HEADS, 2, DA_QK_DIM)
    k = z[..., DA_QK_COLS:2 * DA_QK_COLS].reshape(B, T, DA_HEADS, 2, DA_QK_DIM)
    v = z[..., 2 * DA_QK_COLS:DA_COLS].reshape(B, T, DA_HEADS, DA_V_DIM)
    return q, k, v


def da_post(o, g, lam_init):
    B, T = o.shape[:2]
    return (rms_norm(o, g) * (1.0 - lam_init)).reshape(B, T, DA_WIDTH)


def rwkv_step(S, inp):
    r, w, kk, a, k, v = inp
    sa = jnp.einsum('dbhij,dbhj->dbhi', S, kk)
    S = S * w[..., None, :] - sa[..., :, None] * (kk * a)[..., None, :] + v[..., :, None] * k[..., None, :]
    return S, jnp.einsum('dbhij,dbhj->dbhi', S, r)


def rwkv_group(z, state0, mu, w0, w2, a0, a2, g2, k_k, k_a, r_k, ln_g, ln_b):
    z = z.astype(jnp.float32)
    z = z + mu * (neighbour_mean(z) - z)
    B, T = z.shape[:2]
    C, H, N = RW_WIDTH, RW_HEADS, RW_HEAD_DIM
    r, k, v = z[..., :C], z[..., C:2 * C], z[..., 2 * C:3 * C]
    o1 = 3 * C + 2 * RW_DECAY_RANK
    o2 = o1 + 2 * RW_ICL_RANK
    wd = z[..., 3 * C:o1].reshape(B, T, 2, RW_DECAY_RANK)
    ad = z[..., o1:o2].reshape(B, T, 2, RW_ICL_RANK)
    gd = z[..., o2:]
    decay = jnp.exp(-RW_DECAY_SCALE * jax.nn.sigmoid(w0 + jnp.einsum('btdr,drc->btdc', jnp.tanh(wd), w2)))
    a = jax.nn.sigmoid(a0 + jnp.einsum('btdr,drc->btdc', ad, a2))
    g = jax.nn.sigmoid(gd) @ g2
    kk = split_heads(k * k_k, H, N)
    kk = kk / jnp.maximum(jnp.sqrt(jnp.sum(kk * kk, axis=-1, keepdims=True)), 1e-12)
    kmod = split_heads(k[:, :, None, :] * (1.0 + (a - 1.0) * k_a), H, N)
    rh = split_heads(r, H, N)
    vh = split_heads(v, H, N)

    def shared(u):
        return jnp.stack([u, jnp.flip(u, 1)], 0).transpose(2, 0, 1, 3, 4)

    def per_dir(u):
        return jnp.stack([u[:, :, 0], jnp.flip(u[:, :, 1], 1)], 0).transpose(2, 0, 1, 3, 4)

    state, ys = lax.scan(rwkv_step, state0,
                         (shared(rh), per_dir(split_heads(decay, H, N)), shared(kk),
                          per_dir(split_heads(a, H, N)), per_dir(kmod), shared(vh)))
    y = (ys[:, 0] + jnp.flip(ys[:, 1], 0)).transpose(1, 0, 2, 3)
    y = layer_norm_nogain(y, RW_GN_EPS).reshape(B, T, C) * ln_g + ln_b
    bonus = jnp.sum(rh * r_k * (kmod[:, :, 0] + kmod[:, :, 1]), axis=-1, keepdims=True) * vh
    return (y + bonus.reshape(B, T, C)) * g, state


def mlstm_chunk_step(carry, inp):
    C0, n0, m0 = carry
    q, k, v, ig, lf = inp
    L = q.shape[-2]
    mask = jnp.tril(jnp.ones((L, L), dtype=bool))
    b = jnp.cumsum(lf, axis=-1)
    dmat = jnp.where(mask, b[..., :, None] - b[..., None, :] + ig[..., None, :], -jnp.inf)
    inter = b + m0[..., None]
    m = jnp.maximum(jnp.max(dmat, axis=-1), inter)
    s = jnp.einsum('...td,...sd->...ts', q, k) * jnp.exp(dmat - m[..., None])
    ie = jnp.exp(inter - m)
    num = jnp.einsum('...ts,...sd->...td', s, v) + ie[..., None] * jnp.einsum('...td,...ed->...te', q, C0)
    den = jnp.sum(s, axis=-1) + ie * jnp.einsum('...td,...d->...t', q, n0)
    h = num / jnp.maximum(jnp.abs(den), jnp.exp(-m))[..., None]
    b_last = b[..., -1]
    gam = b_last[..., None] - b + ig
    m_new = jnp.maximum(b_last + m0, jnp.max(gam, axis=-1))
    sc = jnp.exp(gam - m_new[..., None])
    carry_decay = jnp.exp(b_last + m0 - m_new)
    C_new = carry_decay[..., None, None] * C0 + jnp.einsum('...s,...se,...sd->...ed', sc, v, k)
    n_new = carry_decay[..., None] * n0 + jnp.einsum('...s,...sd->...d', sc, k)
    return (C_new, n_new, m_new), h


def mlstm_group(z, state0, conv_w, conv_b, gate_b, norm_g):
    z = z.astype(jnp.float32)
    B, T = z.shape[:2]
    W, H, d, L = ML_WIDTH, ML_HEADS, ML_HEAD_DIM, ML_CHUNK
    nc = T // L
    qk = jax.nn.silu(dwconv3(z[..., :2 * W], conv_w, conv_b))
    q = split_heads(qk[..., :W], H, d)
    k = split_heads(qk[..., W:], H, d) * (d ** -0.5)
    v = split_heads(z[..., 2 * W:3 * W], H, d)
    o = z[..., 3 * W:4 * W]
    gates = (z[..., 4 * W:] + gate_b).reshape(B, T, 2, 2, H)
    ig = gates[:, :, :, 0]
    lf = jax.nn.log_sigmoid(gates[:, :, :, 1])

    def shared(u):
        u = jnp.stack([u, jnp.flip(u, 1)], 0)
        return u.reshape(2, B, nc, L, H, d).transpose(2, 0, 1, 4, 3, 5)

    def per_dir(u):
        u = jnp.stack([u[:, :, 0], jnp.flip(u[:, :, 1], 1)], 0)
        return u.reshape(2, B, nc, L, H).transpose(2, 0, 1, 4, 3)

    state, hs = lax.scan(mlstm_chunk_step, state0,
                         (shared(q), shared(k), shared(v), per_dir(ig), per_dir(lf)))
    hs = hs.transpose(1, 2, 0, 4, 3, 5).reshape(2, B, T, H, d)
    h = layer_norm_nogain(hs[0] + jnp.flip(hs[1], 1), NORM_EPS).reshape(B, T, W) * norm_g
    return jax.nn.sigmoid(o) * h, state


def hier_moe(h, wg, bg, we, be, w_gu, w_down):
    f32 = jnp.float32
    N, D = h.shape
    hf = h.astype(f32)
    g_logits = hf @ wg.astype(f32) + bg.astype(f32)
    g_prob = jax.nn.softmax(g_logits, axis=-1)
    g_sel = jnp.argmax(g_logits, axis=-1)
    g_w = jnp.take_along_axis(g_prob, g_sel[:, None], axis=-1)
    e_logits = (hf @ we.astype(f32) + be.astype(f32)).reshape(N, N_GROUPS, EXPERTS_PER_GROUP)
    e_logits = jnp.take_along_axis(e_logits, g_sel[:, None, None], axis=1)[:, 0]
    top_p, top_i = lax.top_k(jax.nn.softmax(e_logits, axis=-1), TOP_K)
    slot_w = (g_w * top_p / jnp.sum(top_p, axis=-1, keepdims=True)).reshape(-1)
    slot_e = (g_sel[:, None] * EXPERTS_PER_GROUP + top_i).reshape(-1)
    M = N * TOP_K
    slot_tok = jnp.repeat(jnp.arange(N), TOP_K)
    order = jnp.argsort(slot_e)
    se, st, sw = slot_e[order], slot_tok[order], slot_w[order]
    counts = jnp.bincount(slot_e, length=N_EXPERTS)
    padded = (counts + MOE_BLOCK - 1) // MOE_BLOCK * MOE_BLOCK
    pad_end = jnp.cumsum(padded)
    dest = (pad_end - padded)[se] + jnp.arange(M) - (jnp.cumsum(counts) - counts)[se]
    n_blocks = -(-M // MOE_BLOCK) + N_EXPERTS
    xs = jnp.zeros((n_blocks * MOE_BLOCK, D), h.dtype).at[dest].set(h[st])
    block_e = jnp.minimum(jnp.searchsorted(pad_end, jnp.arange(n_blocks) * MOE_BLOCK, side='right'), N_EXPERTS - 1)

    def expert_block(args):
        xb, e = args
        gate, up = jnp.split(xb @ w_gu[e], 2, axis=-1)
        return (jax.nn.silu(gate) * up) @ w_down[e]

    ys = lax.map(expert_block, (xs.reshape(n_blocks, MOE_BLOCK, D), block_e)).reshape(-1, D)
    out = jnp.zeros((N, D), f32).at[st].add(ys[dest].astype(f32) * sw[:, None])
    return out.astype(h.dtype)


def setup_inputs(seed: int = 0) -> dict:
    key = jax.random.key(seed)
    ks = jax.random.split(key, 40)
    f32 = jnp.float32
    D = D_MODEL

    def nrm(i, shape, scale):
        return scale * jax.random.normal(ks[i], shape, f32)

    i_bias = nrm(25, (DEPTH, 2, 1, ML_HEADS), 0.1)
    f_bias = jnp.linspace(3.0, 6.0, ML_HEADS, dtype=f32) + nrm(26, (DEPTH, 2, 1, ML_HEADS), 0.1)
    return {
        'x': nrm(0, (BATCH, SEQ, D), 1.0),
        'c': nrm(1, (BATCH, D), 1.0),
        'ctx': nrm(2, (BATCH, CTX_LEN, D), 1.0),
        'c_ctx': nrm(3, (D,), 1.0),
        'ada_w': nrm(4, (DEPTH, D, 6 * D), 0.3 * D ** -0.5),
        'ada_b': nrm(5, (DEPTH, 6 * D), 0.01),
        'norm1_g': 1.0 + nrm(6, (DEPTH, D), 0.02),
        'norm2_g': 1.0 + nrm(7, (DEPTH, D), 0.02),
        'w_in': nrm(8, (DEPTH, D, IN_COLS), D ** -0.5),
        'w_out': nrm(9, (DEPTH, MIX_WIDTH, D), MIX_WIDTH ** -0.5),
        'da_lambda': nrm(10, (DEPTH, 4, DA_QK_DIM), 0.1),
        'da_subln_g': 1.0 + nrm(11, (DEPTH, DA_V_DIM), 0.02),
        'rw_shift_mu': jax.random.uniform(ks[12], (DEPTH, RW_COLS), f32),
        'rw_w0': nrm(13, (DEPTH, 2, RW_WIDTH), 0.5),
        'rw_w2': nrm(14, (DEPTH, 2, RW_DECAY_RANK, RW_WIDTH), 0.1 * RW_DECAY_RANK ** -0.5),
        'rw_a0': nrm(15, (DEPTH, 2, RW_WIDTH), 0.5),
        'rw_a2': nrm(16, (DEPTH, 2, RW_ICL_RANK, RW_WIDTH), 0.1 * RW_ICL_RANK ** -0.5),
        'rw_g2': nrm(17, (DEPTH, RW_GATE_RANK, RW_WIDTH), RW_GATE_RANK ** -0.5),
        'rw_k_k': 0.85 + nrm(18, (DEPTH, RW_WIDTH), 0.05),
        'rw_k_a': 1.0 + nrm(19, (DEPTH, RW_WIDTH), 0.05),
        'rw_r_k': nrm(20, (DEPTH, RW_HEADS, RW_HEAD_DIM), 0.1),
        'rw_ln_g': 1.0 + nrm(21, (DEPTH, RW_WIDTH), 0.02),
        'rw_ln_b': nrm(22, (DEPTH, RW_WIDTH), 0.01),
        'ml_conv_w': nrm(23, (DEPTH, 3, 2 * ML_WIDTH), 3 ** -0.5),
        'ml_conv_b': nrm(24, (DEPTH, 2 * ML_WIDTH), 0.01),
        'ml_gate_b': jnp.concatenate([i_bias, f_bias], axis=2).reshape(DEPTH, 4 * ML_HEADS),
        'ml_norm_g': 1.0 + nrm(27, (DEPTH, ML_WIDTH), 0.02),
        'router_wg': nrm(28, (DEPTH, D, N_GROUPS), D ** -0.5),
        'router_bg': nrm(29, (DEPTH, N_GROUPS), 0.01),
        'router_we': nrm(30, (DEPTH, D, N_EXPERTS), D ** -0.5),
        'router_be': nrm(31, (DEPTH, N_EXPERTS), 0.01),
        'exp_w_gu': nrm(32, (DEPTH, N_EXPERTS, D, 2 * EXPERT_HIDDEN), D ** -0.5),
        'exp_w_down': nrm(33, (DEPTH, N_EXPERTS, EXPERT_HIDDEN, D), EXPERT_HIDDEN ** -0.5),
        'final_g': 1.0 + nrm(34, (D,), 0.02),
    }


def reference(x, c, ctx, c_ctx, ada_w, ada_b, norm1_g, norm2_g, w_in, w_out, da_lambda, da_subln_g,
              rw_shift_mu, rw_w0, rw_w2, rw_a0, rw_a2, rw_g2, rw_k_k, rw_k_a, rw_r_k, rw_ln_g, rw_ln_b,
              ml_conv_w, ml_conv_b, ml_gate_b, ml_norm_g, router_wg, router_bg, router_we, router_be,
              exp_w_gu, exp_w_down, final_g):
    f32 = jnp.float32
    B, T, D = x.shape
    Tc = ctx.shape[1]
    ROWS = T // GRID_W
    row = jnp.repeat(jnp.arange(ROWS, dtype=f32), GRID_W)
    col = jnp.tile(jnp.arange(GRID_W, dtype=f32), ROWS)
    rw_state0 = jnp.zeros((2, B, RW_HEADS, RW_HEAD_DIM, RW_HEAD_DIM), f32)
    ml_state0 = (jnp.zeros((2, B, ML_HEADS, ML_HEAD_DIM, ML_HEAD_DIM), f32),
                 jnp.zeros((2, B, ML_HEADS, ML_HEAD_DIM), f32),
                 jnp.zeros((2, B, ML_HEADS), f32))
    cs = ctx
    for l in range(DEPTH):
        last = l == DEPTH - 1
        lam_init = 0.8 - 0.6 * math.exp(-0.3 * l)
        mod_x = jax.nn.silu(c) @ ada_w[l] + ada_b[l]
        mod_c = jax.nn.silu(c_ctx) @ ada_w[l] + ada_b[l]
        sh1x, sc1x, g1x, sh2x, sc2x, g2x = [m[:, None, :] for m in jnp.split(mod_x, 6, axis=-1)]
        sh1c, sc1c, g1c, sh2c, sc2c, g2c = jnp.split(mod_c, 6, axis=-1)
        zx = (rms_norm(x, norm1_g[l]) * (1.0 + sc1x) + sh1x) @ w_in[l]
        zc = (rms_norm(cs, norm1_g[l]) * (1.0 + sc1c) + sh1c) @ w_in[l]

        lq1, lk1, lq2, lk2 = da_lambda[l].astype(f32)
        lam = jnp.exp(jnp.sum(lq1 * lk1)) - jnp.exp(jnp.sum(lq2 * lk2)) + lam_init
        qc, kc, vc = da_heads(zc[..., :DA_COLS])
        qx, kx, vx = da_heads(zx[..., :DA_COLS])
        k_all = jnp.concatenate([kc, axial_rope(kx, row, col)], axis=1)
        v_all = jnp.concatenate([vc, vx], axis=1)
        att_x = da_post(diff_attention(axial_rope(qx, row, col), k_all, v_all, lam), da_subln_g[l], lam_init)

        rw_args = (rw_shift_mu[l], rw_w0[l], rw_w2[l], rw_a0[l], rw_a2[l], rw_g2[l],
                   rw_k_k[l], rw_k_a[l], rw_r_k[l], rw_ln_g[l], rw_ln_b[l])
        rw_c, rw_state = rwkv_group(zc[..., DA_COLS:DA_COLS + RW_COLS], rw_state0, *rw_args)
        rw_x, _ = rwkv_group(zx[..., DA_COLS:DA_COLS + RW_COLS], rw_state, *rw_args)

        ml_args = (ml_conv_w[l], ml_conv_b[l], ml_gate_b[l], ml_norm_g[l])
        ml_c, ml_state = mlstm_group(zc[..., DA_COLS + RW_COLS:], ml_state0, *ml_args)
        ml_x, _ = mlstm_group(zx[..., DA_COLS + RW_COLS:], ml_state, *ml_args)

        x = x + g1x * (jnp.concatenate([att_x, rw_x, ml_x], axis=-1).astype(x.dtype) @ w_out[l])
        moe_args = (router_wg[l], router_bg[l], router_we[l], router_be[l], exp_w_gu[l], exp_w_down[l])
        h2x = rms_norm(x, norm2_g[l]) * (1.0 + sc2x) + sh2x
        if last:
            x = x + g2x * hier_moe(h2x.reshape(B * T, D), *moe_args).reshape(B, T, D)
        else:
            att_c = da_post(diff_attention(qc, kc, vc, lam), da_subln_g[l], lam_init)
            cs = cs + g1c * (jnp.concatenate([att_c, rw_c, ml_c], axis=-1).astype(cs.dtype) @ w_out[l])
            h2c = rms_norm(cs, norm2_g[l]) * (1.0 + sc2c) + sh2c
            y = hier_moe(jnp.concatenate([h2c.reshape(B * Tc, D), h2x.reshape(B * T, D)], axis=0), *moe_args)
            cs = cs + g2c * y[:B * Tc].reshape(B, Tc, D)
            x = x + g2x * y[B * Tc:].reshape(B, T, D)
    return rms_norm(x, final_g)
```

```cpp
#include <hip/hip_runtime.h>
#include <cstdio>
#include <cstdint>

#ifndef MK_N_LAUNCHES
#define MK_N_LAUNCHES 1
#endif

namespace pg8 {
#define PG8_LAS __attribute__((address_space(3)))
typedef unsigned short bf16_t;
typedef short bf16x8 __attribute__((ext_vector_type(8)));
typedef float f32x4 __attribute__((ext_vector_type(4)));
typedef unsigned u32x4 __attribute__((ext_vector_type(4)));
constexpr int BM = 256, BK = 64, HALF = 128, HTB = HALF * BK * 2, STAGE_BYTES = 8 * HTB;

__host__ __device__ __forceinline__ int lds_byte(int r, int c) { const int st = (r >> 4) * 2 + (c >> 5), rr = r & 15, cc = c & 31, ob = rr * 64 + cc * 2; return st * 1024 + (ob ^ (((ob >> 9) & 1) << 5)); }
__host__ __device__ __forceinline__ void stage_rc(int b, int& R, int& C) { const int st = b / 1024, sb = b % 1024, swz = sb ^ (((sb >> 9) & 1) << 5); R = (st >> 1) * 16 + swz / 64; C = (st & 1) * 32 + (swz % 64) / 2; }
__host__ __device__ __forceinline__ int perm32(int rho) { const int n = rho >> 4, i = rho & 15; return 8 * (i >> 2) + 4 * n + (i & 3); }

struct Unit { int pm, pn; size_t boff; };
struct Gemm { const bf16_t* A; const bf16_t* Bt; int K; };

__device__ __forceinline__ unsigned cvt_pk_bf16(float lo, float hi) { unsigned r; asm volatile("v_cvt_pk_bf16_f32 %0, %1, %2" : "=v"(r) : "v"(lo), "v"(hi)); return r; }

template <class Epi, class Sched, bool ALIGN_EPI = true, bool SP2 = true>
__device__ __forceinline__ void gemm_phase(PG8_LAS unsigned char* lds, const Gemm g, const Sched& S, const Epi& E) {
    int tid = threadIdx.x; asm volatile("" : "+v"(tid));
    const int wid = __builtin_amdgcn_readfirstlane(tid >> 6), lane = tid & 63, wr = wid >> 2, wc = wid & 3, fr = lane & 15, fq = lane >> 4;
    const int K = g.K, nt = K / BK;
    unsigned voffA[2], voffB[2];
#pragma unroll
    for (int i = 0; i < 2; ++i) { int R, C; stage_rc(tid * 16 + i * 8192, R, C); const int Rb = Epi::PERM ? ((R & ~31) + perm32(R & 31)) : R;
        voffA[i] = (unsigned)(R * K + C) * 2u; voffB[i] = (unsigned)(Rb * K + C) * 2u; }
    const size_t kstep = (size_t)(BK * 2);
    const size_t hstep = (size_t)HALF * K * 2;
    const size_t tstep = 2 * hstep;
    const unsigned ldsw = (unsigned)wid * 1024u;
    const int aoff = lds_byte(wr * 64 + fr, fq * 8), boff = lds_byte(wc * 32 + fr, fq * 8);
#define PG8_SA(b, h) (((b) * 2 + (h)) * HTB)
#define PG8_SB(b, h) ((4 + (b) * 2 + (h)) * HTB)
#define PG8_STAGE(bufoff, gbase, voff) do { _Pragma("unroll") for (int _i = 0; _i < 2; ++_i) \
        __builtin_amdgcn_global_load_lds((const unsigned*)((const char*)(gbase) + (voff)[_i]), (PG8_LAS unsigned*)(lds + (bufoff) + ldsw + _i * 8192), 16, 0, 0); } while (0)
#define PG8_LDA(dst, b, h) do { _Pragma("unroll") for (int m = 0; m < 4; ++m) _Pragma("unroll") for (int k = 0; k < 2; ++k) dst[m][k] = *(const PG8_LAS bf16x8*)(lds + PG8_SA(b, h) + aoff + m * 2048 + k * 1024); } while (0)
#define PG8_LDB(dst, b, h) do { _Pragma("unroll") for (int n = 0; n < 2; ++n) _Pragma("unroll") for (int k = 0; k < 2; ++k) dst[n][k] = *(const PG8_LAS bf16x8*)(lds + PG8_SB(b, h) + boff + n * 2048 + k * 1024); } while (0)
#define PG8_MMA(ai, bj, At, Bt) do { __builtin_amdgcn_s_setprio(1); _Pragma("unroll") for (int m = 0; m < 4; ++m) _Pragma("unroll") for (int n = 0; n < 2; ++n) _Pragma("unroll") for (int k = 0; k < 2; ++k) \
        acc[ai][bj][m][n] = __builtin_amdgcn_mfma_f32_16x16x32_bf16(Bt[n][k], At[m][k], acc[ai][bj][m][n], 0, 0, 0); __builtin_amdgcn_s_setprio(0); } while (0)
#define PG8_WAIT_V(n) asm volatile("s_waitcnt vmcnt(" #n ")" ::: "memory")
#define PG8_WAIT_L(n) asm volatile("s_waitcnt lgkmcnt(" #n ")" ::: "memory")
#define PG8_BAR __builtin_amdgcn_s_barrier()
#define PG8_SCHED __builtin_amdgcn_sched_barrier(0)
    Unit cur, nxt; int ui = 0;
    if (!S.next(0, cur)) return;
    f32x4 acc[2][2][4][2];
#pragma unroll
    for (int a = 0; a < 2; ++a)
#pragma unroll
        for (int b = 0; b < 2; ++b)
#pragma unroll
            for (int m = 0; m < 4; ++m)
#pragma unroll
                for (int n = 0; n < 2; ++n) acc[a][b][m][n] = (f32x4){0.f, 0.f, 0.f, 0.f};
    bf16x8 At[4][2], B0[2][2], B1[2][2];
    const char* cA = (const char*)g.A + (size_t)cur.pm * tstep; const char* cB = (const char*)g.Bt + cur.boff + (size_t)cur.pn * tstep;
    if constexpr (SP2) {
        PG8_STAGE(PG8_SB(0, 0), cB, voffB); PG8_STAGE(PG8_SB(0, 1), cB + hstep, voffB); PG8_STAGE(PG8_SA(0, 0), cA, voffA); PG8_STAGE(PG8_SA(0, 1), cA + hstep, voffA);
        if (wr == 1) PG8_BAR;
        PG8_WAIT_V(2); PG8_BAR;
        PG8_STAGE(PG8_SB(1, 0), cB + kstep, voffB); PG8_STAGE(PG8_SA(1, 0), cA + kstep, voffA); PG8_STAGE(PG8_SB(1, 1), cB + hstep + kstep, voffB);
        PG8_WAIT_V(6); PG8_BAR;
    } else {
        PG8_STAGE(PG8_SB(0, 0), cB, voffB); PG8_STAGE(PG8_SA(0, 0), cA, voffA); PG8_STAGE(PG8_SB(0, 1), cB + hstep, voffB); PG8_STAGE(PG8_SA(0, 1), cA + hstep, voffA);
        if (wr == 1) PG8_BAR;
        PG8_WAIT_V(4); PG8_BAR;
        PG8_STAGE(PG8_SB(1, 0), cB + kstep, voffB); PG8_STAGE(PG8_SA(1, 0), cA + kstep, voffA); PG8_STAGE(PG8_SB(1, 1), cB + hstep + kstep, voffB);
        PG8_WAIT_V(6); PG8_BAR;
    }
    for (;;) {
        const bool has_next = S.next(ui + 1, nxt);
        const char* nA = has_next ? (const char*)g.A + (size_t)nxt.pm * tstep : cA; const char* nB = has_next ? (const char*)g.Bt + nxt.boff + (size_t)nxt.pn * tstep : cB;
        for (int t = 0; t < nt; t += 2) {
            const bool last = (t == nt - 2);
            const char* a1 = cA + (size_t)(t + 1) * kstep;
            const char* a2 = last ? nA : cA + (size_t)(t + 2) * kstep; const char* b2 = last ? nB : cB + (size_t)(t + 2) * kstep;
            const char* a3 = a2 + kstep; const char* b3 = b2 + kstep;
            if constexpr (SP2) {
            PG8_LDB(B0, 0, 0); PG8_LDB(B1, 0, 1); PG8_SCHED; PG8_LDA(At, 0, 0); PG8_STAGE(PG8_SA(1, 1), a1 + hstep, voffA);
            PG8_WAIT_V(8); PG8_WAIT_L(0); PG8_BAR; PG8_MMA(0, 0, At, B0); PG8_MMA(0, 1, At, B1); PG8_BAR; PG8_SCHED;
            PG8_LDA(At, 0, 1); PG8_STAGE(PG8_SB(0, 0), b2, voffB); PG8_STAGE(PG8_SB(0, 1), b2 + hstep, voffB); PG8_STAGE(PG8_SA(0, 0), a2, voffA);
            PG8_WAIT_V(8); PG8_WAIT_L(0); PG8_BAR; PG8_MMA(1, 0, At, B0); PG8_MMA(1, 1, At, B1); PG8_BAR; PG8_SCHED;
            PG8_LDB(B0, 1, 0); PG8_LDB(B1, 1, 1); PG8_SCHED; PG8_LDA(At, 1, 0); PG8_STAGE(PG8_SA(0, 1), a2 + hstep, voffA);
            PG8_WAIT_V(8); PG8_WAIT_L(0); PG8_BAR; PG8_MMA(0, 0, At, B0); PG8_MMA(0, 1, At, B1); PG8_BAR; PG8_SCHED;
            PG8_LDA(At, 1, 1); PG8_STAGE(PG8_SB(1, 0), b3, voffB); PG8_STAGE(PG8_SB(1, 1), b3 + hstep, voffB); PG8_STAGE(PG8_SA(1, 0), a3, voffA);
            PG8_WAIT_V(8); PG8_WAIT_L(0); PG8_BAR; PG8_MMA(1, 0, At, B0); PG8_MMA(1, 1, At, B1); PG8_BAR; PG8_SCHED;
            } else {
            PG8_LDB(B0, 0, 0); PG8_SCHED; PG8_LDA(At, 0, 0); PG8_STAGE(PG8_SA(1, 1), a1 + hstep, voffA);
            PG8_WAIT_L(8); PG8_BAR; PG8_WAIT_L(0); PG8_MMA(0, 0, At, B0); PG8_BAR; PG8_SCHED;
            PG8_LDB(B1, 0, 1); PG8_STAGE(PG8_SB(0, 0), b2, voffB);
            PG8_BAR; PG8_WAIT_L(0); PG8_MMA(0, 1, At, B1); PG8_BAR;
            PG8_LDA(At, 0, 1); PG8_STAGE(PG8_SA(0, 0), a2, voffA);
            PG8_BAR; PG8_WAIT_L(0); PG8_MMA(1, 0, At, B0); PG8_BAR; PG8_SCHED;
            PG8_STAGE(PG8_SB(0, 1), b2 + hstep, voffB);
            PG8_WAIT_V(6); PG8_BAR; PG8_MMA(1, 1, At, B1); PG8_BAR;
            PG8_LDB(B0, 1, 0); PG8_SCHED; PG8_LDA(At, 1, 0); PG8_STAGE(PG8_SA(0, 1), a2 + hstep, voffA);
            PG8_WAIT_L(8); PG8_BAR; PG8_WAIT_L(0); PG8_MMA(0, 0, At, B0); PG8_BAR; PG8_SCHED;
            PG8_LDB(B1, 1, 1); PG8_STAGE(PG8_SB(1, 0), b3, voffB);
            PG8_BAR; PG8_WAIT_L(0); PG8_MMA(0, 1, At, B1); PG8_BAR;
            PG8_LDA(At, 1, 1); PG8_STAGE(PG8_SA(1, 0), a3, voffA);
            PG8_BAR; PG8_WAIT_L(0); PG8_MMA(1, 0, At, B0); PG8_BAR; PG8_SCHED;
            PG8_STAGE(PG8_SB(1, 1), b3 + hstep, voffB);
            PG8_WAIT_V(6); PG8_BAR; PG8_MMA(1, 1, At, B1); PG8_BAR;
            }
        }
        if constexpr (ALIGN_EPI) { if (wr == 0) PG8_BAR; }
        E(acc, cur, wr, wc, fr, fq);
        if (!has_next) break;
#pragma unroll
        for (int a = 0; a < 2; ++a)
#pragma unroll
            for (int b = 0; b < 2; ++b)
#pragma unroll
                for (int m = 0; m < 4; ++m)
#pragma unroll
                    for (int n = 0; n < 2; ++n) acc[a][b][m][n] = (f32x4){0.f, 0.f, 0.f, 0.f};
        cur = nxt; cA = nA; cB = nB; ++ui;
        if constexpr (ALIGN_EPI) { if (wr == 1) PG8_BAR; }
    }
    PG8_WAIT_V(0);
    if constexpr (!ALIGN_EPI) { if (wr == 0) PG8_BAR; }
    PG8_BAR;
#undef PG8_SA
#undef PG8_SB
#undef PG8_STAGE
#undef PG8_LDA
#undef PG8_LDB
#undef PG8_MMA
#undef PG8_WAIT_V
#undef PG8_WAIT_L
#undef PG8_BAR
#undef PG8_SCHED
}
}

constexpr int D = 1024, NB = 8, T = 4096, TC = 256, DEPTH = 4, GRID_W = 64;
constexpr int NCX = NB * TC;
constexpr int NXR = NB * T;
constexpr int NT = NCX + NXR;
constexpr int IN_COLS = 3536, NPAD = 3584;
constexpr int ZQ = 0, ZK = 512, ZV = 1024, ZRW = 1536, ZML = 2496;
constexpr int TK = TC + T;
constexpr int NEXP = 32, EH = 512;
constexpr int MOE_ROWS = 2 * NT + NEXP * 256;
constexpr int NWAVES = 8;
constexpr float NORM_EPS = 1e-6f;

constexpr size_t MiB = 1u << 20;
constexpr size_t WS_CTL = 0, CTL_ZERO_BYTES = 1 * MiB;
constexpr size_t WS_XS = 1 * MiB;
constexpr size_t WS_WIN = 137 * MiB;
constexpr size_t WS_WOUT = 165 * MiB;
constexpr size_t WS_WGU = 173 * MiB;
constexpr size_t WS_WDN = 429 * MiB;
constexpr size_t WS_MOD = 557 * MiB;
constexpr size_t WS_H1 = 558 * MiB;
constexpr size_t WS_ROUTE = 626 * MiB;
constexpr size_t WS_A = 628 * MiB;
constexpr size_t WS_Z = WS_A;
constexpr size_t WS_QB = WS_A + 238 * MiB;
constexpr size_t WS_QC = WS_A + 270 * MiB;
constexpr size_t WS_KB = WS_A + 272 * MiB;
constexpr size_t WS_VB = WS_A + 306 * MiB;
constexpr size_t WS_ATTO = WS_A + 340 * MiB;
constexpr size_t WS_RWC = WS_A + 476 * MiB;
constexpr size_t WS_RV = WS_A + 723 * MiB;
constexpr size_t WS_RG = WS_A + 782 * MiB;
constexpr size_t WS_RBS = WS_A + 757 * MiB;
constexpr size_t WS_RYS = WS_A + 817 * MiB;
constexpr size_t WS_DC = WS_A + 885 * MiB;
constexpr size_t WS_CS = WS_A + 919 * MiB;
constexpr size_t WS_DN = WS_A + 953 * MiB;
constexpr size_t WS_NS = WS_A + 954 * MiB;
constexpr size_t WS_MIX = WS_A + 955 * MiB;
constexpr size_t WS_XSORT = WS_A;
constexpr size_t WS_ACT = WS_A + 152 * MiB;
constexpr size_t WS_YS = WS_A + 228 * MiB;
constexpr size_t WS_WM = WS_A + 1023 * MiB;
constexpr size_t WS_LORA = WS_A + 1025 * MiB;
constexpr size_t WS_END = WS_A + 1026 * MiB;
static_assert(WS_YS + (size_t)MOE_ROWS * 1024 * 4 <= WS_END, "ws map");
constexpr int MOD_LAM = 4 * 9 * 6144;
constexpr int MOD_ROPE = MOD_LAM + 64;
constexpr int LORA_A2T = 4 * 2 * 256 * 32, LORA_G2T = 2 * LORA_A2T;
constexpr int WM_CB = 0;
constexpr size_t WMB_HI = 4096, WMB_LO = 4096 + 9 * 48 * 1024 * 2;
constexpr int ROUTE_RSTD = 327680;
constexpr int CW_TMO = 0;
constexpr int CW_BAR = 4096;
constexpr int CW_QUEUE = 8192;
constexpr int CW_CNT = 9216;
constexpr int CW_PREP = 24576;
constexpr int CW_FLAG = 32768;
constexpr int RING_BYTES = 131072;
constexpr int LDSCTL_OFF = 139264, MISC_OFF = LDSCTL_OFF + 320;
constexpr int LDS_BYTES = 147456;

#define GAS __attribute__((address_space(1)))
#define LAS __attribute__((address_space(3)))
typedef unsigned short bf16;
typedef unsigned v4u __attribute__((ext_vector_type(4)));
typedef unsigned v2u __attribute__((ext_vector_type(2)));
typedef float f32x4 __attribute__((ext_vector_type(4)));
typedef float f32x16 __attribute__((ext_vector_type(16)));
typedef short bf16x8 __attribute__((ext_vector_type(8)));
typedef short s16x4 __attribute__((ext_vector_type(4)));
typedef GAS unsigned gu32;
#define RLX_AGENT __ATOMIC_RELAXED, __HIP_MEMORY_SCOPE_AGENT
__device__ __forceinline__ unsigned pk2(float lo, float hi) { unsigned r; asm volatile("v_cvt_pk_bf16_f32 %0, %1, %2" : "=v"(r) : "v"(lo), "v"(hi)); return r; }
__device__ __forceinline__ unsigned f2bf(float f) { return (__builtin_bit_cast(unsigned, f) + 0x8000u) >> 16; }
__device__ __forceinline__ float bf2f(unsigned short b) { return __builtin_bit_cast(float, ((unsigned)b) << 16); }
__device__ __forceinline__ float bflo(unsigned w) { return __builtin_bit_cast(float, w << 16); }
__device__ __forceinline__ float bfhi(unsigned w) { return __builtin_bit_cast(float, w & 0xffff0000u); }
__device__ __forceinline__ void unpack8(const v4u w, float* f) { f[0] = bflo(w.x); f[1] = bfhi(w.x); f[2] = bflo(w.y); f[3] = bfhi(w.y); f[4] = bflo(w.z); f[5] = bfhi(w.z); f[6] = bflo(w.w); f[7] = bfhi(w.w); }
__device__ __forceinline__ float sigmoidf_(float x) { return __builtin_amdgcn_rcpf(1.f + __builtin_amdgcn_exp2f(-1.4426950408889634f * x)); }
__device__ __forceinline__ float siluf_(float x) { return x * __builtin_amdgcn_rcpf(1.f + __builtin_amdgcn_exp2f(-1.4426950408889634f * x)); }
__device__ __forceinline__ float rl_f(float v, int lane_) { return __builtin_bit_cast(float, __builtin_amdgcn_readlane(__builtin_bit_cast(int, v), lane_)); }
#define DPP_ADD(v, ctrl, rmask) ((v) + __builtin_bit_cast(float, __builtin_amdgcn_update_dpp(0, __builtin_bit_cast(int, (v)), (ctrl), (rmask), 0xF, false)))
__device__ __forceinline__ float quad_sum(float v) { v = DPP_ADD(v, 0xB1, 0xF); v = DPP_ADD(v, 0x4E, 0xF); return v; }
__device__ __forceinline__ float row8_sum(float v) { v = quad_sum(v); v = DPP_ADD(v, 0x141, 0xF); return v; }
__device__ __forceinline__ float row16_sum(float v) { v = row8_sum(v); v = DPP_ADD(v, 0x140, 0xF); return v; }
__device__ __forceinline__ float wave_sum(float v) {
    v = row16_sum(v); v = DPP_ADD(v, 0x142, 0xA); v = DPP_ADD(v, 0x143, 0xC);
    return __builtin_bit_cast(float, __builtin_amdgcn_readlane(__builtin_bit_cast(int, v), 63));
}

#define XB_TMO      128
#define XB_XCNT(j)  (256  + 64 * (j))
#define XB_XSUB(j)  (1280 + 64 * (j))
#define XB_XGEN(j)  (2304 + 64 * (j))
#define XB_TOP      3328
#define XB_TOPGEN   3392
#define XCD_BAR_WORDS 3456
#define XB_SPIN_CAP (1u << 22)
__device__ __forceinline__ unsigned xb_ld(unsigned* p)              { return __hip_atomic_load(p, __ATOMIC_RELAXED, __HIP_MEMORY_SCOPE_AGENT); }
__device__ __forceinline__ unsigned xb_add(unsigned* p, unsigned v) { return __hip_atomic_fetch_add(p, v, __ATOMIC_RELAXED, __HIP_MEMORY_SCOPE_AGENT); }
__device__ __forceinline__ unsigned xb_xcc_id() { return (unsigned)__builtin_amdgcn_s_getreg((3 << 11) | 20) & 0xFu; }
#define XB_SPIN(cond, bar) do { unsigned _sp = 0; while (cond) { __builtin_amdgcn_s_sleep(1); \
    if ((++_sp & 255u) == 0u) { if (xb_ld(&(bar)[XB_TMO])) break; if (_sp > XB_SPIN_CAP) { atomicAdd(&(bar)[XB_TMO], 1u); break; } } } } while (0)
struct XcdBarrier { unsigned* bar; unsigned x; volatile LAS unsigned* st; };
__device__ __forceinline__ XcdBarrier xcd_barrier_post(unsigned* bar, volatile LAS unsigned* st) {
    XcdBarrier b; b.bar = bar; b.x = xb_xcc_id(); b.st = st;
    if (threadIdx.x == 0) (void)xb_add(&bar[XB_XCNT(b.x)], 1u);
    return b;
}
__device__ __forceinline__ void xcd_barrier_complete(unsigned* bar, unsigned x, unsigned& nloc, unsigned& nx) {
    const unsigned G = gridDim.x * gridDim.y * gridDim.z;
    unsigned sum, cnt, mine, sp = 0u;
    for (;;) {
        sum = 0u; cnt = 0u; mine = 0u;
#pragma unroll
        for (unsigned j = 0; j < 16; ++j) { const unsigned c = xb_ld(&bar[XB_XCNT(j)]); sum += c; cnt += (c > 0u) ? 1u : 0u; mine = (j == x) ? c : mine; }
        if (sum == G) break;
        __builtin_amdgcn_s_sleep(1);
        if ((++sp & 255u) == 0u) { if (xb_ld(&bar[XB_TMO])) break; if (sp > XB_SPIN_CAP) { atomicAdd(&bar[XB_TMO], 1u); break; } }
    }
    nloc = mine > 0u ? mine : 1u; nx = cnt > 0u ? cnt : 1u;
}
__device__ __forceinline__ void xcd_barrier(const XcdBarrier& b) {
    asm volatile("s_waitcnt vmcnt(0)" ::: "memory");
    __syncthreads();
    if (threadIdx.x == 0) {
        unsigned* bar = b.bar;
        __builtin_amdgcn_s_waitcnt(0);
        unsigned nloc = b.st[0], nx = b.st[1];
        if (nloc == 0u) { xcd_barrier_complete(bar, b.x, nloc, nx); b.st[0] = nloc; b.st[1] = nx; }
        const unsigned old = xb_add(&bar[XB_XSUB(b.x)], 1u);
        const unsigned gen = old / nloc;
        if (old + 1u == (gen + 1u) * nloc) {
            __builtin_amdgcn_fence(__ATOMIC_RELEASE, "agent");
            asm volatile("s_waitcnt vmcnt(0)" ::: "memory");
            const unsigned og = xb_add(&bar[XB_TOP], 1u);
            const unsigned tg = og / nx;
            if (og + 1u == (tg + 1u) * nx) xb_add(&bar[XB_TOPGEN], 1u);
            else XB_SPIN(xb_ld(&bar[XB_TOPGEN]) == tg, bar);
            __builtin_amdgcn_fence(__ATOMIC_ACQUIRE, "agent");
            xb_add(&bar[XB_XGEN(b.x)], 1u);
            asm volatile("s_waitcnt vmcnt(0)" ::: "memory");
        } else {
            XB_SPIN(xb_ld(&bar[XB_XGEN(b.x)]) == gen, bar);
            __builtin_amdgcn_fence(__ATOMIC_ACQUIRE, "agent");
            asm volatile("s_waitcnt vmcnt(0)" ::: "memory");
        }
    }
    __syncthreads();
}

struct Inputs {
    const float *x, *c, *ctx, *c_ctx, *ada_w, *ada_b, *norm1_g, *norm2_g, *w_in, *w_out, *da_lambda, *da_subln_g,
                *rw_shift_mu, *rw_w0, *rw_w2, *rw_a0, *rw_a2, *rw_g2, *rw_k_k, *rw_k_a, *rw_r_k, *rw_ln_g, *rw_ln_b,
                *ml_conv_w, *ml_conv_b, *ml_gate_b, *ml_norm_g, *router_wg, *router_bg, *router_we, *router_be,
                *exp_w_gu, *exp_w_down, *final_g;
};
struct Args { Inputs in; float* out; unsigned char* ws; int ph_lo, ph_hi; };
struct Frame {
    LAS unsigned char* lds;
    volatile LAS unsigned* MISC;
    gu32* ctl;
    unsigned char* ws;
    int tid, lane, wave, vcu, G, gw, NGW;
};
__device__ __forceinline__ const float* uni_ptr(const float* p) {
    const unsigned long long u = (unsigned long long)p; const unsigned lo = __builtin_amdgcn_readfirstlane((unsigned)u), hi = __builtin_amdgcn_readfirstlane((unsigned)(u >> 32));
    return (const float*)(((unsigned long long)hi << 32) | lo); }
__device__ __forceinline__ void frame_refresh(Frame& F) {
    int t = threadIdx.x; asm volatile("" : "+v"(t));
    F.tid = t; F.lane = t & 63; F.wave = __builtin_amdgcn_readfirstlane(t >> 6); F.gw = F.vcu * NWAVES + F.wave;
}
__device__ __forceinline__ void publish_done(Frame& F, int flag_word) {
    asm volatile("s_waitcnt vmcnt(0)" ::: "memory");
    __syncthreads();
    if (threadIdx.x == 0) {
        __builtin_amdgcn_fence(__ATOMIC_RELEASE, "agent");
        asm volatile("s_waitcnt vmcnt(0)" ::: "memory");
        __hip_atomic_store((unsigned*)(F.ctl + flag_word), 1u, RLX_AGENT);
    }
}
__device__ __forceinline__ void wait_all_done(Frame& F, int flag_base) {
    int t_ = threadIdx.x; asm volatile("" : "+v"(t_));
    if (t_ < 128) {
        unsigned* p = (unsigned*)(F.ctl + flag_base + 64 * t_); unsigned sp = 0;
        while (__hip_atomic_load(p, RLX_AGENT) == 0u) { __builtin_amdgcn_s_sleep(2);
            if (++sp > (1u << 22)) { atomicAdd((unsigned*)(F.ctl + CW_BAR) + XB_TMO, 1u); break; } }
    }
    __syncthreads();
    if (threadIdx.x == 0) { __builtin_amdgcn_fence(__ATOMIC_ACQUIRE, "agent"); asm volatile("s_waitcnt vmcnt(0)" ::: "memory"); }
    __syncthreads();
}
__device__ __forceinline__ int row_seq(int row) { return row < NCX ? 8 : ((row - NCX) >> 12); }

template <int RMAP>
__device__ __forceinline__ void transpose_item(const float* W, int K, int N, bf16* WT, LAS float* scr, int item, int lane) {
    const int nblk = (N + 31) / 32, kb = item / nblk, nb = item % nblk, k0 = 64 * kb, n0 = 32 * nb;
    const int ncol = n0 + (lane & 31);
    float tv[32];
#pragma unroll
    for (int i = 0; i < 32; ++i) { const int kk = 2 * i + (lane >> 5); tv[i] = (ncol < N) ? W[(size_t)(k0 + kk) * N + ncol] : 0.f; }
#pragma unroll
    for (int i = 0; i < 32; ++i) { const int kk = 2 * i + (lane >> 5); scr[kk * 33 + (lane & 31)] = tv[i]; }
    asm volatile("s_waitcnt lgkmcnt(0)" ::: "memory");
    const int c = lane & 7;
#pragma unroll
    for (int j = 0; j < 4; ++j) { const int n = (lane >> 3) + 8 * j; const LAS float* s = scr + (8 * c) * 33 + n;
        v4u o; o.x = pk2(s[0 * 33], s[1 * 33]); o.y = pk2(s[2 * 33], s[3 * 33]); o.z = pk2(s[4 * 33], s[5 * 33]); o.w = pk2(s[6 * 33], s[7 * 33]);
        int nn = n0 + n;
        if (nn < N) {
            if (RMAP == 1) { nn = (nn < 512) ? ((nn >> 7) * 256 + (nn & 127)) : ((((nn - 512) >> 7) * 256) + 128 + ((nn - 512) & 127)); }
            *(GAS v4u*)(WT + (size_t)nn * K + k0 + 8 * c) = o; } }
    asm volatile("s_waitcnt lgkmcnt(0)" ::: "memory");
}

__device__ __forceinline__ void p0_prologue(Frame& F, const Inputs& I) {
    LAS float* scr = (LAS float*)(F.lds + F.wave * 16384);
    unsigned char* ws = F.ws;
    constexpr int I_IN = 16 * 111, I_OUT = 16 * 32, I_GU = 16 * 32, I_DN = 8 * 32;
    constexpr int N_IN = DEPTH * I_IN, N_OUT = DEPTH * I_OUT, N_GU = NEXP * I_GU, N_DN = NEXP * I_DN;
    for (int it = F.gw; it < N_IN + N_OUT + N_GU + N_DN; it += F.NGW) {
        int r = it;
        if (r < N_IN) { const int l = r / I_IN; transpose_item<0>(I.w_in + (size_t)l * D * IN_COLS, D, IN_COLS, (bf16*)(ws + WS_WIN) + (size_t)l * NPAD * D, scr, r % I_IN, F.lane); continue; } r -= N_IN;
        if (r < N_OUT) { const int l = r / I_OUT; transpose_item<0>(I.w_out + (size_t)l * D * D, D, D, (bf16*)(ws + WS_WOUT) + (size_t)l * D * D, scr, r % I_OUT, F.lane); continue; } r -= N_OUT;
        if (r < N_GU) { const int le = r / I_GU; transpose_item<1>(I.exp_w_gu + (size_t)le * D * 1024, D, 1024, (bf16*)(ws + WS_WGU) + (size_t)le * 1024 * D, scr, r % I_GU, F.lane); continue; } r -= N_GU;
        { const int le = r / I_DN; transpose_item<0>(I.exp_w_down + (size_t)le * EH * D, EH, D, (bf16*)(ws + WS_WDN) + (size_t)le * D * EH, scr, r % I_DN, F.lane); }
    }
    for (int i = F.gw * 64 + F.lane; i < DEPTH * (NPAD - IN_COLS) * D / 8; i += F.NGW * 64) {
        const int l = i / ((NPAD - IN_COLS) * D / 8), r = i % ((NPAD - IN_COLS) * D / 8);
        *(GAS v4u*)((bf16*)(ws + WS_WIN) + (size_t)l * NPAD * D + (size_t)IN_COLS * D + (size_t)r * 8) = (v4u){0u, 0u, 0u, 0u};
    }
    float* mod = (float*)(ws + WS_MOD);
    __syncthreads();
    for (int it = F.vcu; it < DEPTH * 96; it += F.G) {
        const int l = it / 96, j = (it % 96) * 64 + F.lane;
        float acc[9];
#pragma unroll
        for (int s = 0; s < 9; ++s) acc[s] = 0.f;
        const float* aw = I.ada_w + (size_t)l * D * 6144 + j;
#pragma unroll 1
        for (int kb = 0; kb < 2; ++kb) {
            const int k0 = F.wave * 128 + kb * 64;
            float sv[9];
#pragma unroll
            for (int s = 0; s < 9; ++s) { const float cv = (s < 8) ? I.c[s * D + k0 + F.lane] : I.c_ctx[k0 + F.lane]; sv[s] = siluf_(cv); }
            float wv[64];
#pragma unroll
            for (int kk = 0; kk < 64; ++kk) wv[kk] = aw[(size_t)(k0 + kk) * 6144];
#pragma unroll
            for (int kk = 0; kk < 64; ++kk)
#pragma unroll
                for (int s = 0; s < 9; ++s) acc[s] += rl_f(sv[s], kk) * wv[kk];
        }
        LAS float* red = (LAS float*)F.lds;
#pragma unroll
        for (int s = 0; s < 9; ++s) red[(F.wave * 9 + s) * 64 + F.lane] = acc[s];
        __syncthreads();
        for (int i = F.tid; i < 9 * 64; i += 512) { float t = 0.f;
#pragma unroll
            for (int w = 0; w < 8; ++w) t += red[w * 576 + i];
            const int s = i >> 6, jj = (it % 96) * 64 + (i & 63);
            mod[(size_t)(l * 9 + s) * 6144 + jj] = t + I.ada_b[l * 6144 + jj]; }
        __syncthreads();
    }
    { bf16* lora = (bf16*)(ws + WS_LORA);
      for (int i = F.gw * 64 + F.lane; i < 4 * 2 * 256 * 32; i += F.NGW * 64) { const int r = i & 31, c = (i >> 5) & 255, ld = i >> 13;
          lora[i] = (bf16)f2bf(I.rw_w2[((size_t)ld * 32 + r) * 256 + c]); lora[LORA_A2T + i] = (bf16)f2bf(I.rw_a2[((size_t)ld * 32 + r) * 256 + c]); }
      for (int i = F.gw * 64 + F.lane; i < 4 * 256 * 64; i += F.NGW * 64) { const int r = i & 63, c = (i >> 6) & 255, l = i >> 14;
          lora[LORA_G2T + i] = (bf16)f2bf(I.rw_g2[((size_t)l * 64 + r) * 256 + c]); } }
    if (F.gw == 0) {
        for (int l = 0; l < DEPTH; ++l) {
            const float* dl = I.da_lambda + l * 256;
            const float s1 = wave_sum(dl[F.lane] * dl[64 + F.lane]), s2 = wave_sum(dl[128 + F.lane] * dl[192 + F.lane]);
            const float lam_init = 0.8f - 0.6f * expf(-0.3f * (float)l);
            if (F.lane == 0) mod[MOD_LAM + l] = expf(s1) - expf(s2) + lam_init;
        }
    }
    if (F.gw == 1) {
        for (int i = F.lane; i < 1024; i += 64) { const int pos = i >> 4, fi = i & 15;
            const float inv = powf(10000.0f, -(float)fi / 16.0f); const float ang = (float)pos * inv;
            mod[MOD_ROPE + 2 * i] = cosf(ang); mod[MOD_ROPE + 2 * i + 1] = sinf(ang); }
    }
}

__device__ __forceinline__ void conv_unit(Frame& F, const Inputs& I, int lsrc, int j) {
    LAS float* scr = (LAS float*)(F.lds + F.wave * 16384);
    if (j < 256) {
#pragma unroll 1
        for (int i = 0; i < 8; ++i) { const int r = j * 64 + i * 8 + F.wave; const int le = lsrc * NEXP + (r >> 9);
            transpose_item<1>(I.exp_w_gu + (size_t)le * D * 1024, D, 1024, (bf16*)(F.ws + WS_WGU) + (size_t)le * 1024 * D, scr, r & 511, F.lane); }
    } else {
#pragma unroll 1
        for (int i = 0; i < 8; ++i) { const int r = (j - 256) * 64 + i * 8 + F.wave; const int le = lsrc * NEXP + (r >> 8);
            transpose_item<0>(I.exp_w_down + (size_t)le * EH * D, EH, D, (bf16*)(F.ws + WS_WDN) + (size_t)le * D * EH, scr, r & 255, F.lane); }
    }
}

struct NormRow { f32x4 v[4]; v2u xb[4]; v2u ya[4], yb[4]; float w0, w1; int row, s; bool ok; };
template <int MODE>
__device__ __forceinline__ void norm_row_load(Frame& F, const Inputs& I, int rr, int nrows, NormRow& R) {
    R.ok = rr < nrows; const int row = R.ok ? rr % NT : NCX; R.row = row; R.s = row_seq(row);
    if (MODE == 2 && row < NCX) R.ok = false;
    const bf16* xs = (const bf16*)(F.ws + WS_XS);
    if (MODE == 0) { const GAS f32x4* xin = (row < NCX) ? (const GAS f32x4*)(I.ctx + (size_t)row * D) + F.lane : (const GAS f32x4*)(I.x + (size_t)(row - NCX) * D) + F.lane;
#pragma unroll
        for (int j = 0; j < 4; ++j) R.v[j] = xin[64 * j]; }
    else { const GAS v2u* xin = (const GAS v2u*)(xs + (size_t)row * D) + F.lane;
#pragma unroll
        for (int j = 0; j < 4; ++j) R.xb[j] = xin[64 * j]; }
    if (MODE != 0) {
        const int* route = (const int*)(F.ws + WS_ROUTE); const bf16* ys = (const bf16*)(F.ws + WS_YS);
        const int d0 = route[row * 8 + 6], d1 = route[row * 8 + 7];
        R.w0 = __builtin_bit_cast(float, route[row * 8 + 4]); R.w1 = __builtin_bit_cast(float, route[row * 8 + 5]);
        const GAS v2u* y0 = (const GAS v2u*)(ys + (size_t)d0 * D) + F.lane; const GAS v2u* y1 = (const GAS v2u*)(ys + (size_t)d1 * D) + F.lane;
#pragma unroll
        for (int j = 0; j < 4; ++j) { R.ya[j] = y0[64 * j]; R.yb[j] = y1[64 * j]; }
    }
}
template <int MODE>
__device__ __forceinline__ void norm_row_finish(Frame& F, const Inputs& I, int l, float* out, NormRow& R) {
    if (!R.ok) return;
    bf16* xs = (bf16*)(F.ws + WS_XS); const float* mod = (const float*)(F.ws + WS_MOD); bf16* h1 = (bf16*)(F.ws + WS_H1);
    const int row = R.row, s = R.s;
    if (MODE != 0) {
        GAS v2u* xr = (GAS v2u*)(xs + (size_t)row * D) + F.lane;
        const GAS f32x4* g2 = (const GAS f32x4*)(mod + (size_t)((l - 1) * 9 + s) * 6144 + 5120) + F.lane;
#pragma unroll
        for (int j = 0; j < 4; ++j) { const v2u ua = R.ya[j], ub = R.yb[j]; const f32x4 g = g2[64 * j];
            const f32x4 a = {bflo(ua.x), bfhi(ua.x), bflo(ua.y), bfhi(ua.y)}, b = {bflo(ub.x), bfhi(ub.x), bflo(ub.y), bfhi(ub.y)};
            const v2u ux = R.xb[j]; const f32x4 x0 = {bflo(ux.x), bfhi(ux.x), bflo(ux.y), bfhi(ux.y)};
            R.v[j] = x0 + g * (a * R.w0 + b * R.w1);
            if (MODE == 1) { v2u w; w.x = pk2(R.v[j].x, R.v[j].y); w.y = pk2(R.v[j].z, R.v[j].w); xr[64 * j] = w;
                R.v[j] = (f32x4){bflo(w.x), bfhi(w.x), bflo(w.y), bfhi(w.y)}; } }
    }
    float ss = 0.f;
#pragma unroll
    for (int j = 0; j < 4; ++j) ss += (R.v[j].x * R.v[j].x + R.v[j].y * R.v[j].y) + (R.v[j].z * R.v[j].z + R.v[j].w * R.v[j].w);
    const float rstd = __builtin_amdgcn_rsqf(wave_sum(ss) * (1.f / D) + NORM_EPS);
    if (MODE == 2) {
        GAS f32x4* o = (GAS f32x4*)(out + (size_t)(row - NCX) * D) + F.lane;
        const GAS f32x4* fg = (const GAS f32x4*)I.final_g + F.lane;
#pragma unroll
        for (int j = 0; j < 4; ++j) o[64 * j] = R.v[j] * rstd * fg[64 * j];
    } else {
        const GAS f32x4* ng = (const GAS f32x4*)(I.norm1_g + l * D) + F.lane;
        const GAS f32x4* sh = (const GAS f32x4*)(mod + (size_t)(l * 9 + s) * 6144) + F.lane;
        const GAS f32x4* sc = (const GAS f32x4*)(mod + (size_t)(l * 9 + s) * 6144 + 1024) + F.lane;
        GAS v2u* o = (GAS v2u*)(h1 + (size_t)row * D) + F.lane;
#pragma unroll
        for (int j = 0; j < 4; ++j) { const f32x4 y = (R.v[j] * rstd * ng[64 * j]) * (sc[64 * j] + 1.0f) + sh[64 * j];
            v2u w; w.x = pk2(y.x, y.y); w.y = pk2(y.z, y.w); o[64 * j] = w; }
    }
}
struct NParams { f32x4 g2[4], ng[4], sh[4], sc[4]; };
struct NRec { int d0, d1; float w0, w1; };
struct NRow { f32x4 v[4]; v2u xb[4], ya[4], yb[4]; float w0, w1; };
template <int MODE>
__device__ __forceinline__ void np_load(Frame& F, const Inputs& I, int l, int s, NParams& P) {
    const float* mod = (const float*)(F.ws + WS_MOD);
    if (MODE != 0) { const GAS f32x4* g2 = (const GAS f32x4*)(mod + (size_t)((l - 1) * 9 + s) * 6144 + 5120) + F.lane;
#pragma unroll
        for (int j = 0; j < 4; ++j) P.g2[j] = g2[64 * j]; }
    if (MODE == 2) { const GAS f32x4* fg = (const GAS f32x4*)I.final_g + F.lane;
#pragma unroll
        for (int j = 0; j < 4; ++j) P.ng[j] = fg[64 * j]; }
    else { const GAS f32x4* ng = (const GAS f32x4*)(I.norm1_g + l * D) + F.lane;
        const GAS f32x4* sh = (const GAS f32x4*)(mod + (size_t)(l * 9 + s) * 6144) + F.lane; const GAS f32x4* sc = (const GAS f32x4*)(mod + (size_t)(l * 9 + s) * 6144 + 1024) + F.lane;
#pragma unroll
        for (int j = 0; j < 4; ++j) { P.ng[j] = ng[64 * j]; P.sh[j] = sh[64 * j]; P.sc[j] = sc[64 * j]; } }
}
__device__ __forceinline__ void nrec_load(Frame& F, int row, NRec& R) {
    const GAS int* rp = (const GAS int*)(F.ws + WS_ROUTE) + (size_t)row * 8;
    R.d0 = rp[6]; R.d1 = rp[7]; R.w0 = __builtin_bit_cast(float, rp[4]); R.w1 = __builtin_bit_cast(float, rp[5]);
}
template <int MODE>
__device__ __forceinline__ void nrow_load(Frame& F, const Inputs& I, int row, const NRec& rec, NRow& R) {
    if (MODE == 0) { const GAS f32x4* xin = (row < NCX) ? (const GAS f32x4*)(I.ctx + (size_t)row * D) + F.lane : (const GAS f32x4*)(I.x + (size_t)(row - NCX) * D) + F.lane;
#pragma unroll
        for (int j = 0; j < 4; ++j) R.v[j] = xin[64 * j]; }
    else { const bf16* xs = (const bf16*)(F.ws + WS_XS); const bf16* ys = (const bf16*)(F.ws + WS_YS);
        const GAS v2u* xin = (const GAS v2u*)(xs + (size_t)row * D) + F.lane;
        const GAS v2u* y0 = (const GAS v2u*)(ys + (size_t)rec.d0 * D) + F.lane; const GAS v2u* y1 = (const GAS v2u*)(ys + (size_t)rec.d1 * D) + F.lane;
#pragma unroll
        for (int j = 0; j < 4; ++j) { R.xb[j] = xin[64 * j]; R.ya[j] = y0[64 * j]; R.yb[j] = y1[64 * j]; }
        R.w0 = rec.w0; R.w1 = rec.w1; }
}
template <int MODE>
__device__ __forceinline__ void nrow_finish(Frame& F, float* out, int row, NRow& R, const NParams& P) {
    bf16* xs = (bf16*)(F.ws + WS_XS); bf16* h1 = (bf16*)(F.ws + WS_H1);
    if (MODE != 0) {
        GAS v2u* xr = (GAS v2u*)(xs + (size_t)row * D) + F.lane;
#pragma unroll
        for (int j = 0; j < 4; ++j) { const v2u ua = R.ya[j], ub = R.yb[j];
            const f32x4 a = {bflo(ua.x), bfhi(ua.x), bflo(ua.y), bfhi(ua.y)}, b = {bflo(ub.x), bfhi(ub.x), bflo(ub.y), bfhi(ub.y)};
            const v2u ux = R.xb[j]; const f32x4 x0 = {bflo(ux.x), bfhi(ux.x), bflo(ux.y), bfhi(ux.y)};
            R.v[j] = x0 + P.g2[j] * (a * R.w0 + b * R.w1);
            if (MODE == 1) { v2u w; w.x = pk2(R.v[j].x, R.v[j].y); w.y = pk2(R.v[j].z, R.v[j].w); xr[64 * j] = w;
                R.v[j] = (f32x4){bflo(w.x), bfhi(w.x), bflo(w.y), bfhi(w.y)}; } }
    }
    float ss = 0.f;
#pragma unroll
    for (int j = 0; j < 4; ++j) ss += (R.v[j].x * R.v[j].x + R.v[j].y * R.v[j].y) + (R.v[j].z * R.v[j].z + R.v[j].w * R.v[j].w);
    const float rstd = __builtin_amdgcn_rsqf(wave_sum(ss) * (1.f / D) + NORM_EPS);
    if (MODE == 2) { GAS f32x4* o = (GAS f32x4*)(out + (size_t)(row - NCX) * D) + F.lane;
#pragma unroll
        for (int j = 0; j < 4; ++j) o[64 * j] = R.v[j] * rstd * P.ng[j];
    } else { GAS v2u* o = (GAS v2u*)(h1 + (size_t)row * D) + F.lane;
#pragma unroll
        for (int j = 0; j < 4; ++j) { const f32x4 y = (R.v[j] * rstd * P.ng[j]) * (P.sc[j] + 1.0f) + P.sh[j];
            v2u w; w.x = pk2(y.x, y.y); w.y = pk2(y.z, y.w); o[64 * j] = w; }
    }
}
template <int MODE>
__device__ __forceinline__ void p_norm1_blk(Frame& F, const Inputs& I, int l, float* out) {
    constexpr int RPW = (MODE == 2) ? NXR / 2048 : NT / 2048;
    static_assert(NXR % 2048 == 0 && NT % 2048 == 0, "row blocks");
    const int r0 = ((MODE == 2) ? NCX : 0) + F.gw * RPW;
    int cur_s = row_seq(r0); NParams P; np_load<MODE>(F, I, l, cur_s, P);
    NRec rc0, rc1; NRow A, B;
#define NROWC(k_) (r0 + (((k_) < RPW) ? (k_) : RPW - 1))
#define NFIN(k_, R_) do { const int row_ = r0 + (k_); const int s_ = row_seq(row_); if (s_ != cur_s) { cur_s = s_; np_load<MODE>(F, I, l, cur_s, P); } nrow_finish<MODE>(F, out, row_, R_, P); } while (0)
    if (MODE != 0) { nrec_load(F, NROWC(0), rc0); nrec_load(F, NROWC(1), rc1); }
    nrow_load<MODE>(F, I, NROWC(0), rc0, A);
#pragma unroll 1
    for (int k = 0; k < RPW; k += 2) {
        if (MODE != 0) nrec_load(F, NROWC(k + 2), rc0);
        nrow_load<MODE>(F, I, NROWC(k + 1), rc1, B);
        NFIN(k, A);
        if (MODE != 0) nrec_load(F, NROWC(k + 3), rc1);
        nrow_load<MODE>(F, I, NROWC(k + 2), rc0, A);
        if (k + 1 < RPW) NFIN(k + 1, B);
    }
#undef NROWC
#undef NFIN
}
template <int MODE>
__device__ __forceinline__ void p_norm1(Frame& F, const Inputs& I, int l, float* out, int reps = 1) {
    if (F.G == 256 && reps == 1) { p_norm1_blk<MODE>(F, I, l, out); return; }
    const int nrows = reps * NT;
    NormRow A, B;
    norm_row_load<MODE>(F, I, F.gw, nrows, A);
    for (int rr = F.gw; rr < nrows; rr += 2 * F.NGW) {
        norm_row_load<MODE>(F, I, rr + F.NGW, nrows, B);
        norm_row_finish<MODE>(F, I, l, out, A);
        norm_row_load<MODE>(F, I, rr + 2 * F.NGW, nrows, A);
        norm_row_finish<MODE>(F, I, l, out, B);
    }
}

template <int NN>
struct StaticOrderT {
    int nM, nwg, G, c, pm0;
    __device__ void init(int M, int  , int G_, int c_, int pm0_ = 0) { nM = M / 256; nwg = nM * NN; G = G_; c = c_; pm0 = pm0_; }
    __device__ bool next(int i, pg8::Unit& u) const {
        const int L = i * G + c; if (L >= nwg) return false;
        const int grp = L / (8 * NN), rem = L % (8 * NN);
        u.pm = pm0 + grp * 8 + (rem & 7); u.pn = rem >> 3; u.boff = 0; return true;
    }
};

constexpr float QSCALE = 0.125f * 1.4426950408889634f;
struct EpiZ {
    static constexpr bool PERM = true;
    bf16* O; int ldc; unsigned char* ws;
    __device__ __forceinline__ void operator()(const pg8::f32x4 (&acc)[2][2][4][2], const pg8::Unit& u, int wr, int wc, int fr, int fq) const {
        const int row0 = u.pm * 256 + wr * 64 + fr;
        if (u.pn >= 6) {
            const int col0 = u.pn * 256 + wc * 32 + 8 * fq;
#pragma unroll
            for (int ai = 0; ai < 2; ++ai)
#pragma unroll
                for (int m = 0; m < 4; ++m) { bf16* rowp = O + (size_t)(row0 + ai * 128 + m * 16) * ldc + col0;
#pragma unroll
                    for (int bj = 0; bj < 2; ++bj) { const pg8::f32x4 v0 = acc[ai][bj][m][0], v1 = acc[ai][bj][m][1];
                        v4u w; w.x = pg8::cvt_pk_bf16(v0[0], v0[1]); w.y = pg8::cvt_pk_bf16(v0[2], v0[3]); w.z = pg8::cvt_pk_bf16(v1[0], v1[1]); w.w = pg8::cvt_pk_bf16(v1[2], v1[3]);
                        *(v4u*)(rowp + bj * 128) = w; } }
            return;
        }
        const bool isctx = u.pm < (NCX / 256);
        const int b = isctx ? (u.pm * 256) / TC : (u.pm * 256 - NCX) / T;
        const int tb = isctx ? (u.pm * 256) % TC : (u.pm * 256 - NCX) % T;
        const int kind = u.pn >> 1;
        const float* rope = (const float*)(ws + WS_MOD) + MOD_ROPE;
        const int lane = fr + 16 * fq;
#pragma unroll
        for (int ai = 0; ai < 2; ++ai)
#pragma unroll
            for (int m = 0; m < 4; ++m) {
                const int t = tb + wr * 64 + fr + ai * 128 + m * 16;
#pragma unroll
                for (int bj = 0; bj < 2; ++bj) {
                    float v[8];
#pragma unroll
                    for (int n = 0; n < 2; ++n)
#pragma unroll
                        for (int e = 0; e < 4; ++e) v[4 * n + e] = acc[ai][bj][m][n][e];
                    if (kind == 2) {
                        const int h = 2 * (u.pn - 4) + bj, off = 32 * wc + 8 * fq;
                        v4u w; w.x = pg8::cvt_pk_bf16(v[0], v[1]); w.y = pg8::cvt_pk_bf16(v[2], v[3]); w.z = pg8::cvt_pk_bf16(v[4], v[5]); w.w = pg8::cvt_pk_bf16(v[6], v[7]);
                        *(v4u*)((bf16*)(ws + WS_VB) + ((size_t)(b * 4 + h) * TK + (isctx ? t : TC + t)) * 128 + off) = w;
                    } else {
                        const int hm = 4 * (u.pn & 1) + 2 * bj + (wc >> 1), o = 32 * (wc & 1) + 8 * fq;
                        if (!isctx) {
                            const int pos = (wc & 1) ? (t & 63) : (t >> 6);
                            const float* cs = rope + 2 * (pos * 16 + 8 * (fq & 1));
                            const bool second = fq >= 2;
#pragma unroll
                            for (int e = 0; e < 8; ++e) {
                                const auto sw = __builtin_amdgcn_permlane32_swap(__builtin_bit_cast(unsigned, v[e]), __builtin_bit_cast(unsigned, v[e]), false, false);
                                const float pv = __builtin_bit_cast(float, (lane < 32) ? sw[1] : sw[0]);
                                const float c = cs[2 * e], sn = cs[2 * e + 1];
                                v[e] = second ? (pv * sn + v[e] * c) : (v[e] * c - pv * sn);
                            }
                        }
                        if (kind == 0) {
#pragma unroll
                            for (int e = 0; e < 8; ++e) v[e] *= QSCALE; }
                        v4u w; w.x = pg8::cvt_pk_bf16(v[0], v[1]); w.y = pg8::cvt_pk_bf16(v[2], v[3]); w.z = pg8::cvt_pk_bf16(v[4], v[5]); w.w = pg8::cvt_pk_bf16(v[6], v[7]);
                        bf16* dst;
                        if (kind == 0) dst = isctx ? (bf16*)(ws + WS_QC) + ((size_t)(b * 8 + hm) * TC + t) * 64 + o : (bf16*)(ws + WS_QB) + ((size_t)(b * 8 + hm) * T + t) * 64 + o;
                        else dst = (bf16*)(ws + WS_KB) + ((size_t)(b * 8 + hm) * TK + (isctx ? t : TC + t)) * 64 + o;
                        *(v4u*)dst = w;
                    }
                }
            }
    }
};
struct EpiResid {
    static constexpr bool PERM = true; static constexpr bool NTB = false;
    bf16* X; const float* mod_g;
    const float* src_c; const float* src_x;
    __device__ __forceinline__ void operator()(const pg8::f32x4 (&acc)[2][2][4][2], const pg8::Unit& u, int wr, int wc, int fr, int fq) const {
        const int row0 = u.pm * 256 + wr * 64 + fr, col0 = u.pn * 256 + wc * 32 + 8 * fq;
        const int s = row_seq(u.pm * 256);
        pg8::f32x4 gv[2][2];
#pragma unroll
        for (int bj = 0; bj < 2; ++bj)
#pragma unroll
            for (int n = 0; n < 2; ++n) gv[bj][n] = *(const GAS pg8::f32x4*)(mod_g + (size_t)s * 6144 + col0 + bj * 128 + 4 * n);
#pragma unroll
        for (int ai = 0; ai < 2; ++ai)
#pragma unroll
            for (int m = 0; m < 4; ++m) { const int row = row0 + ai * 128 + m * 16; bf16* rowp = X + (size_t)row * D + col0;
#pragma unroll
                for (int bj = 0; bj < 2; ++bj) {
                    float r[8];
                    if (src_x) { const float* srcp = (row < NCX) ? src_c + (size_t)row * D + col0 : src_x + (size_t)(row - NCX) * D + col0;
                        const pg8::f32x4 a = *(const GAS pg8::f32x4*)(srcp + bj * 128), b = *(const GAS pg8::f32x4*)(srcp + bj * 128 + 4);
                        r[0] = a[0]; r[1] = a[1]; r[2] = a[2]; r[3] = a[3]; r[4] = b[0]; r[5] = b[1]; r[6] = b[2]; r[7] = b[3]; }
                    else { const v4u w = *(const GAS v4u*)(rowp + bj * 128); unpack8(w, r); }
#pragma unroll
                    for (int n = 0; n < 2; ++n)
#pragma unroll
                        for (int e = 0; e < 4; ++e) r[4 * n + e] += gv[bj][n][e] * acc[ai][bj][m][n][e];
                    v4u o; o.x = pg8::cvt_pk_bf16(r[0], r[1]); o.y = pg8::cvt_pk_bf16(r[2], r[3]); o.z = pg8::cvt_pk_bf16(r[4], r[5]); o.w = pg8::cvt_pk_bf16(r[6], r[7]);
                    *(GAS v4u*)(rowp + bj * 128) = o; } }
    }
};
struct EpiSwiGLU {
    static constexpr bool PERM = true;
    bf16* O;
    __device__ __forceinline__ void operator()(const pg8::f32x4 (&acc)[2][2][4][2], const pg8::Unit& u, int wr, int wc, int fr, int fq) const {
        const int row0 = u.pm * 256 + wr * 64 + fr, col0 = u.pn * 128 + wc * 32 + 8 * fq;
#pragma unroll
        for (int ai = 0; ai < 2; ++ai)
#pragma unroll
            for (int m = 0; m < 4; ++m) { bf16* rowp = O + (size_t)(row0 + ai * 128 + m * 16) * EH + col0;
                float a[8];
#pragma unroll
                for (int n = 0; n < 2; ++n)
#pragma unroll
                    for (int e = 0; e < 4; ++e) { const float g = acc[ai][0][m][n][e], up = acc[ai][1][m][n][e]; a[n * 4 + e] = siluf_(g) * up; }
                v4u w; w.x = pg8::cvt_pk_bf16(a[0], a[1]); w.y = pg8::cvt_pk_bf16(a[2], a[3]); w.z = pg8::cvt_pk_bf16(a[4], a[5]); w.w = pg8::cvt_pk_bf16(a[6], a[7]);
                *(v4u*)rowp = w; }
    }
};
struct EpiY16 {
    static constexpr bool PERM = true;
    bf16* O;
    __device__ __forceinline__ void operator()(const pg8::f32x4 (&acc)[2][2][4][2], const pg8::Unit& u, int wr, int wc, int fr, int fq) const {
        const int row0 = u.pm * 256 + wr * 64 + fr, col0 = u.pn * 256 + wc * 32 + 8 * fq;
#pragma unroll
        for (int ai = 0; ai < 2; ++ai)
#pragma unroll
            for (int m = 0; m < 4; ++m) { bf16* rowp = O + (size_t)(row0 + ai * 128 + m * 16) * D + col0;
#pragma unroll
                for (int bj = 0; bj < 2; ++bj) { const pg8::f32x4 v0 = acc[ai][bj][m][0], v1 = acc[ai][bj][m][1];
                    v4u w; w.x = pg8::cvt_pk_bf16(v0[0], v0[1]); w.y = pg8::cvt_pk_bf16(v0[2], v0[3]); w.z = pg8::cvt_pk_bf16(v1[0], v1[1]); w.w = pg8::cvt_pk_bf16(v1[2], v1[3]);
                    *(v4u*)(rowp + bj * 128) = w; } }
    }
};
struct EpiF32 {
    static constexpr bool PERM = false;
    float* C;
    __device__ __forceinline__ void operator()(const pg8::f32x4 (&acc)[2][2][4][2], const pg8::Unit& u, int wr, int wc, int fr, int fq) const {
        const int row0 = u.pm * 256 + wr * 64 + fr, col0 = u.pn * 256 + wc * 32 + 4 * fq;
#pragma unroll
        for (int ai = 0; ai < 2; ++ai)
#pragma unroll
            for (int m = 0; m < 4; ++m) { float* rowp = C + (size_t)(row0 + ai * 128 + m * 16) * D + col0;
#pragma unroll
                for (int bj = 0; bj < 2; ++bj)
#pragma unroll
                    for (int n = 0; n < 2; ++n) *(pg8::f32x4*)(rowp + bj * 128 + n * 16) = acc[ai][bj][m][n]; }
    }
};
struct MoeOrder {
    const volatile LAS int* blkend;
    int G, c; size_t wstride;
    __device__ bool next(int i, pg8::Unit& u) const {
        const int nblk = blkend[31];
        const long L = (long)i * G + c; if (L >= (long)nblk * 4) return false;
        const int rb = (int)(L >> 2); u.pm = rb; u.pn = (int)(L & 3);
        int e = 0;
#pragma unroll 1
        for (int k = 0; k < 31; ++k) e += (rb >= blkend[k]) ? 1 : 0;
        u.boff = (size_t)e * wstride; return true;
    }
};

__device__ __forceinline__ void p3_rope(Frame& F, int l) {
    const bf16* Z = (const bf16*)(F.ws + WS_Z);
    const float* rope = (const float*)(F.ws + WS_MOD) + MOD_ROPE;
    bf16* QB = (bf16*)(F.ws + WS_QB); bf16* QC = (bf16*)(F.ws + WS_QC); bf16* KB = (bf16*)(F.ws + WS_KB); bf16* VB = (bf16*)(F.ws + WS_VB);
    const int L = F.lane;
    const int hm = L >> 3, o = (L & 7) * 8;
    const int blk = o >> 5, p = o & 31;
    const int fi0 = p & 15; const bool second = p >= 16;
    for (int row = F.gw; row < NT; row += F.NGW) {
        const bf16* zr = Z + (size_t)row * NPAD;
        const v4u qw = *(const GAS v4u*)(zr + ZQ + 8 * L), kw = *(const GAS v4u*)(zr + ZK + 8 * L), vw = *(const GAS v4u*)(zr + ZV + 8 * L);
        if (row < NCX) {
            const int b = row >> 8, t = row & 255;
            { float qf[8]; unpack8(qw, qf); v4u qs; qs.x = pk2(qf[0] * QSCALE, qf[1] * QSCALE); qs.y = pk2(qf[2] * QSCALE, qf[3] * QSCALE); qs.z = pk2(qf[4] * QSCALE, qf[5] * QSCALE); qs.w = pk2(qf[6] * QSCALE, qf[7] * QSCALE);
              *(GAS v4u*)(QC + ((size_t)(b * 8 + hm) * TC + t) * 64 + o) = qs; }
            *(GAS v4u*)(KB + ((size_t)(b * 8 + hm) * TK + t) * 64 + o) = kw;
            *(GAS v4u*)(VB + ((size_t)(b * 4 + (L >> 4)) * TK + t) * 128 + (L & 15) * 8) = vw;
        } else {
            const int r2 = row - NCX, b = r2 >> 12, t = r2 & 4095;
            const int pos = blk ? (t & 63) : (t >> 6);
            float q[8], k[8], qp[8], kp[8];
            unpack8(qw, q); unpack8(kw, k);
#pragma unroll
            for (int e = 0; e < 8; ++e) { qp[e] = __builtin_bit_cast(float, __builtin_amdgcn_update_dpp(0, __builtin_bit_cast(int, q[e]), 0x4E, 0xF, 0xF, false)); kp[e] = __builtin_bit_cast(float, __builtin_amdgcn_update_dpp(0, __builtin_bit_cast(int, k[e]), 0x4E, 0xF, 0xF, false)); }
            float qo[8], ko[8];
#pragma unroll
            for (int e = 0; e < 8; ++e) { const float cs = rope[2 * (pos * 16 + fi0 + e)], sn = rope[2 * (pos * 16 + fi0 + e) + 1];
                qo[e] = second ? (qp[e] * sn + q[e] * cs) : (q[e] * cs - qp[e] * sn);
                ko[e] = second ? (kp[e] * sn + k[e] * cs) : (k[e] * cs - kp[e] * sn); }
#pragma unroll
            for (int e = 0; e < 8; ++e) qo[e] *= QSCALE;
            v4u qq, kk2; qq.x = pk2(qo[0], qo[1]); qq.y = pk2(qo[2], qo[3]); qq.z = pk2(qo[4], qo[5]); qq.w = pk2(qo[6], qo[7]);
            kk2.x = pk2(ko[0], ko[1]); kk2.y = pk2(ko[2], ko[3]); kk2.z = pk2(ko[4], ko[5]); kk2.w = pk2(ko[6], ko[7]);
            *(GAS v4u*)(QB + ((size_t)(b * 8 + hm) * T + t) * 64 + o) = qq;
            *(GAS v4u*)(KB + ((size_t)(b * 8 + hm) * TK + TC + t) * 64 + o) = kk2;
            *(GAS v4u*)(VB + ((size_t)(b * 4 + (L >> 4)) * TK + TC + t) * 128 + (L & 15) * 8) = vw;
        }
    }
}

__device__ __forceinline__ float zshift(const bf16* z0, const bf16* zm, const bf16* zp, bool hm_, bool hp_, int col, float mu) {
    const float a = bf2f(z0[col]); const float m = hm_ ? bf2f(zm[col]) : 0.f; const float p = hp_ ? bf2f(zp[col]) : 0.f;
    return a + mu * (0.5f * (m + p) - a);
}
__device__ __forceinline__ void ml_chunk_rows(int dir, int b, int cc, int& row0, int& t0, int& len) {
    if (cc < 2) { const int j = dir ? 1 - cc : cc; t0 = j * 128; len = TC; row0 = b * TC + t0; }
    else { const int j = dir ? 31 - (cc - 2) : (cc - 2); t0 = j * 128; len = T; row0 = NCX + b * T + t0; }
}
__device__ __forceinline__ float log_sigmoid_(float x) { return fminf(x, 0.f) - __logf(1.0f + __expf(-fabsf(x))); }
__device__ __forceinline__ void ml_gates(Frame& F, const Inputs& I, int l, int dir, int h, int row0, LAS float* gb, LAS float* gi) {
    const bf16* Z = (const bf16*)(F.ws + WS_Z);
    const float* gbias = I.ml_gate_b + l * 16;
    if (F.tid < 128) {
        const int s = F.tid, tau = dir ? 127 - s : s;
        const bf16* zr = Z + (size_t)(row0 + tau) * NPAD + ZML + 1024;
        gi[s] = bf2f(zr[dir * 8 + h]) + ((const GAS float*)gbias)[dir * 8 + h];
        gb[s] = log_sigmoid_(bf2f(zr[dir * 8 + 4 + h]) + ((const GAS float*)gbias)[dir * 8 + 4 + h]);
    }
    __syncthreads();
    if (F.wave == 0) {
        const float a = gb[2 * F.lane], c = gb[2 * F.lane + 1]; const float pr = a + c; float inc = pr;
#pragma unroll
        for (int o = 1; o < 64; o <<= 1) { const float n = __shfl_up(inc, o); if (F.lane >= o) inc += n; }
        const float ex = inc - pr; gb[2 * F.lane] = ex + a; gb[2 * F.lane + 1] = ex + pr;
    }
    __syncthreads();
}
__device__ __forceinline__ void ml_conv16(const bf16* Z, const Inputs& I, int l, int row, int t, int len, int colbase, float scale, float* outv) {
    const bf16* z0 = Z + (size_t)row * NPAD + ZML + colbase;
    const float* cw = I.ml_conv_w + (size_t)l * 3 * 512 + colbase; const float* cb = I.ml_conv_b + l * 512 + colbase;
    float a0[16], am[16], ap[16];
    { const v4u w0 = *(const GAS v4u*)z0, w1 = *(const GAS v4u*)(z0 + 8); unpack8(w0, a0); unpack8(w1, a0 + 8); }
    if (t > 0) { const v4u w0 = *(const GAS v4u*)(z0 - NPAD), w1 = *(const GAS v4u*)(z0 - NPAD + 8); unpack8(w0, am); unpack8(w1, am + 8); }
    else {
#pragma unroll
        for (int e = 0; e < 16; ++e) am[e] = 0.f; }
    if (t < len - 1) { const v4u w0 = *(const GAS v4u*)(z0 + NPAD), w1 = *(const GAS v4u*)(z0 + NPAD + 8); unpack8(w0, ap); unpack8(w1, ap + 8); }
    else {
#pragma unroll
        for (int e = 0; e < 16; ++e) ap[e] = 0.f; }
    float w0_[16], w1_[16], w2_[16], bb_[16];
#pragma unroll
    for (int q = 0; q < 4; ++q) { const f32x4 x0 = *(const GAS f32x4*)(cw + 4 * q), x1 = *(const GAS f32x4*)(cw + 512 + 4 * q), x2 = *(const GAS f32x4*)(cw + 1024 + 4 * q), x3 = *(const GAS f32x4*)(cb + 4 * q);
        w0_[4 * q] = x0.x; w0_[4 * q + 1] = x0.y; w0_[4 * q + 2] = x0.z; w0_[4 * q + 3] = x0.w; w1_[4 * q] = x1.x; w1_[4 * q + 1] = x1.y; w1_[4 * q + 2] = x1.z; w1_[4 * q + 3] = x1.w;
        w2_[4 * q] = x2.x; w2_[4 * q + 1] = x2.y; w2_[4 * q + 2] = x2.z; w2_[4 * q + 3] = x2.w; bb_[4 * q] = x3.x; bb_[4 * q + 1] = x3.y; bb_[4 * q + 2] = x3.z; bb_[4 * q + 3] = x3.w; }
#pragma unroll
    for (int e = 0; e < 16; ++e) { const float y = am[e] * w0_[e] + a0[e] * w1_[e] + ap[e] * w2_[e] + bb_[e]; outv[e] = siluf_(y) * scale; }
}
constexpr int MLS = 136;
constexpr int MLD = 72;
__device__ __forceinline__ bf16x8 lds_frag(const LAS bf16* p) { return *(const LAS bf16x8*)p; }


constexpr int RW_NCH = (TC + T) / 16;
constexpr int RWC_EL = 7424;
constexpr int RWC_PSI = 4096, RWC_RP = 5120, RWC_VT = 6144, RWC_OM = 7168;
constexpr int RWP_WAVE_LDS = 15744;
__device__ __forceinline__ bf16x8 frag16(const LAS bf16* base, int lr, int kg) {
    bf16x8 z = {0, 0, 0, 0, 0, 0, 0, 0};
    return (kg < 2) ? *(const LAS bf16x8*)(base + lr * 16 + kg * 8) : z;
}
#define WAVE_LDS_SYNC() asm volatile("s_waitcnt lgkmcnt(0)" ::: "memory")
__device__ __forceinline__ void rwkv_chunk_pre(Frame& F, const Inputs& I, int l, int reps) {
    const bf16* Z = (const bf16*)(F.ws + WS_Z);
    bf16* RWC = (bf16*)(F.ws + WS_RWC); float* RG = (float*)(F.ws + WS_RG); float* RBS = (float*)(F.ws + WS_RBS); float* RV = (float*)(F.ws + WS_RV);
    LAS unsigned char* wl = F.lds + F.wave * RWP_WAVE_LDS;
    LAS bf16* KH = (LAS bf16*)(wl); LAS bf16* RH = (LAS bf16*)(wl + 2304); LAS bf16* BC = (LAS bf16*)(wl + 4608); LAS bf16* KC = (LAS bf16*)(wl + 6912);
    LAS bf16* BTj = (LAS bf16*)(wl + 9216);
    LAS float* Aab = (LAS float*)(wl + 11264);
    LAS float* Bak = (LAS float*)(wl + 12352);
    LAS float* EC = (LAS float*)(wl + 13440);
    LAS bf16* VS = (LAS bf16*)(wl + 13696);
    LAS bf16* TT = KH; LAS bf16* AakT = KH + 256; LAS bf16* Bab = KH + 512; LAS bf16* Ws = KH + 768;
    LAS bf16* KHj = BC; LAS bf16* Pj = BC;
    const int L = F.lane, lr = L & 15, kg = L >> 4;
    const float* mu = I.rw_shift_mu + l * 960;
    for (int uu_ = F.gw; uu_ < reps * 64 * RW_NCH; uu_ += F.NGW) {
        const int u = uu_ % (64 * RW_NCH);
        const int chain = u / RW_NCH, ck = u % RW_NCH, dir = chain >> 5, b = (chain >> 2) & 7, h = chain & 3;
        const int c = h * 64 + L;
        int rowbase, tbase, len;
        if (ck < 16) { len = TC; tbase = dir ? TC - 1 - ck * 16 : ck * 16; rowbase = b * TC; }
        else { len = T; tbase = dir ? T - 1 - (ck - 16) * 16 : (ck - 16) * 16; rowbase = NCX + b * T; }
        const int tlo = dir ? tbase - 15 : tbase;
        const bf16* zb = Z + (size_t)(rowbase + tlo - 1) * NPAD + ZRW;
        const bool lo_ok = tlo > 0, hi_ok = tlo + 16 < len;
        const bf16* lora = (const bf16*)(F.ws + WS_LORA);
        if (dir == 0) {
            const float mug = ((const GAS float*)mu)[896 + L];
            float zg[18];
#pragma unroll
            for (int r = 0; r < 18; ++r) zg[r] = ((r == 0 && !lo_ok) || (r == 17 && !hi_ok)) ? 0.f : bf2f(zb[(size_t)r * NPAD + 896 + L]);
#pragma unroll
            for (int i = 0; i < 16; ++i) RH[i * 72 + L] = (bf16)f2bf(sigmoidf_(zg[i + 1] + mug * (0.5f * (zg[i] + zg[i + 2]) - zg[i + 1])));
            WAVE_LDS_SYNC();
            const bf16x8 ga0 = lds_frag(RH + lr * 72 + kg * 8), ga1 = lds_frag(RH + lr * 72 + 32 + kg * 8);
            WAVE_LDS_SYNC();
#pragma unroll
            for (int nt = 0; nt < 4; ++nt) { const bf16* gp = lora + LORA_G2T + ((size_t)(l * 256 + h * 64 + 16 * nt + lr)) * 64 + kg * 8;
                f32x4 acc = {0.f, 0.f, 0.f, 0.f};
                acc = __builtin_amdgcn_mfma_f32_16x16x32_bf16(ga0, *(const GAS bf16x8*)gp, acc, 0, 0, 0);
                acc = __builtin_amdgcn_mfma_f32_16x16x32_bf16(ga1, *(const GAS bf16x8*)(gp + 32), acc, 0, 0, 0);
#pragma unroll
                for (int r = 0; r < 4; ++r) RG[(size_t)(rowbase + tlo + 4 * kg + r) * 256 + h * 64 + 16 * nt + lr] = acc[r]; }
        }
        {
            const float w0c = ((const GAS float*)I.rw_w0)[(l * 2 + dir) * 256 + c], a0c = ((const GAS float*)I.rw_a0)[(l * 2 + dir) * 256 + c];
            const float kkc = ((const GAS float*)I.rw_k_k)[l * 256 + c], kac = ((const GAS float*)I.rw_k_a)[l * 256 + c], rkc = ((const GAS float*)I.rw_r_k)[l * 256 + c];
            const float mur = ((const GAS float*)mu)[c], muk = ((const GAS float*)mu)[256 + c], muv = ((const GAS float*)mu)[512 + c];
            const int lcol = (L < 32) ? (768 + dir * 32 + L) : (832 + dir * 32 + (L - 32));
            const float mul = ((const GAS float*)mu)[lcol];
            { float zr[18], zk[18], zv[18], zl[18];
#pragma unroll
              for (int r = 0; r < 18; ++r) { const bool ok = !((r == 0 && !lo_ok) || (r == 17 && !hi_ok)); const bf16* zp_ = zb + (size_t)r * NPAD;
                  zr[r] = ok ? bf2f(zp_[c]) : 0.f; zk[r] = ok ? bf2f(zp_[256 + c]) : 0.f; zv[r] = ok ? bf2f(zp_[512 + c]) : 0.f; zl[r] = ok ? bf2f(zp_[lcol]) : 0.f; }
#pragma unroll
              for (int i = 0; i < 16; ++i) {
                  const int s = dir ? 15 - i : i;
                  RH[s * 72 + L] = (bf16)f2bf(zr[i + 1] + mur * (0.5f * (zr[i] + zr[i + 2]) - zr[i + 1]));
                  KH[s * 72 + L] = (bf16)f2bf(zk[i + 1] + muk * (0.5f * (zk[i] + zk[i + 2]) - zk[i + 1]));
                  VS[s * 64 + L] = (bf16)f2bf(zv[i + 1] + muv * (0.5f * (zv[i] + zv[i + 2]) - zv[i + 1]));
                  const float lv = zl[i + 1] + mul * (0.5f * (zl[i] + zl[i + 2]) - zl[i + 1]);
                  BC[s * 72 + L] = (bf16)f2bf((L < 32) ? (1.0f - 2.0f * __builtin_amdgcn_rcpf(1.0f + __builtin_amdgcn_exp2f(2.8853900817779268f * lv))) : lv); } }
            WAVE_LDS_SYNC();
            { const bf16x8 fw_ = lds_frag(BC + lr * 72 + kg * 8), fa_ = lds_frag(BC + lr * 72 + 32 + kg * 8);
              WAVE_LDS_SYNC();
#pragma unroll
              for (int nt = 0; nt < 4; ++nt) { const size_t wrow = ((size_t)((l * 2 + dir) * 256 + h * 64 + 16 * nt + lr)) * 32 + kg * 8;
                  f32x4 aw_ = {0.f, 0.f, 0.f, 0.f}, aa_ = {0.f, 0.f, 0.f, 0.f};
                  aw_ = __builtin_amdgcn_mfma_f32_16x16x32_bf16(fw_, *(const GAS bf16x8*)(lora + wrow), aw_, 0, 0, 0);
                  aa_ = __builtin_amdgcn_mfma_f32_16x16x32_bf16(fa_, *(const GAS bf16x8*)(lora + LORA_A2T + wrow), aa_, 0, 0, 0);
#pragma unroll
                  for (int r = 0; r < 4; ++r) { KC[(4 * kg + r) * 72 + 16 * nt + lr] = (bf16)f2bf(aw_[r]); BC[(4 * kg + r) * 72 + 16 * nt + lr] = (bf16)f2bf(aa_[r]); } } }
            WAVE_LDS_SYNC();
            float E = 1.0f;
#pragma unroll 1
            for (int s = 0; s < 16; ++s) {
                const int i = dir ? 15 - s : s;
                const int row = rowbase + tlo + i;
                const float rr = bf2f(RH[s * 72 + L]), kq = bf2f(KH[s * 72 + L]), vv = bf2f(VS[s * 64 + L]);
                const float wp = w0c + bf2f(KC[s * 72 + L]), ap = a0c + bf2f(BC[s * 72 + L]);
                const float dec = __expf(-0.606531f * sigmoidf_(wp));
                const float a = sigmoidf_(ap);
                float kk = kq * kkc; const float nrm = __builtin_amdgcn_sqrtf(wave_sum(kk * kk)); kk = kk * __builtin_amdgcn_rcpf(fmaxf(nrm, 1e-12f));
                const float km = kq * (1.0f + (a - 1.0f) * kac);
                const float bb = kk * a;
                const float bsum = wave_sum(rr * rkc * km);
                if (L == 0) RBS[(size_t)row * 8 + dir * 4 + h] = bsum;
                if (dir == 0) RV[(size_t)row * 256 + c] = vv;
                const float Em1 = E; E *= dec; const float iE = __builtin_amdgcn_rcpf(E);
                KH[s * 72 + L] = (bf16)f2bf(kk * Em1); RH[s * 72 + L] = (bf16)f2bf(rr * E); BC[s * 72 + L] = (bf16)f2bf(bb * iE); KC[s * 72 + L] = (bf16)f2bf(km * iE);
            }
            EC[L] = E;
            WAVE_LDS_SYNC();
            { unsigned pb[8], pv[8];
#pragma unroll
              for (int q = 0; q < 8; ++q) { pb[q] = pk2(bf2f(BC[(2 * q) * 72 + L]) * E, bf2f(BC[(2 * q + 1) * 72 + L]) * E); pv[q] = (unsigned)VS[(2 * q) * 64 + L] | ((unsigned)VS[(2 * q + 1) * 64 + L] << 16); }
              *(LAS v4u*)(BTj + L * 16) = (v4u){pb[0], pb[1], pb[2], pb[3]}; *(LAS v4u*)(BTj + L * 16 + 8) = (v4u){pb[4], pb[5], pb[6], pb[7]};
              bf16* vt = RWC + (size_t)u * RWC_EL + RWC_VT + L * 16;
              *(GAS v4u*)vt = (v4u){pv[0], pv[1], pv[2], pv[3]}; *(GAS v4u*)(vt + 8) = (v4u){pv[4], pv[5], pv[6], pv[7]}; }
            WAVE_LDS_SYNC();
            f32x4 aab = {0.f, 0.f, 0.f, 0.f}, aak = aab, bab = aab, bak = aab;
            { bf16x8 fkh[2], frh[2], fbc[2], fkc[2];
#pragma unroll
              for (int ks = 0; ks < 2; ++ks) { fkh[ks] = lds_frag(KH + lr * 72 + ks * 32 + kg * 8); frh[ks] = lds_frag(RH + lr * 72 + ks * 32 + kg * 8); fbc[ks] = lds_frag(BC + lr * 72 + ks * 32 + kg * 8); fkc[ks] = lds_frag(KC + lr * 72 + ks * 32 + kg * 8); }
#pragma unroll
              for (int ks = 0; ks < 2; ++ks) { aab = __builtin_amdgcn_mfma_f32_16x16x32_bf16(fkh[ks], fbc[ks], aab, 0, 0, 0); aak = __builtin_amdgcn_mfma_f32_16x16x32_bf16(fkh[ks], fkc[ks], aak, 0, 0, 0);
                  bab = __builtin_amdgcn_mfma_f32_16x16x32_bf16(frh[ks], fbc[ks], bab, 0, 0, 0); bak = __builtin_amdgcn_mfma_f32_16x16x32_bf16(frh[ks], fkc[ks], bak, 0, 0, 0); } }
#pragma unroll
            for (int r = 0; r < 4; ++r) { const int t = 4 * kg + r; const bool st = lr < t, le = lr <= t;
                aab[r] = st ? aab[r] : 0.f; aak[r] = st ? aak[r] : 0.f; bab[r] = le ? bab[r] : 0.f; bak[r] = le ? bak[r] : 0.f;
                Aab[t * 17 + lr] = aab[r]; Bak[t * 17 + lr] = bak[r]; }
            { unsigned pk_[8];
#pragma unroll
              for (int s = 0; s < 16; ++s) KC[s * 72 + L] = (bf16)f2bf(bf2f(KC[s * 72 + L]) * E);
#pragma unroll
              for (int q = 0; q < 8; ++q) pk_[q] = (unsigned)KH[(2 * q) * 72 + L] | ((unsigned)KH[(2 * q + 1) * 72 + L] << 16);
              WAVE_LDS_SYNC();
              *(LAS v4u*)(KHj + L * 16) = (v4u){pk_[0], pk_[1], pk_[2], pk_[3]}; *(LAS v4u*)(KHj + L * 16 + 8) = (v4u){pk_[4], pk_[5], pk_[6], pk_[7]}; }
            { v2u w; w.x = pk2(aak[0], aak[1]); w.y = pk2(aak[2], aak[3]); *(LAS v2u*)(AakT + lr * 16 + 4 * kg) = w;
#pragma unroll
              for (int r = 0; r < 4; ++r) Bab[(4 * kg + r) * 16 + lr] = (bf16)f2bf(bab[r]); }
            WAVE_LDS_SYNC();
            { float Tc[16];
#pragma unroll
              for (int s = 15; s >= 0; --s) { float acc = (s == lr) ? 1.f : 0.f;
#pragma unroll
                  for (int uu = s + 1; uu < 16; ++uu) acc -= Aab[uu * 17 + s] * Tc[uu];
                  Tc[s] = acc; }
              if (kg == 0) { unsigned p[8];
#pragma unroll
                  for (int q = 0; q < 8; ++q) p[q] = pk2(Tc[2 * q], Tc[2 * q + 1]);
                  *(LAS v4u*)(TT + lr * 16) = (v4u){p[0], p[1], p[2], p[3]}; *(LAS v4u*)(TT + lr * 16 + 8) = (v4u){p[4], p[5], p[6], p[7]}; } }
            WAVE_LDS_SYNC();
            { const bf16x8 ftt = frag16(TT, lr, kg);
              bf16x8 fk[4];
#pragma unroll
              for (int mt = 0; mt < 4; ++mt) fk[mt] = frag16(KHj + mt * 256, lr, kg);
              const bf16x8 fa = frag16(AakT, lr, kg);
              WAVE_LDS_SYNC();
              f32x4 pa[4];
#pragma unroll
              for (int mt = 0; mt < 4; ++mt) { pa[mt] = (f32x4){0.f, 0.f, 0.f, 0.f}; pa[mt] = __builtin_amdgcn_mfma_f32_16x16x32_bf16(fk[mt], ftt, pa[mt], 0, 0, 0); }
              f32x4 wa = {0.f, 0.f, 0.f, 0.f}; wa = __builtin_amdgcn_mfma_f32_16x16x32_bf16(fa, ftt, wa, 0, 0, 0);
#pragma unroll
              for (int mt = 0; mt < 4; ++mt)
#pragma unroll
                  for (int r = 0; r < 4; ++r) Pj[(16 * mt + 4 * kg + r) * 16 + lr] = (bf16)f2bf(pa[mt][r]);
#pragma unroll
              for (int r = 0; r < 4; ++r) Ws[(4 * kg + r) * 16 + lr] = (bf16)f2bf(wa[r]); }
            WAVE_LDS_SYNC();
            { bf16* rec = RWC + (size_t)u * RWC_EL;
              bf16x8 fp[4], fb[4];
#pragma unroll
              for (int q = 0; q < 4; ++q) { fp[q] = frag16(Pj + q * 256, lr, kg); fb[q] = frag16(BTj + q * 256, lr, kg); }
              const bf16x8 fw = frag16(Ws, lr, kg), fbab = frag16(Bab, lr, kg);
#pragma unroll
              for (int mt = 0; mt < 4; ++mt)
#pragma unroll
                  for (int nt = 0; nt < 4; ++nt) { f32x4 acc = {0.f, 0.f, 0.f, 0.f}; acc = __builtin_amdgcn_mfma_f32_16x16x32_bf16(fp[mt], fb[nt], acc, 0, 0, 0);
                      float o[4];
#pragma unroll
                      for (int r = 0; r < 4; ++r) o[r] = ((mt == nt) && (4 * kg + r == lr) ? EC[16 * nt + lr] : 0.f) - acc[r];
                      v2u w; w.x = pk2(o[0], o[1]); w.y = pk2(o[2], o[3]); *(GAS v2u*)(rec + (16 * nt + lr) * 64 + 16 * mt + 4 * kg) = w; }
#pragma unroll
              for (int nt = 0; nt < 4; ++nt) { f32x4 acc = {0.f, 0.f, 0.f, 0.f}; acc = __builtin_amdgcn_mfma_f32_16x16x32_bf16(fw, fb[nt], acc, 0, 0, 0);
                  float o[4];
#pragma unroll
                  for (int r = 0; r < 4; ++r) o[r] = bf2f(KC[(4 * kg + r) * 72 + 16 * nt + lr]) - acc[r];
                  v2u w; w.x = pk2(o[0], o[1]); w.y = pk2(o[2], o[3]); *(GAS v2u*)(rec + RWC_PSI + (16 * nt + lr) * 16 + 4 * kg) = w; }
#pragma unroll
              for (int mt = 0; mt < 4; ++mt) { f32x4 acc = {0.f, 0.f, 0.f, 0.f}; acc = __builtin_amdgcn_mfma_f32_16x16x32_bf16(fp[mt], fbab, acc, 0, 0, 0);
                  float o[4];
#pragma unroll
                  for (int r = 0; r < 4; ++r) o[r] = bf2f(RH[lr * 72 + 16 * mt + 4 * kg + r]) - acc[r];
                  v2u w; w.x = pk2(o[0], o[1]); w.y = pk2(o[2], o[3]); *(GAS v2u*)(rec + RWC_RP + lr * 64 + 16 * mt + 4 * kg) = w; }
              { f32x4 acc = {0.f, 0.f, 0.f, 0.f}; acc = __builtin_amdgcn_mfma_f32_16x16x32_bf16(fw, fbab, acc, 0, 0, 0);
                  float o[4];
#pragma unroll
                  for (int r = 0; r < 4; ++r) o[r] = Bak[lr * 17 + 4 * kg + r] - acc[r];
                  v2u w; w.x = pk2(o[0], o[1]); w.y = pk2(o[2], o[3]); *(GAS v2u*)(rec + RWC_OM + lr * 16 + 4 * kg) = w; } }
            WAVE_LDS_SYNC();
        }
    }
}

__device__ __forceinline__ void p3_mlstate(Frame& F, const Inputs& I, int l) {
    const bf16* Z = (const bf16*)(F.ws + WS_Z);
    float* DC = (float*)(F.ws + WS_DC); float* DN = (float*)(F.ws + WS_DN); float* BT = DN + 64 * 34 * 64;
    LAS bf16* KT = (LAS bf16*)(F.lds);
    LAS bf16* VT = (LAS bf16*)(F.lds + 64 * MLS * 2);
    LAS float* gb = (LAS float*)(F.lds + 2 * 64 * MLS * 2);
    LAS float* gi = gb + 128;
    LAS float* sc = gi + 128;
    for (int u = F.vcu; u < 64 * 34; u += F.G) {
        const int chain = u / 34, cc = u % 34, dir = chain >> 5, b = (chain >> 2) & 7, h = chain & 3;
        int row0, t0, len; ml_chunk_rows(dir, b, cc, row0, t0, len);
        __syncthreads();
        ml_gates(F, I, l, dir, h, row0, gb, gi);
        if (F.tid < 128) sc[F.tid] = __expf(gb[127] - gb[F.tid] + gi[F.tid]);
        __syncthreads();
        { const int s = F.tid & 127, dg = F.tid >> 7, tau = dir ? 127 - s : s; const int row = row0 + tau, t = t0 + tau;
          float kv[16]; ml_conv16(Z, I, l, row, t, len, 256 + h * 64 + dg * 16, 0.125f, kv);
          const bf16* zv = Z + (size_t)row * NPAD + ZML + 512 + h * 64 + dg * 16;
          float vv[16]; { const v4u w0 = *(const GAS v4u*)zv, w1 = *(const GAS v4u*)(zv + 8); unpack8(w0, vv); unpack8(w1, vv + 8); }
          const float scs = sc[s];
#pragma unroll
          for (int e = 0; e < 16; ++e) { KT[(dg * 16 + e) * MLS + s] = (bf16)f2bf(kv[e]); VT[(dg * 16 + e) * MLS + s] = (bf16)f2bf(vv[e] * scs); } }
        __syncthreads();
        { const int te = F.wave >> 1, td0 = (F.wave & 1) * 2; const int lr = F.lane & 15, kg = F.lane >> 4;
          f32x4 acc[2] = {(f32x4){0.f, 0.f, 0.f, 0.f}, (f32x4){0.f, 0.f, 0.f, 0.f}};
#pragma unroll
          for (int ks = 0; ks < 4; ++ks) { const bf16x8 a = lds_frag(VT + (te * 16 + lr) * MLS + ks * 32 + kg * 8);
#pragma unroll
              for (int j = 0; j < 2; ++j) { const bf16x8 bb = lds_frag(KT + ((td0 + j) * 16 + lr) * MLS + ks * 32 + kg * 8);
                  acc[j] = __builtin_amdgcn_mfma_f32_16x16x32_bf16(a, bb, acc[j], 0, 0, 0); } }
          float* dc = DC + ((size_t)chain * 34 + cc) * 4096;
#pragma unroll
          for (int j = 0; j < 2; ++j)
#pragma unroll
              for (int r = 0; r < 4; ++r) dc[(te * 16 + 4 * kg + r) * 64 + (td0 + j) * 16 + lr] = acc[j][r]; }
        if (F.tid < 64) { float a = 0.f; for (int s = 0; s < 128; ++s) a += bf2f(KT[F.tid * MLS + s]) * sc[s]; DN[((size_t)chain * 34 + cc) * 64 + F.tid] = a; }
        if (F.tid == 0) BT[chain * 34 + cc] = gb[127];
    }
    __syncthreads();
}


__device__ __forceinline__ void cv_load(const float* W, int idx, int lane, float (&tv)[32]) {
    const GAS float* w_ = (const GAS float*)W + (size_t)(64 * (idx >> 5) + (lane >> 5)) * 1024 + 32 * (idx & 31) + (lane & 31);
#pragma unroll
    for (int i = 0; i < 32; ++i) tv[i] = w_[(size_t)(2 * i) * 1024];
}
__device__ __forceinline__ void cv_fin(bf16* WT, int K, bool rmap, LAS float* scr, int idx, int lane, const float (&tv)[32]) {
    const int k0 = 64 * (idx >> 5), n0 = 32 * (idx & 31);
#pragma unroll
    for (int i = 0; i < 32; ++i) scr[(2 * i + (lane >> 5)) * 33 + (lane & 31)] = tv[i];
    asm volatile("s_waitcnt lgkmcnt(0)" ::: "memory");
    const int c = lane & 7;
#pragma unroll
    for (int j = 0; j < 4; ++j) { const int n = (lane >> 3) + 8 * j; const LAS float* s_ = scr + (8 * c) * 33 + n;
        v4u o; o.x = pk2(s_[0 * 33], s_[1 * 33]); o.y = pk2(s_[2 * 33], s_[3 * 33]); o.z = pk2(s_[4 * 33], s_[5 * 33]); o.w = pk2(s_[6 * 33], s_[7 * 33]);
        int nn = n0 + n;
        if (rmap) nn = (nn < 512) ? ((nn >> 7) * 256 + (nn & 127)) : ((((nn - 512) >> 7) * 256) + 128 + ((nn - 512) & 127));
        *(GAS v4u*)(WT + (size_t)nn * K + k0 + 8 * c) = o; }
    asm volatile("s_waitcnt lgkmcnt(0)" ::: "memory");
}
constexpr int CONV_PER_CHAIN = 24576 / 64, CONV_PER_WAVE = CONV_PER_CHAIN / 8;
#define LDS_BARRIER() asm volatile("s_waitcnt lgkmcnt(0)\n\ts_barrier" ::: "memory")
template <bool CONV>
__device__ __forceinline__ void rwkv_seq(Frame& F, int chain, const float* cgu, const float* cdn, int convL) {
    const int dir = chain >> 5, b = (chain >> 2) & 7, h = chain & 3;
    const bf16* RWC = (const bf16*)(F.ws + WS_RWC) + (size_t)chain * RW_NCH * RWC_EL;
    float* RYS = (float*)(F.ws + WS_RYS);
    constexpr int CBUF = 16128;
    LAS unsigned char* cb0 = F.lds; LAS bf16* Sb = (LAS bf16*)(F.lds + 2 * CBUF);
    const int w = F.wave, mt = w >> 1, nt0 = (w & 1) * 2, lr = F.lane & 15, kg = F.lane >> 4;
    auto lds_off = [](int q) -> int { const int e = q * 8;
        if (e < 4096) return ((e >> 6) * 72 + (e & 63)) * 2;
        if (e < 5120) return 9216 + (e - 4096) * 2;
        if (e < 6144) { const int e2 = e - 5120; return 11264 + ((e2 >> 6) * 72 + (e2 & 63)) * 2; }
        if (e < 7168) return 13568 + (e - 6144) * 2;
        return 15616 + (e - 7168) * 2; };
    const int q0 = F.tid, q1 = F.tid + 512; const bool has1 = q1 < RWC_EL / 8;
    const int o0 = lds_off(q0), o1 = lds_off(has1 ? q1 : q0), q1c = has1 ? q1 : q0;
    v4u r0[8], r1[8];
    f32x4 S[2] = {(f32x4){0.f, 0.f, 0.f, 0.f}, (f32x4){0.f, 0.f, 0.f, 0.f}};
    __syncthreads();
    { const v4u a0 = *(const GAS v4u*)(RWC + q0 * 8); const v4u a1 = *(const GAS v4u*)(RWC + q1c * 8);
      *(LAS v4u*)(cb0 + o0) = a0; if (has1) *(LAS v4u*)(cb0 + o1) = a1; }
#pragma unroll
    for (int r = 1; r <= 8; ++r) { const bf16* nx = RWC + (size_t)r * RWC_EL; r0[r & 7] = *(const GAS v4u*)(nx + q0 * 8); r1[r & 7] = *(const GAS v4u*)(nx + q1c * 8); }
    LAS float* cscr = (LAS float*)(F.lds + 49152 + F.wave * 8448);
    float ta[32], tb[32]; int cvn = 0;
    bf16* aWT = nullptr; bf16* bWT = nullptr; int aK = D, bK = D, aidx = 0, bidx = 0; bool arm = true, brm = true, aon = false, bon = false;
#define CV_PICK(WT_, K_, IDX_, RM_, ON_, T_) do { ON_ = cvn < CONV_PER_WAVE; if (CONV) { const int it = chain * CONV_PER_CHAIN + ((cvn < CONV_PER_WAVE) ? cvn : CONV_PER_WAVE - 1) * 8 + F.wave; ++cvn; const float* cW;   \
        if (it < 16384) { const int le = convL * NEXP + (it >> 9); IDX_ = it & 511; cW = cgu + (size_t)le * D * 1024; WT_ = (bf16*)(F.ws + WS_WGU) + (size_t)le * 1024 * D; K_ = D; RM_ = true; }                  \
        else { const int i2 = it - 16384; const int le = convL * NEXP + (i2 >> 8); IDX_ = i2 & 255; cW = cdn + (size_t)le * EH * D; WT_ = (bf16*)(F.ws + WS_WDN) + (size_t)le * D * EH; K_ = EH; RM_ = false; } \
        cv_load(cW, IDX_, F.lane, T_); } } while (0)
#pragma unroll 1
    for (int ckb = 0; ckb < RW_NCH; ckb += 8) {
#pragma unroll
      for (int j = 0; j < 8; ++j) {
        const int ck = ckb + j;
        LAS unsigned char* cb = cb0 + (j & 1) * CBUF; LAS unsigned char* cbn = cb0 + ((j + 1) & 1) * CBUF;
#pragma unroll
        for (int jj = 0; jj < 2; ++jj)
#pragma unroll
            for (int r = 0; r < 4; ++r) Sb[(16 * mt + 4 * kg + r) * 72 + 16 * (nt0 + jj) + lr] = (bf16)f2bf(S[jj][r]);
        LDS_BARRIER();
        const LAS bf16* PhiT = (const LAS bf16*)cb; const LAS bf16* PsiT = (const LAS bf16*)(cb + 9216); const LAS bf16* RpT = (const LAS bf16*)(cb + 11264);
        const LAS bf16* VT = (const LAS bf16*)(cb + 13568); const LAS bf16* OmT = (const LAS bf16*)(cb + 15616);
        bf16x8 sA[2]; sA[0] = lds_frag(Sb + (16 * mt + lr) * 72 + kg * 8); sA[1] = lds_frag(Sb + (16 * mt + lr) * 72 + 32 + kg * 8);
        const bf16x8 vA = frag16(VT + mt * 256, lr, kg);
#pragma unroll
        for (int jj = 0; jj < 2; ++jj) { const int nt = nt0 + jj; f32x4 acc = {0.f, 0.f, 0.f, 0.f};
            acc = __builtin_amdgcn_mfma_f32_16x16x32_bf16(sA[0], lds_frag(PhiT + (16 * nt + lr) * 72 + kg * 8), acc, 0, 0, 0);
            acc = __builtin_amdgcn_mfma_f32_16x16x32_bf16(sA[1], lds_frag(PhiT + (16 * nt + lr) * 72 + 32 + kg * 8), acc, 0, 0, 0);
            acc = __builtin_amdgcn_mfma_f32_16x16x32_bf16(vA, frag16(PsiT + nt * 256, lr, kg), acc, 0, 0, 0);
            S[jj] = acc; }
        if ((w & 1) == 0) { f32x4 y = {0.f, 0.f, 0.f, 0.f};
            y = __builtin_amdgcn_mfma_f32_16x16x32_bf16(sA[0], lds_frag(RpT + lr * 72 + kg * 8), y, 0, 0, 0);
            y = __builtin_amdgcn_mfma_f32_16x16x32_bf16(sA[1], lds_frag(RpT + lr * 72 + 32 + kg * 8), y, 0, 0, 0);
            y = __builtin_amdgcn_mfma_f32_16x16x32_bf16(vA, frag16(OmT, lr, kg), y, 0, 0, 0);
            const int stp = ck * 16 + lr; int row;
            if (stp < TC) { const int t = dir ? TC - 1 - stp : stp; row = b * TC + t; } else { const int s2 = stp - TC; const int t = dir ? T - 1 - s2 : s2; row = NCX + b * T + t; }
            *(GAS f32x4*)(RYS + ((size_t)dir * NT + row) * 256 + h * 64 + 16 * mt + 4 * kg) = y; }
        if (ck + 1 < RW_NCH) { *(LAS v4u*)(cbn + o0) = r0[(j + 1) & 7]; if (has1) *(LAS v4u*)(cbn + o1) = r1[(j + 1) & 7]; }
        { const int rn = (ck + 9 < RW_NCH) ? ck + 9 : RW_NCH - 1; const bf16* nx = RWC + (size_t)rn * RWC_EL; r0[(j + 1) & 7] = *(const GAS v4u*)(nx + q0 * 8); r1[(j + 1) & 7] = *(const GAS v4u*)(nx + q1c * 8); }
        if (CONV) {
        if (j == 1) { if (bon) cv_fin(bWT, bK, brm, cscr, bidx, F.lane, tb); bon = false; }
        if (j == 5) { if (aon) cv_fin(aWT, aK, arm, cscr, aidx, F.lane, ta); aon = false; }
        if (j == 0) CV_PICK(aWT, aK, aidx, arm, aon, ta);
        if (j == 4) CV_PICK(bWT, bK, bidx, brm, bon, tb); }
        LDS_BARRIER();
      }
    }
    if (CONV) { if (bon) cv_fin(bWT, bK, brm, cscr, bidx, F.lane, tb);
        if (aon) cv_fin(aWT, aK, arm, cscr, aidx, F.lane, ta); }
#undef CV_PICK
}
__device__ __forceinline__ void ml_prefix(Frame& F, int chain) {
    const float* DC = (const float*)(F.ws + WS_DC); const float* DN = (const float*)(F.ws + WS_DN); const float* BT = DN + 64 * 34 * 64;
    float* CS = (float*)(F.ws + WS_CS); float* NS = (float*)(F.ws + WS_NS);
    f32x4 c0 = (f32x4){0.f, 0.f, 0.f, 0.f}, c1 = c0; float n = 0.f;
    for (int cc = 0; cc < 34; ++cc) {
        const size_t base = ((size_t)chain * 34 + cc) * 4096;
        *(GAS f32x4*)(CS + base + F.tid * 8) = c0; *(GAS f32x4*)(CS + base + F.tid * 8 + 4) = c1;
        if (F.tid < 64) NS[((size_t)chain * 34 + cc) * 64 + F.tid] = n;
        const float dec = __expf(BT[chain * 34 + cc]);
        const f32x4 d0 = *(const GAS f32x4*)(DC + base + F.tid * 8), d1 = *(const GAS f32x4*)(DC + base + F.tid * 8 + 4);
        c0 = c0 * dec + d0; c1 = c1 * dec + d1;
        if (F.tid < 64) n = n * dec + DN[((size_t)chain * 34 + cc) * 64 + F.tid];
    }
}

namespace att {
constexpr int QBLK = 32, KVBLK = 64;
constexpr float SCALE = 0.125f;
constexpr float THR = 8.f;
constexpr int SHM_V = KVBLK * 128 * 2, SHM_K = KVBLK * 64 * 2;
#define KSWZ(row, colB) ((row) * 128 + ((colB) ^ (((((row) & 7) ^ ((((row) >> 3) & 1) << 2))) << 4)))
#define SBAR() __builtin_amdgcn_sched_barrier(0)
__device__ __forceinline__ int crow(int r, int hi) { return (r & 3) + 8 * (r >> 2) + 4 * hi; }
__device__ __forceinline__ unsigned cvtpk(float lo, float hi) { unsigned r; asm volatile("v_cvt_pk_bf16_f32 %0, %1, %2" : "=v"(r) : "v"(lo), "v"(hi)); return r; }
__device__ __forceinline__ void partialSM(f32x16& p0, f32x16& p1) {
#pragma unroll
  for (int r = 0; r < 16; ++r) p0[r] = __builtin_amdgcn_exp2f(p0[r]);
}
__device__ __forceinline__ void finishSM(f32x16& p0, f32x16& p1, float& l_reg, bf16x8& pa0, bf16x8& pa1, bf16x8& pa2, bf16x8& pa3) {
#pragma unroll
  for (int r = 0; r < 16; ++r) p1[r] = __builtin_amdgcn_exp2f(p1[r]);
  float ps = 0;
#pragma unroll
  for (int r = 0; r < 16; ++r) ps += p0[r];
#pragma unroll
  for (int r = 0; r < 16; ++r) ps += p1[r];
  { auto rr = __builtin_amdgcn_permlane32_swap(__float_as_uint(ps), __float_as_uint(ps), false, false);
    ps = __uint_as_float(rr[0]) + __uint_as_float(rr[1]); }
  l_reg += ps;
#define PK4(P, BASE, OUT) do { v4u w = {cvtpk(P[BASE + 0], P[BASE + 1]), cvtpk(P[BASE + 2], P[BASE + 3]), cvtpk(P[BASE + 4], P[BASE + 5]), cvtpk(P[BASE + 6], P[BASE + 7])}; \
    OUT = *reinterpret_cast<bf16x8*>(&w); } while (0)
  PK4(p0, 0, pa0); PK4(p0, 8, pa1); PK4(p1, 0, pa2); PK4(p1, 8, pa3);
#undef PK4
}
__device__ __forceinline__ void qkt(f32x16& p0, f32x16& p1, const LAS char* Ks, const bf16x8* qr, int r32, int hi) {
  p0 = f32x16{}; p1 = f32x16{};
#pragma unroll
  for (int d0 = 0; d0 < 4; ++d0) { const int cb = (d0 * 16 + hi * 8) * 2;
    const bf16x8 b0 = *(const LAS bf16x8*)(Ks + KSWZ(r32, cb));
    const bf16x8 b1 = *(const LAS bf16x8*)(Ks + KSWZ(32 + r32, cb));
    p0 = __builtin_amdgcn_mfma_f32_32x32x16_bf16(b0, qr[d0], p0, 0, 0, 0);
    p1 = __builtin_amdgcn_mfma_f32_32x32x16_bf16(b1, qr[d0], p1, 0, 0, 0); }
}
__device__ __forceinline__ int v_st(int k, int c) { const int kk = (k & ~0xC) | ((k & 4) << 1) | ((k & 8) >> 1); return ((kk >> 3) * 4 + (c >> 5)) * 512 + ((kk & 7) * 32 + (c & 31)) * 2; }
__device__ __forceinline__ int v_rd_base(int lane) { return ((lane & 3) << 3) | (((lane >> 2) & 3) << 6) | (((lane >> 4) & 1) << 5) | (((lane >> 5) & 1) << 8); }
constexpr int v_rd_off(int d0, int ks, int half) { return d0 * 512 + ks * 4096 + half * 2048; }
template <int OFF> __device__ __forceinline__ s16x4 tr_read(int vb) {
  s16x4 r; asm volatile("ds_read_b64_tr_b16 %0, %1 offset:%2" : "=&v"(r) : "v"(vb), "i"(OFF) : "memory"); return r;
}
template <int D0> __device__ __forceinline__ void pv_one(f32x16& od, int vb, bf16x8 pa0, bf16x8 pa1, bf16x8 pa2, bf16x8 pa3) {
  const s16x4 l0 = tr_read<v_rd_off(D0, 0, 0)>(vb), h0 = tr_read<v_rd_off(D0, 0, 1)>(vb), l1 = tr_read<v_rd_off(D0, 1, 0)>(vb), h1 = tr_read<v_rd_off(D0, 1, 1)>(vb);
  const s16x4 l2 = tr_read<v_rd_off(D0, 2, 0)>(vb), h2 = tr_read<v_rd_off(D0, 2, 1)>(vb), l3 = tr_read<v_rd_off(D0, 3, 0)>(vb), h3 = tr_read<v_rd_off(D0, 3, 1)>(vb);
  asm volatile("s_waitcnt lgkmcnt(0)" ::: "memory"); SBAR();
#define PK(L, H) (bf16x8){L[0], L[1], L[2], L[3], H[0], H[1], H[2], H[3]}
  od = __builtin_amdgcn_mfma_f32_32x32x16_bf16(pa0, PK(l0, h0), od, 0, 0, 0);
  od = __builtin_amdgcn_mfma_f32_32x32x16_bf16(pa1, PK(l1, h1), od, 0, 0, 0);
  od = __builtin_amdgcn_mfma_f32_32x32x16_bf16(pa2, PK(l2, h2), od, 0, 0, 0);
  od = __builtin_amdgcn_mfma_f32_32x32x16_bf16(pa3, PK(l3, h3), od, 0, 0, 0);
#undef PK
}
__device__ __forceinline__ void pv_d0(f32x16* o, int vb, bf16x8 pa0, bf16x8 pa1, bf16x8 pa2, bf16x8 pa3) {
  pv_one<0>(o[0], vb, pa0, pa1, pa2, pa3); pv_one<1>(o[1], vb, pa0, pa1, pa2, pa3); pv_one<2>(o[2], vb, pa0, pa1, pa2, pa3); pv_one<3>(o[3], vb, pa0, pa1, pa2, pa3);
}
__device__ __forceinline__ void attn_unit(const bf16* __restrict__ Qb, const bf16* __restrict__ Kh, const bf16* __restrict__ Vh, float* __restrict__ Ob, int ldo, int seq, LAS char* lds) {
  int tid = threadIdx.x; asm volatile("" : "+v"(tid));
  const int wid = tid >> 6, lane = tid & 63, r32 = lane & 31, hi = lane >> 5;
  LAS char* V_lds = lds; LAS char* K_lds = lds + 2 * SHM_V;
  LAS float* ws = (LAS float*)(lds + 2 * SHM_V + 2 * SHM_K) + wid * 64; LAS float* li_l = ws; LAS float* al_l = ws + 32;
  float l_reg = 0; f32x16 o[4] = {}; bf16x8 qr[4];
  const bf16* Qw = Qb + (long)(wid * QBLK + r32) * 64 + hi * 8;
#pragma unroll
  for (int d0 = 0; d0 < 4; ++d0) qr[d0] = *(const GAS bf16x8*)(Qw + d0 * 16);
  const int sr = tid >> 4, sc = (tid & 15) * 8, vst0 = v_st(sr, sc), vst1 = v_st(32 + sr, sc);
  const int kr = tid >> 3, kc = (tid & 7) * 8; const int kst = KSWZ((kr & ~0xC) | ((kr & 4) << 1) | ((kr & 8) >> 1), kc * 2);
  const int vb0 = (int)(unsigned)(size_t)V_lds + v_rd_base(lane);
  bf16x8 vsA0, vsA1, ksA, vsB0, vsB1, ksB;
#define SLOADA(k0) do { vsA0 = *(const GAS bf16x8*)&Vh[(long)((k0) + sr) * 128 + sc]; vsA1 = *(const GAS bf16x8*)&Vh[(long)((k0) + 32 + sr) * 128 + sc]; ksA = *(const GAS bf16x8*)&Kh[(long)((k0) + kr) * 64 + kc]; } while (0)
#define SLOADB(k0) do { vsB0 = *(const GAS bf16x8*)&Vh[(long)((k0) + sr) * 128 + sc]; vsB1 = *(const GAS bf16x8*)&Vh[(long)((k0) + 32 + sr) * 128 + sc]; ksB = *(const GAS bf16x8*)&Kh[(long)((k0) + kr) * 64 + kc]; } while (0)
#define SWRITEA(b) do { *(LAS bf16x8*)(V_lds + (b) * SHM_V + vst0) = vsA0; *(LAS bf16x8*)(V_lds + (b) * SHM_V + vst1) = vsA1; *(LAS bf16x8*)(K_lds + (b) * SHM_K + kst) = ksA; } while (0)
#define SWRITEB(b) do { *(LAS bf16x8*)(V_lds + (b) * SHM_V + vst0) = vsB0; *(LAS bf16x8*)(V_lds + (b) * SHM_V + vst1) = vsB1; *(LAS bf16x8*)(K_lds + (b) * SHM_K + kst) = ksB; } while (0)
#define SWAIT() asm volatile("s_waitcnt vmcnt(3)" ::: "memory")
#define RESC(a) do { if (__any((a) < 1.f)) { if (hi == 0) al_l[r32] = (a); asm volatile("s_waitcnt lgkmcnt(0)" ::: "memory"); \
    _Pragma("unroll") for (int d = 0; d < 4; ++d) _Pragma("unroll") for (int r = 0; r < 16; ++r) o[d][r] *= al_l[crow(r, hi)]; } } while (0)
  f32x16 pA0, pA1, pB0, pB1; bf16x8 pa0, pa1, pa2, pa3; const int NTL = seq / KVBLK;
  __syncthreads();
  SLOADA(0); asm volatile("s_waitcnt vmcnt(0)" ::: "memory"); SWRITEA(0); __syncthreads();
  qkt(pA0, pA1, K_lds, qr, r32, hi); partialSM(pA0, pA1);
  SLOADB(KVBLK); if (2 < NTL) SLOADA(2 * KVBLK);
  SWAIT(); SWRITEB(1); __syncthreads();
  for (int j = 1; j + 1 < NTL; j += 2) {
    SBAR(); qkt(pB0, pB1, K_lds + SHM_K, qr, r32, hi);
    finishSM(pA0, pA1, l_reg, pa0, pa1, pa2, pa3); SBAR();
    SLOADB((j + 2) * KVBLK); SBAR();
    pv_d0(o, vb0, pa0, pa1, pa2, pa3); partialSM(pB0, pB1);
    __syncthreads(); SWAIT(); SWRITEA(0);
    __syncthreads();
    SBAR(); qkt(pA0, pA1, K_lds, qr, r32, hi);
    finishSM(pB0, pB1, l_reg, pa0, pa1, pa2, pa3); SBAR();
    if (j + 3 < NTL) SLOADA((j + 3) * KVBLK); SBAR();
    pv_d0(o, vb0 + SHM_V, pa0, pa1, pa2, pa3); partialSM(pA0, pA1);
    __syncthreads(); SWAIT(); SWRITEB(1);
    __syncthreads();
  }
  SBAR(); qkt(pB0, pB1, K_lds + SHM_K, qr, r32, hi);
  finishSM(pA0, pA1, l_reg, pa0, pa1, pa2, pa3); SBAR();
  pv_d0(o, vb0, pa0, pa1, pa2, pa3); partialSM(pB0, pB1);
  __syncthreads();
  finishSM(pB0, pB1, l_reg, pa0, pa1, pa2, pa3); SBAR();
  pv_d0(o, vb0 + SHM_V, pa0, pa1, pa2, pa3);
  if (hi == 0) li_l[r32] = l_reg; asm volatile("s_waitcnt lgkmcnt(0)" ::: "memory");
  float rli[16];
#pragma unroll
  for (int r = 0; r < 16; ++r) rli[r] = __builtin_amdgcn_rcpf(li_l[crow(r, hi)]);
  float* Ow = Ob + (long)(wid * QBLK) * ldo;
#pragma unroll
  for (int r = 0; r < 16; ++r) { const int orow = crow(r, hi);
#pragma unroll
    for (int d0 = 0; d0 < 4; ++d0) Ow[(long)orow * ldo + d0 * 32 + r32] = o[d0][r] * rli[r]; }
  asm volatile("s_waitcnt vmcnt(0)" ::: "memory");
#undef SLOADA
#undef SLOADB
#undef SWRITEA
#undef SWRITEB
#undef SWAIT
#undef RESC
}
__device__ __forceinline__ void attn_unit2(const bf16* __restrict__ Q0, const bf16* __restrict__ K0, const bf16* __restrict__ Vh, bf16* __restrict__ Ob, int seq, size_t qmap_stride, size_t kmap_stride,
                                           float lam, float post_scale, const float* __restrict__ gsub, LAS char* lds) {
  int tid = threadIdx.x; asm volatile("" : "+v"(tid));
  const int wid = tid >> 6, lane = tid & 63, r32 = lane & 31, hi = lane >> 5, map = wid >> 2, wq = wid & 3;
  LAS char* V_lds = lds; LAS char* K_lds = lds + 3 * SHM_V;
  LAS float* ws = (LAS float*)(lds + 3 * SHM_V + 6 * SHM_K) + wid * 64; LAS float* li_l = ws;
  LAS float* EX = (LAS float*)lds;
  float l_reg = 0; f32x16 o[4] = {}; bf16x8 qr[4];
  const bf16* Qw = Q0 + (size_t)map * qmap_stride + (long)(wq * QBLK + r32) * 64 + hi * 8;
#pragma unroll
  for (int d0 = 0; d0 < 4; ++d0) qr[d0] = *(const GAS bf16x8*)(Qw + d0 * 16);
  const int sr = tid >> 4, sc = (tid & 15) * 8, vst0 = v_st(sr, sc), vst1 = v_st(32 + sr, sc);
  const int kr = tid >> 3, kc = (tid & 7) * 8; const int kst = KSWZ((kr & ~0xC) | ((kr & 4) << 1) | ((kr & 8) >> 1), kc * 2);
  const bf16* K1 = K0 + kmap_stride;
  const int vb0 = (int)(unsigned)(size_t)V_lds + v_rd_base(lane);
  const LAS char* Kmine = K_lds + map * SHM_K;
  bf16x8 vsA0, vsA1, ksA0, ksA1, vsB0, vsB1, ksB0, ksB1;
#define SLOADA(k0) do { vsA0 = *(const GAS bf16x8*)&Vh[(long)((k0) + sr) * 128 + sc]; vsA1 = *(const GAS bf16x8*)&Vh[(long)((k0) + 32 + sr) * 128 + sc]; ksA0 = *(const GAS bf16x8*)&K0[(long)((k0) + kr) * 64 + kc]; ksA1 = *(const GAS bf16x8*)&K1[(long)((k0) + kr) * 64 + kc]; } while (0)
#define SLOADB(k0) do { vsB0 = *(const GAS bf16x8*)&Vh[(long)((k0) + sr) * 128 + sc]; vsB1 = *(const GAS bf16x8*)&Vh[(long)((k0) + 32 + sr) * 128 + sc]; ksB0 = *(const GAS bf16x8*)&K0[(long)((k0) + kr) * 64 + kc]; ksB1 = *(const GAS bf16x8*)&K1[(long)((k0) + kr) * 64 + kc]; } while (0)
#define SWRITEA(b) do { *(LAS bf16x8*)(V_lds + (b) * SHM_V + vst0) = vsA0; *(LAS bf16x8*)(V_lds + (b) * SHM_V + vst1) = vsA1; *(LAS bf16x8*)(K_lds + ((b) * 2) * SHM_K + kst) = ksA0; *(LAS bf16x8*)(K_lds + ((b) * 2 + 1) * SHM_K + kst) = ksA1; } while (0)
#define SWRITEB(b) do { *(LAS bf16x8*)(V_lds + (b) * SHM_V + vst0) = vsB0; *(LAS bf16x8*)(V_lds + (b) * SHM_V + vst1) = vsB1; *(LAS bf16x8*)(K_lds + ((b) * 2) * SHM_K + kst) = ksB0; *(LAS bf16x8*)(K_lds + ((b) * 2 + 1) * SHM_K + kst) = ksB1; } while (0)
#define SWAIT() asm volatile("s_waitcnt vmcnt(4)" ::: "memory")
  f32x16 pA0, pA1, pB0, pB1; bf16x8 pa0, pa1, pa2, pa3; const int NTL = seq / KVBLK;
  __syncthreads();
  SLOADA(0); asm volatile("s_waitcnt vmcnt(0)" ::: "memory"); SWRITEA(0); __syncthreads();
  qkt(pA0, pA1, Kmine, qr, r32, hi); partialSM(pA0, pA1);
  SLOADB(KVBLK); if (2 < NTL) SLOADA(2 * KVBLK);
  SWAIT(); SWRITEB(1); __syncthreads();
  int b_prev = 0, b_cur = 1, b_nxt = 2;
  for (int j = 1; j + 1 < NTL; j += 2) {
    SBAR(); qkt(pB0, pB1, Kmine + b_cur * 2 * SHM_K, qr, r32, hi);
    finishSM(pA0, pA1, l_reg, pa0, pa1, pa2, pa3); SBAR();
    SLOADB((j + 2) * KVBLK); SBAR();
    pv_d0(o, vb0 + b_prev * SHM_V, pa0, pa1, pa2, pa3); partialSM(pB0, pB1);
    SWAIT(); SWRITEA(b_nxt);
    __syncthreads();
    { const int t_ = b_prev; b_prev = b_cur; b_cur = b_nxt; b_nxt = t_; }
    SBAR(); qkt(pA0, pA1, Kmine + b_cur * 2 * SHM_K, qr, r32, hi);
    finishSM(pB0, pB1, l_reg, pa0, pa1, pa2, pa3); SBAR();
    if (j + 3 < NTL) SLOADA((j + 3) * KVBLK); SBAR();
    pv_d0(o, vb0 + b_prev * SHM_V, pa0, pa1, pa2, pa3); partialSM(pA0, pA1);
    SWAIT(); SWRITEB(b_nxt);
    __syncthreads();
    { const int t_ = b_prev; b_prev = b_cur; b_cur = b_nxt; b_nxt = t_; }
  }
  SBAR(); qkt(pB0, pB1, Kmine + b_cur * 2 * SHM_K, qr, r32, hi);
  finishSM(pA0, pA1, l_reg, pa0, pa1, pa2, pa3); SBAR();
  pv_d0(o, vb0 + b_prev * SHM_V, pa0, pa1, pa2, pa3); partialSM(pB0, pB1);
  finishSM(pB0, pB1, l_reg, pa0, pa1, pa2, pa3); SBAR();
  pv_d0(o, vb0 + b_cur * SHM_V, pa0, pa1, pa2, pa3);
  if (hi == 0) li_l[r32] = l_reg; asm volatile("s_waitcnt lgkmcnt(0)" ::: "memory");
  float rli[16];
#pragma unroll
  for (int r = 0; r < 16; ++r) rli[r] = __builtin_amdgcn_rcpf(li_l[crow(r, hi)]);
  __syncthreads();
  if (map == 1) {
#pragma unroll
    for (int d0 = 0; d0 < 4; ++d0)
#pragma unroll
      for (int r = 0; r < 16; ++r) EX[((wq * 4 + d0) * 16 + r) * 64 + lane] = o[d0][r] * (rli[r] * lam);
  }
  __syncthreads();
  if (map == 0) {
    float ss[16];
#pragma unroll
    for (int r = 0; r < 16; ++r) ss[r] = 0.f;
#pragma unroll
    for (int d0 = 0; d0 < 4; ++d0)
#pragma unroll
      for (int r = 0; r < 16; ++r) { const float v = o[d0][r] * rli[r] - EX[((wq * 4 + d0) * 16 + r) * 64 + lane]; o[d0][r] = v; ss[r] += v * v; }
    float gv[4];
#pragma unroll
    for (int d0 = 0; d0 < 4; ++d0) gv[d0] = gsub[d0 * 32 + r32] * post_scale;
#pragma unroll
    for (int r = 0; r < 16; ++r) { float t = row16_sum(ss[r]); t += __shfl_xor(t, 16); ss[r] = __builtin_amdgcn_rsqf(t * (1.f / 128.f) + 1e-6f); }
    bf16* Ow = Ob + (long)(wq * QBLK) * 1024;
#pragma unroll
    for (int r = 0; r < 16; ++r) { const int orow = crow(r, hi);
#pragma unroll
      for (int d0 = 0; d0 < 4; ++d0) Ow[(long)orow * 1024 + d0 * 32 + r32] = (bf16)f2bf(o[d0][r] * ss[r] * gv[d0]); }
  }
  asm volatile("s_waitcnt vmcnt(0)" ::: "memory");
#undef SLOADA
#undef SLOADB
#undef SWRITEA
#undef SWRITEB
#undef SWAIT
}
}

__device__ __forceinline__ void p5_att(Frame& F, const Inputs& I, int l, int row_lo) {
    const float* AO = (const float*)(F.ws + WS_ATTO); bf16* MIX = (bf16*)(F.ws + WS_MIX);
    const float lam = ((const float*)(F.ws + WS_MOD))[MOD_LAM + l];
    const float lam_init = 0.8f - 0.6f * expf(-0.3f * (float)l);
    const int L = F.lane, h = L >> 4, off = (L & 15) * 8;
    const f32x4 g0 = *(const GAS f32x4*)(I.da_subln_g + l * 128 + off), g1 = *(const GAS f32x4*)(I.da_subln_g + l * 128 + off + 4);
    for (int row = row_lo + F.gw; row < NT; row += F.NGW) {
        const float* p0 = AO + (size_t)row * 1024 + h * 256 + off; const float* p1 = p0 + 128;
        const f32x4 a0 = *(const GAS f32x4*)p0, a1 = *(const GAS f32x4*)(p0 + 4), b0 = *(const GAS f32x4*)p1, b1 = *(const GAS f32x4*)(p1 + 4);
        const f32x4 o0 = a0 - b0 * lam, o1 = a1 - b1 * lam;
        float ss = (o0.x * o0.x + o0.y * o0.y) + (o0.z * o0.z + o0.w * o0.w) + (o1.x * o1.x + o1.y * o1.y) + (o1.z * o1.z + o1.w * o1.w);
        ss = row16_sum(ss);
        const float sc = (1.0f / sqrtf(ss * (1.f / 128.f) + NORM_EPS)) * (1.0f - lam_init);
        const f32x4 y0 = o0 * g0 * sc, y1 = o1 * g1 * sc;
        v4u w; w.x = pk2(y0.x, y0.y); w.y = pk2(y0.z, y0.w); w.z = pk2(y1.x, y1.y); w.w = pk2(y1.z, y1.w);
        *(GAS v4u*)(MIX + (size_t)row * D + h * 128 + off) = w;
    }
}
__device__ __forceinline__ void p5_rwkv(Frame& F, const Inputs& I, int l, int row_begin, int row_end, int row_step) {
    const float* RYS = (const float*)(F.ws + WS_RYS); const float* RV = (const float*)(F.ws + WS_RV); const float* RG = (const float*)(F.ws + WS_RG); const float* RBS = (const float*)(F.ws + WS_RBS);
    bf16* MIX = (bf16*)(F.ws + WS_MIX);
    const int L = F.lane, c0 = 4 * L, h = L >> 4;
    const f32x4 lg = *(const GAS f32x4*)(I.rw_ln_g + l * 256 + c0), lb = *(const GAS f32x4*)(I.rw_ln_b + l * 256 + c0);
#pragma unroll 4
    for (int row = row_begin; row < row_end; row += row_step) {
        const f32x4 y = *(const GAS f32x4*)(RYS + (size_t)row * 256 + c0) + *(const GAS f32x4*)(RYS + ((size_t)NT + row) * 256 + c0);
        float s = (y.x + y.y) + (y.z + y.w);
        s = row16_sum(s);
        const float mu = s * (1.f / 64.f);
        const f32x4 d = y - mu;
        float q = (d.x * d.x + d.y * d.y) + (d.z * d.z + d.w * d.w);
        q = row16_sum(q);
        const float rstd = __builtin_amdgcn_rsqf(q * (1.f / 64.f) + 64e-5f);
        const f32x4 v = *(const GAS f32x4*)(RV + (size_t)row * 256 + c0);
        const f32x4 g = *(const GAS f32x4*)(RG + (size_t)row * 256 + c0);
        const float bs = RBS[(size_t)row * 8 + h] + RBS[(size_t)row * 8 + 4 + h];
        const f32x4 o = ((d * rstd) * lg + lb + v * bs) * g;
        v2u w; w.x = pk2(o.x, o.y); w.y = pk2(o.z, o.w);
        *(GAS v2u*)(MIX + (size_t)row * D + 512 + c0) = w;
    }
}
__device__ __forceinline__ void p5_mlout(Frame& F, const Inputs& I, int l, int u) {
    const bf16* Z = (const bf16*)(F.ws + WS_Z);
    const float* CS = (const float*)(F.ws + WS_CS); const float* NS = (const float*)(F.ws + WS_NS);
    bf16* MIX = (bf16*)(F.ws + WS_MIX);
    LAS bf16* QL = (LAS bf16*)(F.lds);
    LAS bf16* KL = (LAS bf16*)(F.lds + 18432);
    LAS bf16* VT = (LAS bf16*)(F.lds + 36864);
    LAS bf16* PL = (LAS bf16*)(F.lds + 54272);
    LAS bf16* CB = (LAS bf16*)(F.lds + 89088);
    LAS float* HL = (LAS float*)(F.lds + 100608);
    LAS float* gb = (LAS float*)(F.lds + 135424);
    LAS float* gi = gb + 128;
    const int w = F.wave;
    {
        int tid_ = threadIdx.x; asm volatile("" : "+v"(tid_));
        const int lane_ = tid_ & 63, lr = lane_ & 15, kg = lane_ >> 4;
        int b, j, h, row0, len;
        if (u < 64) { b = u >> 3; j = (u >> 2) & 1; h = u & 3; row0 = b * TC + j * 128; len = TC; }
        else { const int u2 = u - 64; b = u2 >> 7; j = (u2 >> 2) & 31; h = u2 & 3; row0 = NCX + b * T + j * 128; len = T; }
        const int t0 = j * 128;
        __syncthreads();
        { const int s = tid_ & 127, dg = tid_ >> 7; const int row = row0 + s, t = t0 + s;
          { float qv[16]; ml_conv16(Z, I, l, row, t, len, h * 64 + dg * 16, 1.0f, qv);
            v4u a, c;
            a.x = pk2(qv[0], qv[1]); a.y = pk2(qv[2], qv[3]); a.z = pk2(qv[4], qv[5]); a.w = pk2(qv[6], qv[7]);
            c.x = pk2(qv[8], qv[9]); c.y = pk2(qv[10], qv[11]); c.z = pk2(qv[12], qv[13]); c.w = pk2(qv[14], qv[15]);
            *(LAS v4u*)(QL + s * MLD + dg * 16) = a; *(LAS v4u*)(QL + s * MLD + dg * 16 + 8) = c; }
          asm volatile("" ::: "memory");
          { float kv[16]; ml_conv16(Z, I, l, row, t, len, 256 + h * 64 + dg * 16, 0.125f, kv);
            v4u a, c;
            a.x = pk2(kv[0], kv[1]); a.y = pk2(kv[2], kv[3]); a.z = pk2(kv[4], kv[5]); a.w = pk2(kv[6], kv[7]);
            c.x = pk2(kv[8], kv[9]); c.y = pk2(kv[10], kv[11]); c.z = pk2(kv[12], kv[13]); c.w = pk2(kv[14], kv[15]);
            *(LAS v4u*)(KL + s * MLD + dg * 16) = a; *(LAS v4u*)(KL + s * MLD + dg * 16 + 8) = c; }
          asm volatile("" ::: "memory");
          float vv[16];
          const bf16* zv = Z + (size_t)row * NPAD + ZML + 512 + h * 64 + dg * 16;
          { const v4u w0 = *(const GAS v4u*)zv, w1 = *(const GAS v4u*)(zv + 8); unpack8(w0, vv); unpack8(w1, vv + 8); }
#pragma unroll
          for (int e = 0; e < 16; ++e) VT[(dg * 16 + e) * MLS + s] = (bf16)f2bf(vv[e]); }
#pragma unroll 1
        for (int dir = 0; dir < 2; ++dir) {
            const int chain = dir * 32 + b * 4 + h;
            const int cc = (u < 64) ? (dir ? 1 - j : j) : 2 + (dir ? 31 - j : j);
            __syncthreads();
            ml_gates(F, I, l, dir, h, row0, gb, gi);
            { const float* cs = CS + ((size_t)chain * 34 + cc) * 4096; const int e = tid_ >> 3, d0 = (tid_ & 7) * 8;
              const f32x4 x0 = *(const GAS f32x4*)(cs + e * 64 + d0), x1 = *(const GAS f32x4*)(cs + e * 64 + d0 + 4);
              v4u o; o.x = pk2(x0.x, x0.y); o.y = pk2(x0.z, x0.w); o.z = pk2(x1.x, x1.y); o.w = pk2(x1.z, x1.w);
              *(LAS v4u*)(CB + e * MLD + d0) = o;
              if (tid_ < 64) CB[64 * MLD + tid_] = (bf16)f2bf(NS[((size_t)chain * 34 + cc) * 64 + tid_]);
              for (int i = tid_; i < 15 * 64; i += 512) CB[(65 + (i >> 6)) * MLD + (i & 63)] = 0; }
            __syncthreads();
            bf16x8 qa[2];
#pragma unroll
            for (int ks = 0; ks < 2; ++ks) qa[ks] = lds_frag(QL + (16 * w + lr) * MLD + ks * 32 + kg * 8);
            float bt[4], den[4];
#pragma unroll
            for (int r = 0; r < 4; ++r) { const int tq = 16 * w + 4 * kg + r; bt[r] = gb[dir ? 127 - tq : tq]; den[r] = 0.f; }
#pragma unroll 1
            for (int hf = 0; hf < 2; ++hf) {
                f32x4 sacc[4];
#pragma unroll
                for (int tc = 0; tc < 4; ++tc) sacc[tc] = (f32x4){0.f, 0.f, 0.f, 0.f};
#pragma unroll
                for (int tc = 0; tc < 4; ++tc)
#pragma unroll
                    for (int ks = 0; ks < 2; ++ks) sacc[tc] = __builtin_amdgcn_mfma_f32_16x16x32_bf16(qa[ks], lds_frag(KL + (16 * (hf * 4 + tc) + lr) * MLD + ks * 32 + kg * 8), sacc[tc], 0, 0, 0);
#pragma unroll
                for (int tc = 0; tc < 4; ++tc) { const int s = 16 * (hf * 4 + tc) + lr; const int sg = dir ? 127 - s : s; const float bs = gb[sg], is = gi[sg];
#pragma unroll
                    for (int r = 0; r < 4; ++r) { const int t = 16 * w + 4 * kg + r;
                        const float p = (dir ? (s >= t) : (s <= t)) ? sacc[tc][r] * __expf(bt[r] - bs + is) : 0.f;
                        den[r] += p; PL[t * MLS + s] = (bf16)f2bf(p); } }
            }
#pragma unroll
            for (int r = 0; r < 4; ++r) den[r] = row16_sum(den[r]);
            __syncthreads();
            f32x4 nacc[4], iacc[5];
#pragma unroll
            for (int te = 0; te < 4; ++te) nacc[te] = (f32x4){0.f, 0.f, 0.f, 0.f};
#pragma unroll
            for (int te = 0; te < 5; ++te) iacc[te] = (f32x4){0.f, 0.f, 0.f, 0.f};
#pragma unroll
            for (int ks = 0; ks < 4; ++ks) { const bf16x8 pa = lds_frag(PL + (16 * w + lr) * MLS + ks * 32 + kg * 8);
#pragma unroll
                for (int te = 0; te < 4; ++te) nacc[te] = __builtin_amdgcn_mfma_f32_16x16x32_bf16(pa, lds_frag(VT + (16 * te + lr) * MLS + ks * 32 + kg * 8), nacc[te], 0, 0, 0); }
#pragma unroll
            for (int ks = 0; ks < 2; ++ks)
#pragma unroll
                for (int te = 0; te < 5; ++te) iacc[te] = __builtin_amdgcn_mfma_f32_16x16x32_bf16(qa[ks], lds_frag(CB + (16 * te + lr) * MLD + ks * 32 + kg * 8), iacc[te], 0, 0, 0);
#pragma unroll
            for (int r = 0; r < 4; ++r) {
                const float et = __expf(bt[r]);
                const float qn = __shfl(iacc[4][r], lane_ & 48);
                const float dn = den[r] + et * qn;
                const float inv = __builtin_amdgcn_rcpf(fmaxf(fabsf(dn), 1.0f));
                const int tau = 16 * w + 4 * kg + r;
#pragma unroll
                for (int te = 0; te < 4; ++te) { const float hv = (nacc[te][r] + et * iacc[te][r]) * inv; LAS float* hp = HL + tau * 68 + 16 * te + lr;
                    if (dir == 0) *hp = hv; else *hp += hv; }
            }
        }
        __syncthreads();
        { const int tok = tid_ >> 2, q4 = tid_ & 3; const int row = row0 + tok;
          float y[16]; float s = 0.f;
#pragma unroll
          for (int e = 0; e < 16; ++e) { y[e] = HL[tok * 68 + q4 * 16 + e]; s += y[e]; }
          s = quad_sum(s);
          const float mu = s * (1.f / 64.f); float q = 0.f;
#pragma unroll
          for (int e = 0; e < 16; ++e) { y[e] -= mu; q += y[e] * y[e]; }
          q = quad_sum(q);
          const float rstd = __builtin_amdgcn_rsqf(q * (1.f / 64.f) + NORM_EPS);
          const bf16* zo = Z + (size_t)row * NPAD + ZML + 768 + h * 64 + q4 * 16;
          float og[16]; { const v4u w0 = *(const GAS v4u*)zo, w1 = *(const GAS v4u*)(zo + 8); unpack8(w0, og); unpack8(w1, og + 8); }
          int l2_ = l; asm volatile("" : "+s"(l2_));
          const float* ng = I.ml_norm_g + l2_ * 256 + h * 64 + q4 * 16;
          float o[16];
#pragma unroll
          for (int e = 0; e < 16; ++e) o[e] = sigmoidf_(og[e]) * (y[e] * rstd * ng[e]);
          v4u a, c;
          a.x = pk2(o[0], o[1]); a.y = pk2(o[2], o[3]); a.z = pk2(o[4], o[5]); a.w = pk2(o[6], o[7]);
          c.x = pk2(o[8], o[9]); c.y = pk2(o[10], o[11]); c.z = pk2(o[12], o[13]); c.w = pk2(o[14], o[15]);
          bf16* mp = MIX + (size_t)row * D + 768 + h * 64 + q4 * 16;
          *(GAS v4u*)mp = a; *(GAS v4u*)(mp + 8) = c; }
    }
    __syncthreads();
}

__device__ __forceinline__ void build_wm(Frame& F, const Inputs& I, int l) {
    const float* mod = (const float*)(F.ws + WS_MOD); float* WM = (float*)(F.ws + WS_WM);
    bf16* WMh = (bf16*)(F.ws + WS_WM + WMB_HI); bf16* WMl = (bf16*)(F.ws + WS_WM + WMB_LO);
    const float* we = I.router_we + (size_t)l * D * 32; const float* wg = I.router_wg + (size_t)l * D * 4;
    for (int i = F.gw * 64 + F.lane; i < 9 * 48 * 1024; i += F.NGW * 64) {
        const int k = i & 1023, n = (i >> 10) % 48, s = i / (48 * 1024);
        const float G = I.norm2_g[l * D + k] * (1.0f + mod[(size_t)(l * 9 + s) * 6144 + 4096 + k]);
        const float w = (n < 32) ? we[k * 32 + n] : ((n < 36) ? wg[k * 4 + (n - 32)] : 0.f);
        const float v = G * w; const unsigned hi = f2bf(v); const float r = v - bf2f((unsigned short)hi);
        WMh[i] = (bf16)hi; WMl[i] = (bf16)f2bf(r);
    }
    for (int p = F.gw; p < 9 * 36; p += F.NGW) {
        const int s = p / 36, n = p % 36; const float* sh = mod + (size_t)(l * 9 + s) * 6144 + 3072;
        float a = 0.f;
        for (int k = F.lane; k < D; k += 64) a += sh[k] * ((n < 32) ? we[k * 32 + n] : wg[k * 4 + (n - 32)]);
        a = wave_sum(a);
        if (F.lane == 0) WM[WM_CB + s * 48 + n] = a + ((n < 32) ? I.router_be[l * 32 + n] : I.router_bg[l * 4 + (n - 32)]);
    }
}
template <bool DRY, bool KONLY = false>
__device__ __forceinline__ void p7_route(Frame& F, const Inputs& I, int l, int row_lo) {
    const bf16* xs = (const bf16*)(F.ws + WS_XS); const float* WM = (const float*)(F.ws + WS_WM);
    const bf16* WMh = (const bf16*)(F.ws + WS_WM + WMB_HI); const bf16* WMl = (const bf16*)(F.ws + WS_WM + WMB_LO);
    int* route = (int*)(F.ws + WS_ROUTE);
    unsigned* cnt = (unsigned*)(F.ctl + CW_CNT + 64 * l);
    LAS float* XL = (LAS float*)(F.lds + F.wave * 16640);
    LAS float* LG = XL;
    LAS float* rs = LG + 16 * 49;
    LAS unsigned* lc = (LAS unsigned*)(F.lds + 133120);
    LAS unsigned* gbase = lc + 32;
    const int L = F.lane, lr = L & 15, kg = L >> 4;
    const int nunits = (NT - row_lo) / 16; const int nfull = (nunits >= 8 * F.G) ? 8 * F.G : 0;
    const int nextra = nunits - nfull;
    int nxr = 0; for (int r_ = nextra; r_ > 0; r_ -= 8 * F.G) ++nxr;
    const int niter = 1 + ((nextra > 0) ? ((nextra <= F.G) ? 1 : nxr) : 0);
    for (int it = 0; it < niter; ++it) {
        if (F.tid < 32) lc[F.tid] = 0u;
        __syncthreads();
        const bool shared_it = (it > 0) && (nextra <= F.G);
        int u; bool have;
        if (it == 0) { u = F.vcu * 8 + F.wave; have = u < nfull; }
        else if (shared_it) { u = nfull + F.vcu; have = F.vcu < nextra; }
        else { u = nfull + ((it - 1) * F.G + F.vcu) * 8 + F.wave; have = u < nunits; }
        if (!have) u = 0;
        const int row0 = row_lo + u * 16; const int s = row_seq(row0);
        const int hs0 = shared_it ? F.wave : 0, nhs = shared_it ? 1 : 8;
        const bf16* xrow = xs + (size_t)(row0 + (L >> 4)) * D + 8 * (L & 15);
        const bf16* bh = WMh + ((size_t)s * 48 + lr) * 1024 + 8 * kg; const bf16* bl = WMl + ((size_t)s * 48 + lr) * 1024 + 8 * kg;
        f32x4 acc[3] = {(f32x4){0.f, 0.f, 0.f, 0.f}, (f32x4){0.f, 0.f, 0.f, 0.f}, (f32x4){0.f, 0.f, 0.f, 0.f}};
        float ssq = 0.f;
        v4u pre[4];
#pragma unroll
        for (int jj = 0; jj < 4; ++jj) pre[jj] = *(const GAS v4u*)(xrow + (size_t)(4 * jj) * D + hs0 * 128);
#define ROUTE_KSTEP(FBH, FBL) do {                                                                                                                            \
                const f32x4 a0 = *(const LAS f32x4*)(XL + lr * 132 + ks * 32 + 8 * kg), a1 = *(const LAS f32x4*)(XL + lr * 132 + ks * 32 + 8 * kg + 4);                  \
                ssq += (a0.x * a0.x + a0.y * a0.y) + (a0.z * a0.z + a0.w * a0.w) + (a1.x * a1.x + a1.y * a1.y) + (a1.z * a1.z + a1.w * a1.w);                          \
                const float xv[8] = {a0.x, a0.y, a0.z, a0.w, a1.x, a1.y, a1.z, a1.w};                                                                                    \
                unsigned hh[4], ll[4];                                                                                                                                    \
                _Pragma("unroll") for (int q = 0; q < 4; ++q) hh[q] = (__builtin_bit_cast(unsigned, xv[2 * q]) >> 16) | (__builtin_bit_cast(unsigned, xv[2 * q + 1]) & 0xffff0000u);   \
                (void)ll; const v4u hv = {hh[0], hh[1], hh[2], hh[3]};                         \
                const bf16x8 fah = __builtin_bit_cast(bf16x8, hv);                                                                                                        \
                _Pragma("unroll") for (int nt = 0; nt < 3; ++nt) {                                                                                                        \
                    acc[nt] = __builtin_amdgcn_mfma_f32_16x16x32_bf16(fah, FBH[nt], acc[nt], 0, 0, 0);                                                                    \
                    acc[nt] = __builtin_amdgcn_mfma_f32_16x16x32_bf16(fah, FBL[nt], acc[nt], 0, 0, 0); } } while (0)
        if (!shared_it) {
            LAS unsigned char* Bb = F.lds + 8448;
            const int uw = (it == 0) ? F.vcu * 8 : nfull + ((it - 1) * F.G + F.vcu) * 8;
            const int sB = row_seq(row_lo + ((uw < nunits) ? uw : 0) * 16);
            const bf16* gsrc[3]; int ldst[3]; v4u bc[3];
#pragma unroll
            for (int q = 0; q < 3; ++q) { const int c = F.tid + 512 * q, wh = (c >= 768) ? 1 : 0, cc = c - 768 * wh, n = cc >> 4, kc = cc & 15;
                gsrc[q] = (wh ? WMl : WMh) + ((size_t)sB * 48 + n) * 1024 + kc * 8; const int R = wh * 48 + n; ldst[q] = (R >> 4) * 16640 + (R & 15) * 272 + kc * 16;
                bc[q] = *(const GAS v4u*)(gsrc[q]); }
            const int fro = lr * 272 + kg * 16;
            v4u preB[4];
#pragma unroll
            for (int jj = 0; jj < 4; ++jj) preB[jj] = *(const GAS v4u*)(xrow + (size_t)(4 * jj) * D + 1 * 128);
#define RT_HALF(HQ, PC) do {                                                                                                                                  \
                asm volatile("s_waitcnt lgkmcnt(0)\n\ts_barrier" ::: "memory");                     \
                _Pragma("unroll") for (int q = 0; q < 3; ++q) *(LAS v4u*)(Bb + ldst[q]) = bc[q];                                                                \
                _Pragma("unroll") for (int jj = 0; jj < 4; ++jj) { float f_[8]; unpack8(PC[jj], f_); LAS float* dst_ = XL + (4 * jj + (L >> 4)) * 132 + 8 * (L & 15); \
                    *(LAS f32x4*)dst_ = (f32x4){f_[0], f_[1], f_[2], f_[3]}; *(LAS f32x4*)(dst_ + 4) = (f32x4){f_[4], f_[5], f_[6], f_[7]}; }                 \
                { const int h1_ = ((HQ) + 1 < 8) ? (HQ) + 1 : 7, h2_ = ((HQ) + 2 < 8) ? (HQ) + 2 : 7;                                                          \
                  _Pragma("unroll") for (int q = 0; q < 3; ++q) bc[q] = *(const GAS v4u*)(gsrc[q] + h1_ * 128);                                                 \
                  _Pragma("unroll") for (int jj = 0; jj < 4; ++jj) PC[jj] = *(const GAS v4u*)(xrow + (size_t)(4 * jj) * D + h2_ * 128); }                      \
                asm volatile("s_waitcnt lgkmcnt(0)\n\ts_barrier" ::: "memory");       \
                _Pragma("unroll") for (int ks = 0; ks < 4; ++ks) {                                                                                             \
                    bf16x8 fbh[3], fbl[3];                                                                                                                     \
                    _Pragma("unroll") for (int nt = 0; nt < 3; ++nt) { fbh[nt] = *(const LAS bf16x8*)(Bb + fro + nt * 16640 + ks * 64); fbl[nt] = *(const LAS bf16x8*)(Bb + fro + (3 + nt) * 16640 + ks * 64); } \
                    ROUTE_KSTEP(fbh, fbl); } } while (0)
#pragma unroll 1
            for (int hq = 0; hq < 8; hq += 2) { RT_HALF(hq, pre); RT_HALF(hq + 1, preB); }
#undef RT_HALF
            WAVE_LDS_SYNC();
        } else {
#pragma unroll 1
        for (int hq = 0; hq < nhs; ++hq) {
            const int hs = hs0 + hq;
#pragma unroll
            for (int jj = 0; jj < 4; ++jj) { float f_[8]; unpack8(pre[jj], f_); LAS float* dst_ = XL + (4 * jj + (L >> 4)) * 132 + 8 * (L & 15);
                    *(LAS f32x4*)dst_ = (f32x4){f_[0], f_[1], f_[2], f_[3]}; *(LAS f32x4*)(dst_ + 4) = (f32x4){f_[4], f_[5], f_[6], f_[7]}; }
            if (hq + 1 < nhs) {
#pragma unroll
                for (int jj = 0; jj < 4; ++jj) pre[jj] = *(const GAS v4u*)(xrow + (size_t)(4 * jj) * D + (hs + 1) * 128); }
            WAVE_LDS_SYNC();
#pragma unroll
            for (int ks = 0; ks < 4; ++ks) {
                const int kk = hs * 128 + ks * 32;
                bf16x8 fbh[3], fbl[3];
#pragma unroll
                for (int nt = 0; nt < 3; ++nt) { fbh[nt] = *(const GAS bf16x8*)(bh + (size_t)nt * 16 * 1024 + kk); fbl[nt] = *(const GAS bf16x8*)(bl + (size_t)nt * 16 * 1024 + kk); }
                ROUTE_KSTEP(fbh, fbl);
            }
            WAVE_LDS_SYNC();
        }
        }
#undef ROUTE_KSTEP
        if (shared_it) {
            LAS float* PA = (LAS float*)(F.lds + F.wave * 16640);
#pragma unroll
            for (int nt = 0; nt < 3; ++nt)
#pragma unroll
                for (int r = 0; r < 4; ++r) PA[(nt * 4 + r) * 64 + L] = acc[nt][r];
            PA[12 * 64 + L] = ssq;
            __syncthreads();
            if (F.wave == 0) {
#pragma unroll 1
                for (int w2 = 1; w2 < 8; ++w2) { const LAS float* PB = (const LAS float*)(F.lds + w2 * 16640);
#pragma unroll
                    for (int nt = 0; nt < 3; ++nt)
#pragma unroll
                        for (int r = 0; r < 4; ++r) acc[nt][r] += PB[(nt * 4 + r) * 64 + L];
                    ssq += PB[12 * 64 + L]; } }
            __syncthreads();
            have = have && (F.wave == 0);
        }
        ssq += __shfl_xor(ssq, 16); ssq += __shfl_xor(ssq, 32);
        const float rstd = __builtin_amdgcn_rsqf(ssq * (1.f / D) + NORM_EPS);
        if (KONLY) { if (L == 0 && have) ((float*)(route + (size_t)NT * 8))[u & 1023] = acc[0][0] + acc[1][1] + acc[2][2] + rstd; }
        if (kg == 0) rs[lr] = rstd;
        WAVE_LDS_SYNC();
#pragma unroll
        for (int nt = 0; nt < 3; ++nt)
#pragma unroll
            for (int r = 0; r < 4; ++r) { const int i = 4 * kg + r; LG[i * 49 + nt * 16 + lr] = rs[i] * acc[nt][r] + WM[WM_CB + s * 48 + nt * 16 + lr]; }
        WAVE_LDS_SYNC();
        int e0 = 0, e1 = 0; unsigned lp0 = 0u, lp1 = 0u; float w0 = 0.f, w1 = 0.f;
        if (L < 16 && !KONLY && have) {
            const LAS float* lg = LG + L * 49;
            float gl[4];
#pragma unroll
            for (int q = 0; q < 4; ++q) gl[q] = lg[32 + q];
            int gs = 0; float gm = gl[0];
#pragma unroll
            for (int q = 1; q < 4; ++q) { const bool gt = gl[q] > gm; gm = gt ? gl[q] : gm; gs = gt ? q : gs; }
            float gsum = 0.f;
#pragma unroll
            for (int q = 0; q < 4; ++q) gsum += __expf(gl[q] - gm);
            const float gw_ = 1.0f / gsum;
            float el[8];
#pragma unroll
            for (int e = 0; e < 8; ++e) el[e] = lg[gs * 8 + e];
            int i0 = 0; float m0 = el[0];
#pragma unroll
            for (int e = 1; e < 8; ++e) { const bool gt = el[e] > m0; m0 = gt ? el[e] : m0; i0 = gt ? e : i0; }
            int i1 = -1; float m1 = -3.0e38f;
#pragma unroll
            for (int e = 0; e < 8; ++e) { const bool gt = (e != i0) && (el[e] > m1); m1 = gt ? el[e] : m1; i1 = gt ? e : i1; }
            const float p1 = __expf(m1 - m0);
            w0 = gw_ / (1.0f + p1); w1 = gw_ * p1 / (1.0f + p1);
            e0 = gs * 8 + i0; e1 = gs * 8 + i1;
            lp0 = atomicAdd((unsigned*)(lc + e0), 1u); lp1 = atomicAdd((unsigned*)(lc + e1), 1u);
        }
        __syncthreads();
        if (F.tid < 32) { const unsigned c = lc[F.tid]; gbase[F.tid] = (c && !DRY) ? atomicAdd(cnt + F.tid, c) : 0u; }
        __syncthreads();
        if (L < 16 && !KONLY && have) {
            const int row = row0 + L;
            int* rp = DRY ? (route + (size_t)NT * 8 + (size_t)(row & 1023) * 8) : (route + (size_t)row * 8);
            rp[0] = e0; rp[1] = e1; rp[2] = (int)(gbase[e0] + lp0); rp[3] = (int)(gbase[e1] + lp1); rp[4] = __builtin_bit_cast(int, w0); rp[5] = __builtin_bit_cast(int, w1);
            if (!DRY) ((float*)(route + ROUTE_RSTD))[row] = rs[L];
        }
        __syncthreads();
    }
}
__device__ __forceinline__ void p8_scatter(Frame& F, const Inputs& I, int l, int row_lo) {
    const bf16* xs = (const bf16*)(F.ws + WS_XS); const float* mod = (const float*)(F.ws + WS_MOD);
    int* route = (int*)(F.ws + WS_ROUTE); bf16* xsrt = (bf16*)(F.ws + WS_XSORT);
    const unsigned* cnt = (const unsigned*)(F.ctl + CW_CNT + 64 * l);
    int blocks = 0; if (F.lane < 32) blocks = (int)((__hip_atomic_load(cnt + F.lane, RLX_AGENT) + 255u) >> 8);
    int inc = blocks;
#pragma unroll
    for (int o = 1; o < 32; o <<= 1) { const int n = __shfl_up(inc, o); if (F.lane >= o) inc += n; }
    const int padoff = (inc - blocks) * 256;
    const GAS f32x4* ng = (const GAS f32x4*)(I.norm2_g + l * D) + F.lane;
    v2u xa[4], xb[4];
    auto ld = [&](int row, v2u (&x)[4]) { const int r_ = row < NT ? row : NT - 1; const GAS v2u* xr = (const GAS v2u*)(xs + (size_t)r_ * D) + F.lane;
#pragma unroll
        for (int j = 0; j < 4; ++j) x[j] = xr[64 * j]; };
    auto fin = [&](int row, const v2u (&x)[4]) { if (row >= NT) return;
        int* rp = route + (size_t)row * 8;
        const int e0 = rp[0], e1 = rp[1], q0 = rp[2], q1 = rp[3];
        const int d0 = __shfl(padoff, e0) + q0, d1 = __shfl(padoff, e1) + q1;
        const float rstd = ((const float*)(route + ROUTE_RSTD))[row];
        const int s = row_seq(row);
        const GAS f32x4* sh = (const GAS f32x4*)(mod + (size_t)(l * 9 + s) * 6144 + 3072) + F.lane;
        const GAS f32x4* sc = (const GAS f32x4*)(mod + (size_t)(l * 9 + s) * 6144 + 4096) + F.lane;
        GAS v2u* p0 = (GAS v2u*)(xsrt + (size_t)d0 * D) + F.lane; GAS v2u* p1 = (GAS v2u*)(xsrt + (size_t)d1 * D) + F.lane;
#pragma unroll
        for (int j = 0; j < 4; ++j) { const f32x4 xv = {bflo(x[j].x), bfhi(x[j].x), bflo(x[j].y), bfhi(x[j].y)};
            const f32x4 y = (xv * rstd * ng[64 * j]) * (sc[64 * j] + 1.0f) + sh[64 * j];
            v2u w; w.x = pk2(y.x, y.y); w.y = pk2(y.z, y.w); p0[64 * j] = w; p1[64 * j] = w; }
        if (F.lane == 0) { rp[6] = d0; rp[7] = d1; } };
    if (F.G == 256) {
        struct SRow { v2u x[4]; int e0, e1, q0, q1; float rstd; };
        const int rpw = (NT - row_lo) >> 11, r0 = row_lo + F.gw * rpw;
        f32x4 pg[4], ph[4], pc[4]; int cur_s = -1;
        auto lp = [&](int s_) { const GAS f32x4* sh = (const GAS f32x4*)(mod + (size_t)(l * 9 + s_) * 6144 + 3072) + F.lane; const GAS f32x4* sc = (const GAS f32x4*)(mod + (size_t)(l * 9 + s_) * 6144 + 4096) + F.lane;
#pragma unroll
            for (int j = 0; j < 4; ++j) { ph[j] = sh[64 * j]; pc[j] = sc[64 * j]; } };
#pragma unroll
        for (int j = 0; j < 4; ++j) pg[j] = ng[64 * j];
        cur_s = row_seq(r0); lp(cur_s);
        auto ldr = [&](int k, SRow& R) { const int row = r0 + ((k < rpw) ? k : rpw - 1); const GAS v2u* xr = (const GAS v2u*)(xs + (size_t)row * D) + F.lane;
#pragma unroll
            for (int j = 0; j < 4; ++j) R.x[j] = xr[64 * j];
            const GAS int* rp = (const GAS int*)route + (size_t)row * 8; R.e0 = rp[0]; R.e1 = rp[1]; R.q0 = rp[2]; R.q1 = rp[3];
            R.rstd = ((const GAS float*)(route + ROUTE_RSTD))[row]; };
        auto fnr = [&](int k, const SRow& R) { const int row = r0 + k; const int s_ = row_seq(row); if (s_ != cur_s) { cur_s = s_; lp(s_); }
            const int d0 = __shfl(padoff, R.e0) + R.q0, d1 = __shfl(padoff, R.e1) + R.q1;
            GAS v2u* p0 = (GAS v2u*)(xsrt + (size_t)d0 * D) + F.lane; GAS v2u* p1 = (GAS v2u*)(xsrt + (size_t)d1 * D) + F.lane;
#pragma unroll
            for (int j = 0; j < 4; ++j) { const f32x4 xv = {bflo(R.x[j].x), bfhi(R.x[j].x), bflo(R.x[j].y), bfhi(R.x[j].y)};
                const f32x4 y = (xv * R.rstd * pg[j]) * (pc[j] + 1.0f) + ph[j];
                v2u w; w.x = pk2(y.x, y.y); w.y = pk2(y.z, y.w); p0[64 * j] = w; p1[64 * j] = w; }
            if (F.lane == 0) { int* rp = route + (size_t)row * 8; rp[6] = d0; rp[7] = d1; } };
        SRow A, B;
        ldr(0, A);
#pragma unroll 1
        for (int k = 0; k < rpw; k += 2) {
            ldr(k + 1, B); fnr(k, A);
            ldr(k + 2, A); if (k + 1 < rpw) fnr(k + 1, B);
        }
        return;
    }
    ld(row_lo + F.gw, xa);
    for (int row = row_lo + F.gw; row < NT; row += 2 * F.NGW) {
        ld(row + F.NGW, xb); fin(row, xa);
        ld(row + 2 * F.NGW, xa); fin(row + F.NGW, xb);
    }
}
__device__ __forceinline__ void moe_table(Frame& F, int l, volatile LAS int* blkend) {
    const unsigned* cnt = (const unsigned*)(F.ctl + CW_CNT + 64 * l);
    if (F.wave == 0) {
        int blocks = 0; if (F.lane < 32) blocks = (int)((__hip_atomic_load(cnt + F.lane, RLX_AGENT) + 255u) >> 8);
        int inc = blocks;
#pragma unroll
        for (int o = 1; o < 32; o <<= 1) { const int n = __shfl_up(inc, o); if (F.lane >= o) inc += n; }
        if (F.lane < 32) blkend[F.lane] = inc;
    }
    __syncthreads();
}

constexpr int PH_PER_LAYER = 10, PH_FINAL = 1 + DEPTH * PH_PER_LAYER, N_PHASES = PH_FINAL + 1;
constexpr int MOE_TAB_OFF = 131072;
constexpr int N_ATT_X = NB * 4 * 32, N_ATT_C = NB * 4 * 2;

__global__ void __launch_bounds__(NWAVES * 64, 2) mk_fwd(Args args) {
    extern __shared__ __attribute__((aligned(16))) unsigned char lds[];
    Frame F;
    F.lds = (LAS unsigned char*)lds;
    F.MISC = (volatile LAS unsigned*)(F.lds + MISC_OFF);
    F.tid = threadIdx.x; F.lane = F.tid & 63; F.wave = __builtin_amdgcn_readfirstlane(F.tid >> 6);
    F.G = gridDim.x; { const int bx = blockIdx.x; F.vcu = (F.G % 8 == 0) ? (bx % 8) * (F.G / 8) + bx / 8 : bx; }
    F.gw = F.vcu * NWAVES + F.wave; F.NGW = F.G * NWAVES;
    F.ws = args.ws; F.ctl = (gu32*)(args.ws + WS_CTL);
    const float* const volatile* kp_ = (const float* const volatile*)__builtin_amdgcn_kernarg_segment_ptr();
    for (int u = F.tid; u < (LDS_BYTES - LDSCTL_OFF) / 4; u += NWAVES * 64) ((LAS unsigned*)(F.lds + LDSCTL_OFF))[u] = 0u;
    __syncthreads();
    XcdBarrier bar; bar.bar = (unsigned*)(F.ctl + CW_BAR); bar.x = 0; bar.st = nullptr;
    const int lo = args.ph_lo, hi = args.ph_hi;
    const bool fused = (hi - lo) > 1;
    if (fused) bar = xcd_barrier_post((unsigned*)(F.ctl + CW_BAR), F.MISC + 8);
#ifndef PH_ENABLE
#define PH_ENABLE 0xFFFFu
#endif
#ifndef REP_PH
#define REP_PH -1
#endif
#ifndef REP_N
#define REP_N 2
#endif
#define NREP(p) ((p) == (REP_PH) ? (REP_N) : 1)
#define REPEAT(p) _Pragma("unroll") for (int rep_ = 0; rep_ < NREP(p); ++rep_)
#define EN(p) (((PH_ENABLE) >> (p)) & 1)
#define IN(k) (lo <= (k) && (k) < hi)
#define SEAM(k) do { if (IN(k) && IN((k) + 1)) xcd_barrier(bar); } while (0)
    float* mod = (float*)(F.ws + WS_MOD);
    volatile LAS int* blkend = (volatile LAS int*)(F.lds + MOE_TAB_OFF);

#define PHASE_BEGIN() frame_refresh(F); Inputs I; I.x = uni_ptr(kp_[0]); I.c = uni_ptr(kp_[1]); I.ctx = uni_ptr(kp_[2]); I.c_ctx = uni_ptr(kp_[3]); I.ada_w = uni_ptr(kp_[4]); I.ada_b = uni_ptr(kp_[5]); I.norm1_g = uni_ptr(kp_[6]); I.norm2_g = uni_ptr(kp_[7]); I.w_in = uni_ptr(kp_[8]); I.w_out = uni_ptr(kp_[9]); I.da_lambda = uni_ptr(kp_[10]); I.da_subln_g = uni_ptr(kp_[11]); I.rw_shift_mu = uni_ptr(kp_[12]); I.rw_w0 = uni_ptr(kp_[13]); I.rw_w2 = uni_ptr(kp_[14]); I.rw_a0 = uni_ptr(kp_[15]); I.rw_a2 = uni_ptr(kp_[16]); I.rw_g2 = uni_ptr(kp_[17]); I.rw_k_k = uni_ptr(kp_[18]); I.rw_k_a = uni_ptr(kp_[19]); I.rw_r_k = uni_ptr(kp_[20]); I.rw_ln_g = uni_ptr(kp_[21]); I.rw_ln_b = uni_ptr(kp_[22]); I.ml_conv_w = uni_ptr(kp_[23]); I.ml_conv_b = uni_ptr(kp_[24]); I.ml_gate_b = uni_ptr(kp_[25]); I.ml_norm_g = uni_ptr(kp_[26]); I.router_wg = uni_ptr(kp_[27]); I.router_bg = uni_ptr(kp_[28]); I.router_we = uni_ptr(kp_[29]); I.router_be = uni_ptr(kp_[30]); I.exp_w_gu = uni_ptr(kp_[31]); I.exp_w_down = uni_ptr(kp_[32]); I.final_g = uni_ptr(kp_[33]);
    if (EN(10) && IN(0)) { PHASE_BEGIN(); REPEAT(10) p0_prologue(F, I); SEAM(0); }
#pragma unroll 1
    for (int l = 0; l < DEPTH; ++l) {
        const int pb = 1 + l * PH_PER_LAYER;
        const bool last = (l == DEPTH - 1);
        if (EN(0) && IN(pb + 0)) { PHASE_BEGIN(); if (l == 0) p_norm1<0>(F, I, l, args.out); else p_norm1<1>(F, I, l, args.out);
            if (NREP(0) > 1) p_norm1<0>(F, I, l, args.out, NREP(0) - 1);
            build_wm(F, I, l);
            if (fused && NREP(50) > 1) { for (int rb_ = 0; rb_ < 10; ++rb_) xcd_barrier(bar); }
            SEAM(pb + 0); }
        if (EN(1) && IN(pb + 1)) { PHASE_BEGIN();
            pg8::Gemm g{(const bf16*)(F.ws + WS_H1), (const bf16*)(F.ws + WS_WIN) + (size_t)l * NPAD * D, D};
            StaticOrderT<NPAD / 256> S; S.init(NT, NPAD, F.G, F.vcu);
            EpiZ E{(bf16*)(F.ws + WS_Z), NPAD, F.ws};
            REPEAT(1) pg8::gemm_phase<EpiZ, StaticOrderT<NPAD / 256>>(F.lds, g, S, E);
            SEAM(pb + 1);
        }
        if (EN(2) && IN(pb + 2)) { PHASE_BEGIN(); rwkv_chunk_pre(F, I, l, NREP(21)); REPEAT(22) p3_mlstate(F, I, l);
            asm volatile("s_waitcnt vmcnt(0)" ::: "memory"); __syncthreads();
            if (F.tid == 0) { __builtin_amdgcn_fence(__ATOMIC_RELEASE, "agent"); asm volatile("s_waitcnt vmcnt(0)" ::: "memory");
                __hip_atomic_fetch_add((unsigned*)(F.ctl + CW_PREP + 64 * l), 1u, RLX_AGENT); }
        }
        if (EN(3) && IN(pb + 3)) { PHASE_BEGIN();
            if (F.vcu < 128) {
                if (F.tid == 0) { unsigned* p = (unsigned*)(F.ctl + CW_PREP + 64 * l); unsigned sp = 0;
                    while (__hip_atomic_load(p, RLX_AGENT) < (unsigned)F.G) { __builtin_amdgcn_s_sleep(2);
                        if (++sp > (1u << 22)) { atomicAdd((unsigned*)(F.ctl + CW_BAR) + XB_TMO, 1u); break; } }
                    __builtin_amdgcn_fence(__ATOMIC_ACQUIRE, "agent"); asm volatile("s_waitcnt vmcnt(0)" ::: "memory"); }
                __syncthreads();
            }
            for (int ch = F.vcu; ch < 64; ch += F.G) { if (last) rwkv_seq<false>(F, ch, I.exp_w_gu, I.exp_w_down, 0); else rwkv_seq<true>(F, ch, I.exp_w_gu, I.exp_w_down, l + 1); publish_done(F, CW_FLAG + (l * 128 + ch) * 64); }
            for (int ch = F.vcu; ch < 128; ch += F.G) if (ch >= 64) { ml_prefix(F, ch - 64); publish_done(F, CW_FLAG + (l * 128 + ch) * 64); }
            const int n_att = last ? N_ATT_X : N_ATT_X + N_ATT_C;
            constexpr int N_CONV = 384; const int n_conv = 0;
            REPEAT(32)
            for (;;) {
                __syncthreads();
                if (F.tid == 0) F.MISC[0] = __hip_atomic_fetch_add((unsigned*)(F.ctl + CW_QUEUE + 64 * l + 8 * rep_), 1u, RLX_AGENT);
                __syncthreads();
                int u = __builtin_amdgcn_readfirstlane((int)F.MISC[0]);
                if (u >= n_att + n_conv) break;
                if (n_conv) {
                    const int j = u / 3;
                    if (u - 3 * j == 2 && j < N_CONV) { conv_unit(F, I, l + 1, j); continue; }
                    const int nc = (u + 1) / 3; u -= (nc < N_CONV) ? nc : N_CONV;
                }
                const bf16 *Qp, *Kp, *Vp; bf16* Op; int seq; size_t qstr;
                if (u < N_ATT_X) { const int b = u >> 7, h = (u >> 5) & 3, qb = u & 31;
                    Qp = (const bf16*)(F.ws + WS_QB) + ((size_t)(b * 8 + h * 2) * T + qb * 128) * 64; qstr = (size_t)T * 64;
                    Kp = (const bf16*)(F.ws + WS_KB) + (size_t)(b * 8 + h * 2) * TK * 64;
                    Vp = (const bf16*)(F.ws + WS_VB) + (size_t)(b * 4 + h) * TK * 128;
                    Op = (bf16*)(F.ws + WS_MIX) + (size_t)(NCX + b * T + qb * 128) * 1024 + h * 128; seq = TK; }
                else { const int u2 = u - N_ATT_X, b = u2 >> 3, h = (u2 >> 1) & 3, qb = u2 & 1;
                    Qp = (const bf16*)(F.ws + WS_QC) + ((size_t)(b * 8 + h * 2) * TC + qb * 128) * 64; qstr = (size_t)TC * 64;
                    Kp = (const bf16*)(F.ws + WS_KB) + (size_t)(b * 8 + h * 2) * TK * 64;
                    Vp = (const bf16*)(F.ws + WS_VB) + (size_t)(b * 4 + h) * TK * 128;
                    Op = (bf16*)(F.ws + WS_MIX) + (size_t)(b * TC + qb * 128) * 1024 + h * 128; seq = TC; }
                att::attn_unit2(Qp, Kp, Vp, Op, seq, qstr, (size_t)TK * 64, mod[MOD_LAM + l], 1.0f - (0.8f - 0.6f * __expf(-0.3f * (float)l)), I.da_subln_g + l * 128, (LAS char*)F.lds);
            }
            { PHASE_BEGIN();
            wait_all_done(F, CW_FLAG + l * 128 * 64);
            { const int u_lo = last ? 64 : 0, n_ml = 1088 - u_lo;
              for (;;) {
                __syncthreads();
                if (F.tid == 0) F.MISC[0] = __hip_atomic_fetch_add((unsigned*)(F.ctl + CW_QUEUE + 64 * l + 16), 1u, RLX_AGENT);
                __syncthreads();
                const int u = (int)F.MISC[0];
                if (u >= n_ml) break;
                p5_mlout(F, I, l, u_lo + u);
              } }
            { const int r_lo = last ? NCX : 0, n_rw = (NT - r_lo) / 128;
              for (;;) {
                __syncthreads();
                if (F.tid == 0) F.MISC[0] = __hip_atomic_fetch_add((unsigned*)(F.ctl + CW_QUEUE + 64 * l + 32), 1u, RLX_AGENT);
                __syncthreads();
                const int u = (int)F.MISC[0];
                if (u >= n_rw) break;
                const int rb = r_lo + u * 128 + F.wave * 16;
                p5_rwkv(F, I, l, rb, rb + 16, 1);
              } }
            }
            SEAM(pb + 3);
        }
        if (EN(5) && IN(pb + 5)) { PHASE_BEGIN();
            pg8::Gemm g{(const bf16*)(F.ws + WS_MIX), (const bf16*)(F.ws + WS_WOUT) + (size_t)l * D * D, D};
            StaticOrderT<D / 256> S; if (last) S.init(NXR, D, F.G, F.vcu, NCX / 256); else S.init(NT, D, F.G, F.vcu);
            EpiResid E{(bf16*)(F.ws + WS_XS), mod + (size_t)l * 9 * 6144 + 2048, (l == 0) ? I.ctx : nullptr, (l == 0) ? I.x : nullptr};
            pg8::gemm_phase<EpiResid, StaticOrderT<D / 256>>(F.lds, g, S, E);
            REPEAT(5) { if (rep_ > 0) { EpiF32 E2{(float*)(F.ws + WS_YS)}; pg8::gemm_phase<EpiF32, StaticOrderT<D / 256>>(F.lds, g, S, E2); } }
            SEAM(pb + 5);
        }
        if (EN(6) && IN(pb + 6)) { PHASE_BEGIN(); p7_route<false>(F, I, l, last ? NCX : 0); REPEAT(6) { if (rep_ > 0) p7_route<true>(F, I, l, 0); } REPEAT(61) { if (rep_ > 0) p7_route<true, true>(F, I, l, 0); } SEAM(pb + 6); }
        if (EN(7) && IN(pb + 7)) { PHASE_BEGIN(); REPEAT(7) p8_scatter(F, I, l, last ? NCX : 0); SEAM(pb + 7); }
        if (EN(8) && IN(pb + 8)) { PHASE_BEGIN();
            moe_table(F, l, blkend);
            pg8::Gemm g{(const bf16*)(F.ws + WS_XSORT), (const bf16*)(F.ws + WS_WGU) + (size_t)l * NEXP * 1024 * D, D};
            MoeOrder S{blkend, F.G, F.vcu, (size_t)1024 * D * 2};
            EpiSwiGLU E{(bf16*)(F.ws + WS_ACT)};
            REPEAT(8) pg8::gemm_phase<EpiSwiGLU, MoeOrder>(F.lds, g, S, E);
            SEAM(pb + 8);
        }
        if (EN(9) && IN(pb + 9)) { PHASE_BEGIN();
            moe_table(F, l, blkend);
            pg8::Gemm g{(const bf16*)(F.ws + WS_ACT), (const bf16*)(F.ws + WS_WDN) + (size_t)l * NEXP * D * EH, EH};
            MoeOrder S{blkend, F.G, F.vcu, (size_t)D * EH * 2};
            EpiY16 E{(bf16*)(F.ws + WS_YS)};
            REPEAT(9) pg8::gemm_phase<EpiY16, MoeOrder>(F.lds, g, S, E);
            SEAM(pb + 9);
        }
    }
    if (EN(11) && IN(PH_FINAL)) { PHASE_BEGIN(); p_norm1<2>(F, I, DEPTH, args.out); }
#undef IN
#undef SEAM
}

extern "C" void kernel_launch(void* const* d_in, const int* in_sizes, int n_in, void* d_out, int out_size, void* d_ws, size_t ws_size, hipStream_t stream) {
    static int grid = 0;
    if (grid == 0) {
        if (n_in != 34 || in_sizes[0] != NXR * D || out_size != NXR * D || ws_size < WS_END) {
            fprintf(stderr, "kernel_launch: unexpected shapes: n_in %d in0 %d out %d ws %zu (need %zu)\n", n_in, n_in > 0 ? in_sizes[0] : -1, out_size, ws_size, (size_t)WS_END); grid = -1; return; }
        int dev = 0, cus = 0, per_cu = 0;
        if (hipGetDevice(&dev) != hipSuccess || hipDeviceGetAttribute(&cus, hipDeviceAttributeMultiprocessorCount, dev) != hipSuccess) { grid = -1; return; }
        if (hipFuncSetAttribute((const void*)mk_fwd, hipFuncAttributeMaxDynamicSharedMemorySize, LDS_BYTES) != hipSuccess) { fprintf(stderr, "kernel_launch: hipFuncSetAttribute failed\n"); grid = -1; return; }
        if (hipOccupancyMaxActiveBlocksPerMultiprocessor(&per_cu, (const void*)mk_fwd, NWAVES * 64, LDS_BYTES) != hipSuccess || per_cu < 1)
            fprintf(stderr, "kernel_launch: occupancy query reports %d blocks per CU\n", per_cu);
        (void)hipGetLastError();
        grid = cus;
    }
    if (grid < 0) return;
    if (hipMemsetAsync((char*)d_ws + WS_CTL, 0, CTL_ZERO_BYTES, stream) != hipSuccess) return;
    Args a{};
    const float** ip = (const float**)&a.in;
    for (int i = 0; i < 34; ++i) ip[i] = (const float*)d_in[i];
    a.out = (float*)d_out; a.ws = (unsigned char*)d_ws;
#if MK_N_LAUNCHES == 1
    a.ph_lo = 0; a.ph_hi = N_PHASES;
    hipLaunchKernelGGL(mk_fwd, dim3(grid), dim3(NWAVES * 64), LDS_BYTES, stream, a);
#else
    for (int p = 0; p < N_PHASES; ++p) { a.ph_lo = p; a.ph_hi = p + 1;
        hipLaunchKernelGGL(mk_fwd, dim3(grid), dim3(NWAVES * 64), LDS_BYTES, stream, a); }
#endif
    const hipError_t le = hipPeekAtLastError();
    if (le != hipSuccess) fprintf(stderr, "kernel_launch: launch failed: %s\n", hipGetErrorName(le));
}
```

```cpp
#include <hip/hip_runtime.h>
#include <cstdio>
#include <cstdint>

#ifndef MK_N_LAUNCHES
#define MK_N_LAUNCHES 1
#endif

namespace pg8 {
#define PG8_LAS __attribute__((address_space(3)))
typedef unsigned short bf16_t;
typedef short bf16x8 __attribute__((ext_vector_type(8)));
typedef float f32x4 __attribute__((ext_vector_type(4)));
typedef unsigned u32x4 __attribute__((ext_vector_type(4)));
constexpr int BM = 256, BK = 64, HALF = 128, HTB = HALF * BK * 2, STAGE_BYTES = 8 * HTB;

__host__ __device__ __forceinline__ int lds_byte(int r, int c) { const int st = (r >> 4) * 2 + (c >> 5), rr = r & 15, cc = c & 31, ob = rr * 64 + cc * 2; return st * 1024 + (ob ^ (((ob >> 9) & 1) << 5)); }
__host__ __device__ __forceinline__ void stage_rc(int b, int& R, int& C) { const int st = b / 1024, sb = b % 1024, swz = sb ^ (((sb >> 9) & 1) << 5); R = (st >> 1) * 16 + swz / 64; C = (st & 1) * 32 + (swz % 64) / 2; }
__host__ __device__ __forceinline__ int perm32(int rho) { const int n = rho >> 4, i = rho & 15; return 8 * (i >> 2) + 4 * n + (i & 3); }

struct Unit { int pm, pn; size_t boff; };
struct Gemm { const bf16_t* A; const bf16_t* Bt; int K; };

__device__ __forceinline__ unsigned cvt_pk_bf16(float lo, float hi) { unsigned r; asm volatile("v_cvt_pk_bf16_f32 %0, %1, %2" : "=v"(r) : "v"(lo), "v"(hi)); return r; }

template <class Epi, class Sched, bool ALIGN_EPI = true, bool SP2 = true>
__device__ __forceinline__ void gemm_phase(PG8_LAS unsigned char* lds, const Gemm g, const Sched& S, const Epi& E) {
    int tid = threadIdx.x; asm volatile("" : "+v"(tid));
    const int wid = __builtin_amdgcn_readfirstlane(tid >> 6), lane = tid & 63, wr = wid >> 2, wc = wid & 3, fr = lane & 15, fq = lane >> 4;
    const int K = g.K, nt = K / BK;
    unsigned voffA[2], voffB[2];
#pragma unroll
    for (int i = 0; i < 2; ++i) { int R, C; stage_rc(tid * 16 + i * 8192, R, C); const int Rb = Epi::PERM ? ((R & ~31) + perm32(R & 31)) : R;
        voffA[i] = (unsigned)(R * K + C) * 2u; voffB[i] = (unsigned)(Rb * K + C) * 2u; }
    const size_t kstep = (size_t)(BK * 2);
    const size_t hstep = (size_t)HALF * K * 2;
    const size_t tstep = 2 * hstep;
    const unsigned ldsw = (unsigned)wid * 1024u;
    const int aoff = lds_byte(wr * 64 + fr, fq * 8), boff = lds_byte(wc * 32 + fr, fq * 8);
#define PG8_SA(b, h) (((b) * 2 + (h)) * HTB)
#define PG8_SB(b, h) ((4 + (b) * 2 + (h)) * HTB)
#define PG8_STAGE(bufoff, gbase, voff) do { _Pragma("unroll") for (int _i = 0; _i < 2; ++_i) \
        __builtin_amdgcn_global_load_lds((const unsigned*)((const char*)(gbase) + (voff)[_i]), (PG8_LAS unsigned*)(lds + (bufoff) + ldsw + _i * 8192), 16, 0, 0); } while (0)
#define PG8_LDA(dst, b, h) do { _Pragma("unroll") for (int m = 0; m < 4; ++m) _Pragma("unroll") for (int k = 0; k < 2; ++k) dst[m][k] = *(const PG8_LAS bf16x8*)(lds + PG8_SA(b, h) + aoff + m * 2048 + k * 1024); } while (0)
#define PG8_LDB(dst, b, h) do { _Pragma("unroll") for (int n = 0; n < 2; ++n) _Pragma("unroll") for (int k = 0; k < 2; ++k) dst[n][k] = *(const PG8_LAS bf16x8*)(lds + PG8_SB(b, h) + boff + n * 2048 + k * 1024); } while (0)
#define PG8_MMA(ai, bj, At, Bt) do { __builtin_amdgcn_s_setprio(1); _Pragma("unroll") for (int m = 0; m < 4; ++m) _Pragma("unroll") for (int n = 0; n < 2; ++n) _Pragma("unroll") for (int k = 0; k < 2; ++k) \
        acc[ai][bj][m][n] = __builtin_amdgcn_mfma_f32_16x16x32_bf16(Bt[n][k], At[m][k], acc[ai][bj][m][n], 0, 0, 0); __builtin_amdgcn_s_setprio(0); } while (0)
#define PG8_WAIT_V(n) asm volatile("s_waitcnt vmcnt(" #n ")" ::: "memory")
#define PG8_WAIT_L(n) asm volatile("s_waitcnt lgkmcnt(" #n ")" ::: "memory")
#define PG8_BAR __builtin_amdgcn_s_barrier()
#define PG8_SCHED __builtin_amdgcn_sched_barrier(0)
    Unit cur, nxt; int ui = 0;
    if (!S.next(0, cur)) return;
    f32x4 acc[2][2][4][2];
#pragma unroll
    for (int a = 0; a < 2; ++a)
#pragma unroll
        for (int b = 0; b < 2; ++b)
#pragma unroll
            for (int m = 0; m < 4; ++m)
#pragma unroll
                for (int n = 0; n < 2; ++n) acc[a][b][m][n] = (f32x4){0.f, 0.f, 0.f, 0.f};
    bf16x8 At[4][2], B0[2][2], B1[2][2];
    const char* cA = (const char*)g.A + (size_t)cur.pm * tstep; const char* cB = (const char*)g.Bt + cur.boff + (size_t)cur.pn * tstep;
    if constexpr (SP2) {
        PG8_STAGE(PG8_SB(0, 0), cB, voffB); PG8_STAGE(PG8_SB(0, 1), cB + hstep, voffB); PG8_STAGE(PG8_SA(0, 0), cA, voffA); PG8_STAGE(PG8_SA(0, 1), cA + hstep, voffA);
        if (wr == 1) PG8_BAR;
        PG8_WAIT_V(2); PG8_BAR;
        PG8_STAGE(PG8_SB(1, 0), cB + kstep, voffB); PG8_STAGE(PG8_SA(1, 0), cA + kstep, voffA); PG8_STAGE(PG8_SB(1, 1), cB + hstep + kstep, voffB);
        PG8_WAIT_V(6); PG8_BAR;
    } else {
        PG8_STAGE(PG8_SB(0, 0), cB, voffB); PG8_STAGE(PG8_SA(0, 0), cA, voffA); PG8_STAGE(PG8_SB(0, 1), cB + hstep, voffB); PG8_STAGE(PG8_SA(0, 1), cA + hstep, voffA);
        if (wr == 1) PG8_BAR;
        PG8_WAIT_V(4); PG8_BAR;
        PG8_STAGE(PG8_SB(1, 0), cB + kstep, voffB); PG8_STAGE(PG8_SA(1, 0), cA + kstep, voffA); PG8_STAGE(PG8_SB(1, 1), cB + hstep + kstep, voffB);
        PG8_WAIT_V(6); PG8_BAR;
    }
    for (;;) {
        const bool has_next = S.next(ui + 1, nxt);
        const char* nA = has_next ? (const char*)g.A + (size_t)nxt.pm * tstep : cA; const char* nB = has_next ? (const char*)g.Bt + nxt.boff + (size_t)nxt.pn * tstep : cB;
        for (int t = 0; t < nt; t += 2) {
            const bool last = (t == nt - 2);
            const char* a1 = cA + (size_t)(t + 1) * kstep;
            const char* a2 = last ? nA : cA + (size_t)(t + 2) * kstep; const char* b2 = last ? nB : cB + (size_t)(t + 2) * kstep;
            const char* a3 = a2 + kstep; const char* b3 = b2 + kstep;
            if constexpr (SP2) {
            PG8_LDB(B0, 0, 0); PG8_LDB(B1, 0, 1); PG8_SCHED; PG8_LDA(At, 0, 0); PG8_STAGE(PG8_SA(1, 1), a1 + hstep, voffA);
            PG8_WAIT_V(8); PG8_WAIT_L(0); PG8_BAR; PG8_MMA(0, 0, At, B0); PG8_MMA(0, 1, At, B1); PG8_BAR; PG8_SCHED;
            PG8_LDA(At, 0, 1); PG8_STAGE(PG8_SB(0, 0), b2, voffB); PG8_STAGE(PG8_SB(0, 1), b2 + hstep, voffB); PG8_STAGE(PG8_SA(0, 0), a2, voffA);
            PG8_WAIT_V(8); PG8_WAIT_L(0); PG8_BAR; PG8_MMA(1, 0, At, B0); PG8_MMA(1, 1, At, B1); PG8_BAR; PG8_SCHED;
            PG8_LDB(B0, 1, 0); PG8_LDB(B1, 1, 1); PG8_SCHED; PG8_LDA(At, 1, 0); PG8_STAGE(PG8_SA(0, 1), a2 + hstep, voffA);
            PG8_WAIT_V(8); PG8_WAIT_L(0); PG8_BAR; PG8_MMA(0, 0, At, B0); PG8_MMA(0, 1, At, B1); PG8_BAR; PG8_SCHED;
            PG8_LDA(At, 1, 1); PG8_STAGE(PG8_SB(1, 0), b3, voffB); PG8_STAGE(PG8_SB(1, 1), b3 + hstep, voffB); PG8_STAGE(PG8_SA(1, 0), a3, voffA);
            PG8_WAIT_V(8); PG8_WAIT_L(0); PG8_BAR; PG8_MMA(1, 0, At, B0); PG8_MMA(1, 1, At, B1); PG8_BAR; PG8_SCHED;
            } else {
            PG8_LDB(B0, 0, 0); PG8_SCHED; PG8_LDA(At, 0, 0); PG8_STAGE(PG8_SA(1, 1), a1 + hstep, voffA);
            PG8_WAIT_L(8); PG8_BAR; PG8_WAIT_L(0); PG8_MMA(0, 0, At, B0); PG8_BAR; PG8_SCHED;
            PG8_LDB(B1, 0, 1); PG8_STAGE(PG8_SB(0, 0), b2, voffB);
            PG8_BAR; PG8_WAIT_L(0); PG8_MMA(0, 1, At, B1); PG8_BAR;
            PG8_LDA(At, 0, 1); PG8_STAGE(PG8_SA(0, 0), a2, voffA);
            PG8_BAR; PG8_WAIT_L(0); PG8_MMA(1, 0, At, B0); PG8_BAR; PG8_SCHED;
            PG8_STAGE(PG8_SB(0, 1), b2 + hstep, voffB);
            PG8_WAIT_V(6); PG8_BAR; PG8_MMA(1, 1, At, B1); PG8_BAR;
            PG8_LDB(B0, 1, 0); PG8_SCHED; PG8_LDA(At, 1, 0); PG8_STAGE(PG8_SA(0, 1), a2 + hstep, voffA);
            PG8_WAIT_L(8); PG8_BAR; PG8_WAIT_L(0); PG8_MMA(0, 0, At, B0); PG8_BAR; PG8_SCHED;
            PG8_LDB(B1, 1, 1); PG8_STAGE(PG8_SB(1, 0), b3, voffB);
            PG8_BAR; PG8_WAIT_L(0); PG8_MMA(0, 1, At, B1); PG8_BAR;
            PG8_LDA(At, 1, 1); PG8_STAGE(PG8_SA(1, 0), a3, voffA);
            PG8_BAR; PG8_WAIT_L(0); PG8_MMA(1, 0, At, B0); PG8_BAR; PG8_SCHED;
            PG8_STAGE(PG8_SB(1, 1), b3 + hstep, voffB);
            PG8_WAIT_V(6); PG8_BAR; PG8_MMA(1, 1, At, B1); PG8_BAR;
            }
        }
        if constexpr (ALIGN_EPI) { if (wr == 0) PG8_BAR; }
        E(acc, cur, wr, wc, fr, fq);
        if (!has_next) break;
#pragma unroll
        for (int a = 0; a < 2; ++a)
#pragma unroll
            for (int b = 0; b < 2; ++b)
#pragma unroll
                for (int m = 0; m < 4; ++m)
#pragma unroll
                    for (int n = 0; n < 2; ++n) acc[a][b][m][n] = (f32x4){0.f, 0.f, 0.f, 0.f};
        cur = nxt; cA = nA; cB = nB; ++ui;
        if constexpr (ALIGN_EPI) { if (wr == 1) PG8_BAR; }
    }
    PG8_WAIT_V(0);
    if constexpr (!ALIGN_EPI) { if (wr == 0) PG8_BAR; }
    PG8_BAR;
#undef PG8_SA
#undef PG8_SB
#undef PG8_STAGE
#undef PG8_LDA
#undef PG8_LDB
#undef PG8_MMA
#undef PG8_WAIT_V
#undef PG8_WAIT_L
#undef PG8_BAR
#undef PG8_SCHED
}
}

constexpr int D = 1024, NB = 8, T = 4096, TC = 256, DEPTH = 4, GRID_W = 64;
constexpr int NCX = NB * TC;
constexpr int NXR = NB * T;
constexpr int NT = NCX + NXR;
constexpr int IN_COLS = 3536, NPAD = 3584;
constexpr int ZQ = 0, ZK = 512, ZV = 1024, ZRW = 1536, ZML = 2496;
constexpr int TK = TC + T;
constexpr int NEXP = 32, EH = 512;
constexpr int MOE_ROWS = 2 * NT + NEXP * 256;
constexpr int NWAVES = 8;
constexpr float NORM_EPS = 1e-6f;

constexpr size_t MiB = 1u << 20;
constexpr size_t WS_CTL = 0, CTL_ZERO_BYTES = 1 * MiB;
constexpr size_t WS_XS = 1 * MiB;
constexpr size_t WS_WIN = 137 * MiB;
constexpr size_t WS_WOUT = 165 * MiB;
constexpr size_t WS_WGU = 173 * MiB;
constexpr size_t WS_WDN = 429 * MiB;
constexpr size_t WS_MOD = 557 * MiB;
constexpr size_t WS_H1 = 558 * MiB;
constexpr size_t WS_ROUTE = 626 * MiB;
constexpr size_t WS_A = 628 * MiB;
constexpr size_t WS_Z = WS_A;
constexpr size_t WS_QB = WS_A + 238 * MiB;
constexpr size_t WS_QC = WS_A + 270 * MiB;
constexpr size_t WS_KB = WS_A + 272 * MiB;
constexpr size_t WS_VB = WS_A + 306 * MiB;
constexpr size_t WS_ATTO = WS_A + 340 * MiB;
constexpr size_t WS_RWC = WS_A + 476 * MiB;
constexpr size_t WS_RV = WS_A + 723 * MiB;
constexpr size_t WS_RG = WS_A + 782 * MiB;
constexpr size_t WS_RBS = WS_A + 757 * MiB;
constexpr size_t WS_RYS = WS_A + 817 * MiB;
constexpr size_t WS_DC = WS_A + 885 * MiB;
constexpr size_t WS_CS = WS_A + 919 * MiB;
constexpr size_t WS_DN = WS_A + 953 * MiB;
constexpr size_t WS_NS = WS_A + 954 * MiB;
constexpr size_t WS_MIX = WS_A + 955 * MiB;
constexpr size_t WS_XSORT = WS_A;
constexpr size_t WS_ACT = WS_A + 152 * MiB;
constexpr size_t WS_YS = WS_A + 228 * MiB;
constexpr size_t WS_WM = WS_A + 1023 * MiB;
constexpr size_t WS_LORA = WS_A + 1025 * MiB;
constexpr size_t WS_END = WS_A + 1026 * MiB;
static_assert(WS_YS + (size_t)MOE_ROWS * 1024 * 4 <= WS_END, "ws map");
constexpr int MOD_LAM = 4 * 9 * 6144;
constexpr int MOD_ROPE = MOD_LAM + 64;
constexpr int LORA_A2T = 4 * 2 * 256 * 32, LORA_G2T = 2 * LORA_A2T;
constexpr int WM_CB = 0;
constexpr size_t WMB_HI = 4096, WMB_LO = 4096 + 9 * 48 * 1024 * 2;
constexpr int ROUTE_RSTD = 327680;
constexpr int CW_TMO = 0;
constexpr int CW_BAR = 4096;
constexpr int CW_QUEUE = 8192;
constexpr int CW_CNT = 9216;
constexpr int CW_PREP = 24576;
constexpr int CW_FLAG = 32768;
constexpr int RING_BYTES = 131072;
constexpr int LDSCTL_OFF = 139264, MISC_OFF = LDSCTL_OFF + 320;
constexpr int LDS_BYTES = 147456;

#define GAS __attribute__((address_space(1)))
#define LAS __attribute__((address_space(3)))
typedef unsigned short bf16;
typedef unsigned v4u __attribute__((ext_vector_type(4)));
typedef unsigned v2u __attribute__((ext_vector_type(2)));
typedef float f32x4 __attribute__((ext_vector_type(4)));
typedef float f32x16 __attribute__((ext_vector_type(16)));
typedef short bf16x8 __attribute__((ext_vector_type(8)));
typedef short s16x4 __attribute__((ext_vector_type(4)));
typedef GAS unsigned gu32;
#define RLX_AGENT __ATOMIC_RELAXED, __HIP_MEMORY_SCOPE_AGENT
__device__ __forceinline__ unsigned pk2(float lo, float hi) { unsigned r; asm volatile("v_cvt_pk_bf16_f32 %0, %1, %2" : "=v"(r) : "v"(lo), "v"(hi)); return r; }
__device__ __forceinline__ unsigned f2bf(float f) { return (__builtin_bit_cast(unsigned, f) + 0x8000u) >> 16; }
__device__ __forceinline__ float bf2f(unsigned short b) { return __builtin_bit_cast(float, ((unsigned)b) << 16); }
__device__ __forceinline__ float bflo(unsigned w) { return __builtin_bit_cast(float, w << 16); }
__device__ __forceinline__ float bfhi(unsigned w) { return __builtin_bit_cast(float, w & 0xffff0000u); }
__device__ __forceinline__ void unpack8(const v4u w, float* f) { f[0] = bflo(w.x); f[1] = bfhi(w.x); f[2] = bflo(w.y); f[3] = bfhi(w.y); f[4] = bflo(w.z); f[5] = bfhi(w.z); f[6] = bflo(w.w); f[7] = bfhi(w.w); }
__device__ __forceinline__ float sigmoidf_(float x) { return __builtin_amdgcn_rcpf(1.f + __builtin_amdgcn_exp2f(-1.4426950408889634f * x)); }
__device__ __forceinline__ float siluf_(float x) { return x * __builtin_amdgcn_rcpf(1.f + __builtin_amdgcn_exp2f(-1.4426950408889634f * x)); }
__device__ __forceinline__ float rl_f(float v, int lane_) { return __builtin_bit_cast(float, __builtin_amdgcn_readlane(__builtin_bit_cast(int, v), lane_)); }
#define DPP_ADD(v, ctrl, rmask) ((v) + __builtin_bit_cast(float, __builtin_amdgcn_update_dpp(0, __builtin_bit_cast(int, (v)), (ctrl), (rmask), 0xF, false)))
__device__ __forceinline__ float quad_sum(float v) { v = DPP_ADD(v, 0xB1, 0xF); v = DPP_ADD(v, 0x4E, 0xF); return v; }
__device__ __forceinline__ float row8_sum(float v) { v = quad_sum(v); v = DPP_ADD(v, 0x141, 0xF); return v; }
__device__ __forceinline__ float row16_sum(float v) { v = row8_sum(v); v = DPP_ADD(v, 0x140, 0xF); return v; }
__device__ __forceinline__ float wave_sum(float v) {
    v = row16_sum(v); v = DPP_ADD(v, 0x142, 0xA); v = DPP_ADD(v, 0x143, 0xC);
    return __builtin_bit_cast(float, __builtin_amdgcn_readlane(__builtin_bit_cast(int, v), 63));
}

#define XB_TMO      128
#define XB_XCNT(j)  (256  + 64 * (j))
#define XB_XSUB(j)  (1280 + 64 * (j))
#define XB_XGEN(j)  (2304 + 64 * (j))
#define XB_TOP      3328
#define XB_TOPGEN   3392
#define XCD_BAR_WORDS 3456
#define XB_SPIN_CAP (1u << 22)
__device__ __forceinline__ unsigned xb_ld(unsigned* p)              { return __hip_atomic_load(p, __ATOMIC_RELAXED, __HIP_MEMORY_SCOPE_AGENT); }
__device__ __forceinline__ unsigned xb_add(unsigned* p, unsigned v) { return __hip_atomic_fetch_add(p, v, __ATOMIC_RELAXED, __HIP_MEMORY_SCOPE_AGENT); }
__device__ __forceinline__ unsigned xb_xcc_id() { return (unsigned)__builtin_amdgcn_s_getreg((3 << 11) | 20) & 0xFu; }
#define XB_SPIN(cond, bar) do { unsigned _sp = 0; while (cond) { __builtin_amdgcn_s_sleep(1); \
    if ((++_sp & 255u) == 0u) { if (xb_ld(&(bar)[XB_TMO])) break; if (_sp > XB_SPIN_CAP) { atomicAdd(&(bar)[XB_TMO], 1u); break; } } } } while (0)
struct XcdBarrier { unsigned* bar; unsigned x; volatile LAS unsigned* st; };
__device__ __forceinline__ XcdBarrier xcd_barrier_post(unsigned* bar, volatile LAS unsigned* st) {
    XcdBarrier b; b.bar = bar; b.x = xb_xcc_id(); b.st = st;
    if (threadIdx.x == 0) (void)xb_add(&bar[XB_XCNT(b.x)], 1u);
    return b;
}
__device__ __forceinline__ void xcd_barrier_complete(unsigned* bar, unsigned x, unsigned& nloc, unsigned& nx) {
    const unsigned G = gridDim.x * gridDim.y * gridDim.z;
    unsigned sum, cnt, mine, sp = 0u;
    for (;;) {
        sum = 0u; cnt = 0u; mine = 0u;
#pragma unroll
        for (unsigned j = 0; j < 16; ++j) { const unsigned c = xb_ld(&bar[XB_XCNT(j)]); sum += c; cnt += (c > 0u) ? 1u : 0u; mine = (j == x) ? c : mine; }
        if (sum == G) break;
        __builtin_amdgcn_s_sleep(1);
        if ((++sp & 255u) == 0u) { if (xb_ld(&bar[XB_TMO])) break; if (sp > XB_SPIN_CAP) { atomicAdd(&bar[XB_TMO], 1u); break; } }
    }
    nloc = mine > 0u ? mine : 1u; nx = cnt > 0u ? cnt : 1u;
}
__device__ __forceinline__ void xcd_barrier(const XcdBarrier& b) {
    asm volatile("s_waitcnt vmcnt(0)" ::: "memory");
    __syncthreads();
    if (threadIdx.x == 0) {
        unsigned* bar = b.bar;
        __builtin_amdgcn_s_waitcnt(0);
        unsigned nloc = b.st[0], nx = b.st[1];
        if (nloc == 0u) { xcd_barrier_complete(bar, b.x, nloc, nx); b.st[0] = nloc; b.st[1] = nx; }
        const unsigned old = xb_add(&bar[XB_XSUB(b.x)], 1u);
        const unsigned gen = old / nloc;
        if (old + 1u == (gen + 1u) * nloc) {
            __builtin_amdgcn_fence(__ATOMIC_RELEASE, "agent");
            asm volatile("s_waitcnt vmcnt(0)" ::: "memory");
            const unsigned og = xb_add(&bar[XB_TOP], 1u);
            const unsigned tg = og / nx;
            if (og + 1u == (tg + 1u) * nx) xb_add(&bar[XB_TOPGEN], 1u);
            else XB_SPIN(xb_ld(&bar[XB_TOPGEN]) == tg, bar);
            __builtin_amdgcn_fence(__ATOMIC_ACQUIRE, "agent");
            xb_add(&bar[XB_XGEN(b.x)], 1u);
            asm volatile("s_waitcnt vmcnt(0)" ::: "memory");
        } else {
            XB_SPIN(xb_ld(&bar[XB_XGEN(b.x)]) == gen, bar);
            __builtin_amdgcn_fence(__ATOMIC_ACQUIRE, "agent");
            asm volatile("s_waitcnt vmcnt(0)" ::: "memory");
        }
    }
    __syncthreads();
}

struct Inputs {
    const float *x, *c, *ctx, *c_ctx, *ada_w, *ada_b, *norm1_g, *norm2_g, *w_in, *w_out, *da_lambda, *da_subln_g,
                *rw_shift_mu, *rw_w0, *rw_w2, *rw_a0, *rw_a2, *rw_g2, *rw_k_k, *rw_k_a, *rw_r_k, *rw_ln_g, *rw_ln_b,
                *ml_conv_w, *ml_conv_b, *ml_gate_b, *ml_norm_g, *router_wg, *router_bg, *router_we, *router_be,
                *exp_w_gu, *exp_w_down, *final_g;
};
struct Args { Inputs in; float* out; unsigned char* ws; int ph_lo, ph_hi; };
struct Frame {
    LAS unsigned char* lds;
    volatile LAS unsigned* MISC;
    gu32* ctl;
    unsigned char* ws;
    int tid, lane, wave, vcu, G, gw, NGW;
};
__device__ __forceinline__ const float* uni_ptr(const float* p) {
    const unsigned long long u = (unsigned long long)p; const unsigned lo = __builtin_amdgcn_readfirstlane((unsigned)u), hi = __builtin_amdgcn_readfirstlane((unsigned)(u >> 32));
    return (const float*)(((unsigned long long)hi << 32) | lo); }
__device__ __forceinline__ void frame_refresh(Frame& F) {
    int t = threadIdx.x; asm volatile("" : "+v"(t));
    F.tid = t; F.lane = t & 63; F.wave = __builtin_amdgcn_readfirstlane(t >> 6); F.gw = F.vcu * NWAVES + F.wave;
}
__device__ __forceinline__ void publish_done(Frame& F, int flag_word) {
    asm volatile("s_waitcnt vmcnt(0)" ::: "memory");
    __syncthreads();
    if (threadIdx.x == 0) {
        __builtin_amdgcn_fence(__ATOMIC_RELEASE, "agent");
        asm volatile("s_waitcnt vmcnt(0)" ::: "memory");
        __hip_atomic_store((unsigned*)(F.ctl + flag_word), 1u, RLX_AGENT);
    }
}
__device__ __forceinline__ void wait_all_done(Frame& F, int flag_base) {
    int t_ = threadIdx.x; asm volatile("" : "+v"(t_));
    if (t_ < 128) {
        unsigned* p = (unsigned*)(F.ctl + flag_base + 64 * t_); unsigned sp = 0;
        while (__hip_atomic_load(p, RLX_AGENT) == 0u) { __builtin_amdgcn_s_sleep(2);
            if (++sp > (1u << 22)) { atomicAdd((unsigned*)(F.ctl + CW_BAR) + XB_TMO, 1u); break; } }
    }
    __syncthreads();
    if (threadIdx.x == 0) { __builtin_amdgcn_fence(__ATOMIC_ACQUIRE, "agent"); asm volatile("s_waitcnt vmcnt(0)" ::: "memory"); }
    __syncthreads();
}
__device__ __forceinline__ int row_seq(int row) { return row < NCX ? 8 : ((row - NCX) >> 12); }

template <int RMAP>
__device__ __forceinline__ void transpose_item(const float* W, int K, int N, bf16* WT, LAS float* scr, int item, int lane) {
    const int nblk = (N + 31) / 32, kb = item / nblk, nb = item % nblk, k0 = 64 * kb, n0 = 32 * nb;
    const int ncol = n0 + (lane & 31);
    float tv[32];
#pragma unroll
    for (int i = 0; i < 32; ++i) { const int kk = 2 * i + (lane >> 5); tv[i] = (ncol < N) ? W[(size_t)(k0 + kk) * N + ncol] : 0.f; }
#pragma unroll
    for (int i = 0; i < 32; ++i) { const int kk = 2 * i + (lane >> 5); scr[kk * 33 + (lane & 31)] = tv[i]; }
    asm volatile("s_waitcnt lgkmcnt(0)" ::: "memory");
    const int c = lane & 7;
#pragma unroll
    for (int j = 0; j < 4; ++j) { const int n = (lane >> 3) + 8 * j; const LAS float* s = scr + (8 * c) * 33 + n;
        v4u o; o.x = pk2(s[0 * 33], s[1 * 33]); o.y = pk2(s[2 * 33], s[3 * 33]); o.z = pk2(s[4 * 33], s[5 * 33]); o.w = pk2(s[6 * 33], s[7 * 33]);
        int nn = n0 + n;
        if (nn < N) {
            if (RMAP == 1) { nn = (nn < 512) ? ((nn >> 7) * 256 + (nn & 127)) : ((((nn - 512) >> 7) * 256) + 128 + ((nn - 512) & 127)); }
            *(GAS v4u*)(WT + (size_t)nn * K + k0 + 8 * c) = o; } }
    asm volatile("s_waitcnt lgkmcnt(0)" ::: "memory");
}

__device__ __forceinline__ void p0_prologue(Frame& F, const Inputs& I) {
    LAS float* scr = (LAS float*)(F.lds + F.wave * 16384);
    unsigned char* ws = F.ws;
    constexpr int I_IN = 16 * 111, I_OUT = 16 * 32, I_GU = 16 * 32, I_DN = 8 * 32;
    constexpr int N_IN = DEPTH * I_IN, N_OUT = DEPTH * I_OUT, N_GU = NEXP * I_GU, N_DN = NEXP * I_DN;
    for (int it = F.gw; it < N_IN + N_OUT + N_GU + N_DN; it += F.NGW) {
        int r = it;
        if (r < N_IN) { const int l = r / I_IN; transpose_item<0>(I.w_in + (size_t)l * D * IN_COLS, D, IN_COLS, (bf16*)(ws + WS_WIN) + (size_t)l * NPAD * D, scr, r % I_IN, F.lane); continue; } r -= N_IN;
        if (r < N_OUT) { const int l = r / I_OUT; transpose_item<0>(I.w_out + (size_t)l * D * D, D, D, (bf16*)(ws + WS_WOUT) + (size_t)l * D * D, scr, r % I_OUT, F.lane); continue; } r -= N_OUT;
        if (r < N_GU) { const int le = r / I_GU; transpose_item<1>(I.exp_w_gu + (size_t)le * D * 1024, D, 1024, (bf16*)(ws + WS_WGU) + (size_t)le * 1024 * D, scr, r % I_GU, F.lane); continue; } r -= N_GU;
        { const int le = r / I_DN; transpose_item<0>(I.exp_w_down + (size_t)le * EH * D, EH, D, (bf16*)(ws + WS_WDN) + (size_t)le * D * EH, scr, r % I_DN, F.lane); }
    }
    for (int i = F.gw * 64 + F.lane; i < DEPTH * (NPAD - IN_COLS) * D / 8; i += F.NGW * 64) {
        const int l = i / ((NPAD - IN_COLS) * D / 8), r = i % ((NPAD - IN_COLS) * D / 8);
        *(GAS v4u*)((bf16*)(ws + WS_WIN) + (size_t)l * NPAD * D + (size_t)IN_COLS * D + (size_t)r * 8) = (v4u){0u, 0u, 0u, 0u};
    }
    float* mod = (float*)(ws + WS_MOD);
    __syncthreads();
    for (int it = F.vcu; it < DEPTH * 96; it += F.G) {
        const int l = it / 96, j = (it % 96) * 64 + F.lane;
        float acc[9];
#pragma unroll
        for (int s = 0; s < 9; ++s) acc[s] = 0.f;
        const float* aw = I.ada_w + (size_t)l * D * 6144 + j;
#pragma unroll 1
        for (int kb = 0; kb < 2; ++kb) {
            const int k0 = F.wave * 128 + kb * 64;
            float sv[9];
#pragma unroll
            for (int s = 0; s < 9; ++s) { const float cv = (s < 8) ? I.c[s * D + k0 + F.lane] : I.c_ctx[k0 + F.lane]; sv[s] = siluf_(cv); }
            float wv[64];
#pragma unroll
            for (int kk = 0; kk < 64; ++kk) wv[kk] = aw[(size_t)(k0 + kk) * 6144];
#pragma unroll
            for (int kk = 0; kk < 64; ++kk)
#pragma unroll
                for (int s = 0; s < 9; ++s) acc[s] += rl_f(sv[s], kk) * wv[kk];
        }
        LAS float* red = (LAS float*)F.lds;
#pragma unroll
        for (int s = 0; s < 9; ++s) red[(F.wave * 9 + s) * 64 + F.lane] = acc[s];
        __syncthreads();
        for (int i = F.tid; i < 9 * 64; i += 512) { float t = 0.f;
#pragma unroll
            for (int w = 0; w < 8; ++w) t += red[w * 576 + i];
            const int s = i >> 6, jj = (it % 96) * 64 + (i & 63);
            mod[(size_t)(l * 9 + s) * 6144 + jj] = t + I.ada_b[l * 6144 + jj]; }
        __syncthreads();
    }
    { bf16* lora = (bf16*)(ws + WS_LORA);
      for (int i = F.gw * 64 + F.lane; i < 4 * 2 * 256 * 32; i += F.NGW * 64) { const int r = i & 31, c = (i >> 5) & 255, ld = i >> 13;
          lora[i] = (bf16)f2bf(I.rw_w2[((size_t)ld * 32 + r) * 256 + c]); lora[LORA_A2T + i] = (bf16)f2bf(I.rw_a2[((size_t)ld * 32 + r) * 256 + c]); }
      for (int i = F.gw * 64 + F.lane; i < 4 * 256 * 64; i += F.NGW * 64) { const int r = i & 63, c = (i >> 6) & 255, l = i >> 14;
          lora[LORA_G2T + i] = (bf16)f2bf(I.rw_g2[((size_t)l * 64 + r) * 256 + c]); } }
    if (F.gw == 0) {
        for (int l = 0; l < DEPTH; ++l) {
            const float* dl = I.da_lambda + l * 256;
            const float s1 = wave_sum(dl[F.lane] * dl[64 + F.lane]), s2 = wave_sum(dl[128 + F.lane] * dl[192 + F.lane]);
            const float lam_init = 0.8f - 0.6f * expf(-0.3f * (float)l);
            if (F.lane == 0) mod[MOD_LAM + l] = expf(s1) - expf(s2) + lam_init;
        }
    }
    if (F.gw == 1) {
        for (int i = F.lane; i < 1024; i += 64) { const int pos = i >> 4, fi = i & 15;
            const float inv = powf(10000.0f, -(float)fi / 16.0f); const float ang = (float)pos * inv;
            mod[MOD_ROPE + 2 * i] = cosf(ang); mod[MOD_ROPE + 2 * i + 1] = sinf(ang); }
    }
}

__device__ __forceinline__ void conv_unit(Frame& F, const Inputs& I, int lsrc, int j) {
    LAS float* scr = (LAS float*)(F.lds + F.wave * 16384);
    if (j < 256) {
#pragma unroll 1
        for (int i = 0; i < 8; ++i) { const int r = j * 64 + i * 8 + F.wave; const int le = lsrc * NEXP + (r >> 9);
            transpose_item<1>(I.exp_w_gu + (size_t)le * D * 1024, D, 1024, (bf16*)(F.ws + WS_WGU) + (size_t)le * 1024 * D, scr, r & 511, F.lane); }
    } else {
#pragma unroll 1
        for (int i = 0; i < 8; ++i) { const int r = (j - 256) * 64 + i * 8 + F.wave; const int le = lsrc * NEXP + (r >> 8);
            transpose_item<0>(I.exp_w_down + (size_t)le * EH * D, EH, D, (bf16*)(F.ws + WS_WDN) + (size_t)le * D * EH, scr, r & 255, F.lane); }
    }
}

struct NormRow { f32x4 v[4]; v2u xb[4]; v2u ya[4], yb[4]; float w0, w1; int row, s; bool ok; };
template <int MODE>
__device__ __forceinline__ void norm_row_load(Frame& F, const Inputs& I, int rr, int nrows, NormRow& R) {
    R.ok = rr < nrows; const int row = R.ok ? rr % NT : NCX; R.row = row; R.s = row_seq(row);
    if (MODE == 2 && row < NCX) R.ok = false;
    const bf16* xs = (const bf16*)(F.ws + WS_XS);
    if (MODE == 0) { const GAS f32x4* xin = (row < NCX) ? (const GAS f32x4*)(I.ctx + (size_t)row * D) + F.lane : (const GAS f32x4*)(I.x + (size_t)(row - NCX) * D) + F.lane;
#pragma unroll
        for (int j = 0; j < 4; ++j) R.v[j] = xin[64 * j]; }
    else { const GAS v2u* xin = (const GAS v2u*)(xs + (size_t)row * D) + F.lane;
#pragma unroll
        for (int j = 0; j < 4; ++j) R.xb[j] = xin[64 * j]; }
    if (MODE != 0) {
        const int* route = (const int*)(F.ws + WS_ROUTE); const bf16* ys = (const bf16*)(F.ws + WS_YS);
        const int d0 = route[row * 8 + 6], d1 = route[row * 8 + 7];
        R.w0 = __builtin_bit_cast(float, route[row * 8 + 4]); R.w1 = __builtin_bit_cast(float, route[row * 8 + 5]);
        const GAS v2u* y0 = (const GAS v2u*)(ys + (size_t)d0 * D) + F.lane; const GAS v2u* y1 = (const GAS v2u*)(ys + (size_t)d1 * D) + F.lane;
#pragma unroll
        for (int j = 0; j < 4; ++j) { R.ya[j] = y0[64 * j]; R.yb[j] = y1[64 * j]; }
    }
}
template <int MODE>
__device__ __forceinline__ void norm_row_finish(Frame& F, const Inputs& I, int l, float* out, NormRow& R) {
    if (!R.ok) return;
    bf16* xs = (bf16*)(F.ws + WS_XS); const float* mod = (const float*)(F.ws + WS_MOD); bf16* h1 = (bf16*)(F.ws + WS_H1);
    const int row = R.row, s = R.s;
    if (MODE != 0) {
        GAS v2u* xr = (GAS v2u*)(xs + (size_t)row * D) + F.lane;
        const GAS f32x4* g2 = (const GAS f32x4*)(mod + (size_t)((l - 1) * 9 + s) * 6144 + 5120) + F.lane;
#pragma unroll
        for (int j = 0; j < 4; ++j) { const v2u ua = R.ya[j], ub = R.yb[j]; const f32x4 g = g2[64 * j];
            const f32x4 a = {bflo(ua.x), bfhi(ua.x), bflo(ua.y), bfhi(ua.y)}, b = {bflo(ub.x), bfhi(ub.x), bflo(ub.y), bfhi(ub.y)};
            const v2u ux = R.xb[j]; const f32x4 x0 = {bflo(ux.x), bfhi(ux.x), bflo(ux.y), bfhi(ux.y)};
            R.v[j] = x0 + g * (a * R.w0 + b * R.w1);
            if (MODE == 1) { v2u w; w.x = pk2(R.v[j].x, R.v[j].y); w.y = pk2(R.v[j].z, R.v[j].w); xr[64 * j] = w;
                R.v[j] = (f32x4){bflo(w.x), bfhi(w.x), bflo(w.y), bfhi(w.y)}; } }
    }
    float ss = 0.f;
#pragma unroll
    for (int j = 0; j < 4; ++j) ss += (R.v[j].x * R.v[j].x + R.v[j].y * R.v[j].y) + (R.v[j].z * R.v[j].z + R.v[j].w * R.v[j].w);
    const float rstd = __builtin_amdgcn_rsqf(wave_sum(ss) * (1.f / D) + NORM_EPS);
    if (MODE == 2) {
        GAS f32x4* o = (GAS f32x4*)(out + (size_t)(row - NCX) * D) + F.lane;
        const GAS f32x4* fg = (const GAS f32x4*)I.final_g + F.lane;
#pragma unroll
        for (int j = 0; j < 4; ++j) o[64 * j] = R.v[j] * rstd * fg[64 * j];
    } else {
        const GAS f32x4* ng = (const GAS f32x4*)(I.norm1_g + l * D) + F.lane;
        const GAS f32x4* sh = (const GAS f32x4*)(mod + (size_t)(l * 9 + s) * 6144) + F.lane;
        const GAS f32x4* sc = (const GAS f32x4*)(mod + (size_t)(l * 9 + s) * 6144 + 1024) + F.lane;
        GAS v2u* o = (GAS v2u*)(h1 + (size_t)row * D) + F.lane;
#pragma unroll
        for (int j = 0; j < 4; ++j) { const f32x4 y = (R.v[j] * rstd * ng[64 * j]) * (sc[64 * j] + 1.0f) + sh[64 * j];
            v2u w; w.x = pk2(y.x, y.y); w.y = pk2(y.z, y.w); o[64 * j] = w; }
    }
}
struct NParams { f32x4 g2[4], ng[4], sh[4], sc[4]; };
struct NRec { int d0, d1; float w0, w1; };
struct NRow { f32x4 v[4]; v2u xb[4], ya[4], yb[4]; float w0, w1; };
template <int MODE>
__device__ __forceinline__ void np_load(Frame& F, const Inputs& I, int l, int s, NParams& P) {
    const float* mod = (const float*)(F.ws + WS_MOD);
    if (MODE != 0) { const GAS f32x4* g2 = (const GAS f32x4*)(mod + (size_t)((l - 1) * 9 + s) * 6144 + 5120) + F.lane;
#pragma unroll
        for (int j = 0; j < 4; ++j) P.g2[j] = g2[64 * j]; }
    if (MODE == 2) { const GAS f32x4* fg = (const GAS f32x4*)I.final_g + F.lane;
#pragma unroll
        for (int j = 0; j < 4; ++j) P.ng[j] = fg[64 * j]; }
    else { const GAS f32x4* ng = (const GAS f32x4*)(I.norm1_g + l * D) + F.lane;
        const GAS f32x4* sh = (const GAS f32x4*)(mod + (size_t)(l * 9 + s) * 6144) + F.lane; const GAS f32x4* sc = (const GAS f32x4*)(mod + (size_t)(l * 9 + s) * 6144 + 1024) + F.lane;
#pragma unroll
        for (int j = 0; j < 4; ++j) { P.ng[j] = ng[64 * j]; P.sh[j] = sh[64 * j]; P.sc[j] = sc[64 * j]; } }
}
__device__ __forceinline__ void nrec_load(Frame& F, int row, NRec& R) {
    const GAS int* rp = (const GAS int*)(F.ws + WS_ROUTE) + (size_t)row * 8;
    R.d0 = rp[6]; R.d1 = rp[7]; R.w0 = __builtin_bit_cast(float, rp[4]); R.w1 = __builtin_bit_cast(float, rp[5]);
}
template <int MODE>
__device__ __forceinline__ void nrow_load(Frame& F, const Inputs& I, int row, const NRec& rec, NRow& R) {
    if (MODE == 0) { const GAS f32x4* xin = (row < NCX) ? (const GAS f32x4*)(I.ctx + (size_t)row * D) + F.lane : (const GAS f32x4*)(I.x + (size_t)(row - NCX) * D) + F.lane;
#pragma unroll
        for (int j = 0; j < 4; ++j) R.v[j] = xin[64 * j]; }
    else { const bf16* xs = (const bf16*)(F.ws + WS_XS); const bf16* ys = (const bf16*)(F.ws + WS_YS);
        const GAS v2u* xin = (const GAS v2u*)(xs + (size_t)row * D) + F.lane;
        const GAS v2u* y0 = (const GAS v2u*)(ys + (size_t)rec.d0 * D) + F.lane; const GAS v2u* y1 = (const GAS v2u*)(ys + (size_t)rec.d1 * D) + F.lane;
#pragma unroll
        for (int j = 0; j < 4; ++j) { R.xb[j] = xin[64 * j]; R.ya[j] = y0[64 * j]; R.yb[j] = y1[64 * j]; }
        R.w0 = rec.w0; R.w1 = rec.w1; }
}
template <int MODE>
__device__ __forceinline__ void nrow_finish(Frame& F, float* out, int row, NRow& R, const NParams& P) {
    bf16* xs = (bf16*)(F.ws + WS_XS); bf16* h1 = (bf16*)(F.ws + WS_H1);
    if (MODE != 0) {
        GAS v2u* xr = (GAS v2u*)(xs + (size_t)row * D) + F.lane;
#pragma unroll
        for (int j = 0; j < 4; ++j) { const v2u ua = R.ya[j], ub = R.yb[j];
            const f32x4 a = {bflo(ua.x), bfhi(ua.x), bflo(ua.y), bfhi(ua.y)}, b = {bflo(ub.x), bfhi(ub.x), bflo(ub.y), bfhi(ub.y)};
            const v2u ux = R.xb[j]; const f32x4 x0 = {bflo(ux.x), bfhi(ux.x), bflo(ux.y), bfhi(ux.y)};
            R.v[j] = x0 + P.g2[j] * (a * R.w0 + b * R.w1);
            if (MODE == 1) { v2u w; w.x = pk2(R.v[j].x, R.v[j].y); w.y = pk2(R.v[j].z, R.v[j].w); xr[64 * j] = w;
                R.v[j] = (f32x4){bflo(w.x), bfhi(w.x), bflo(w.y), bfhi(w.y)}; } }
    }
    float ss = 0.f;
#pragma unroll
    for (int j = 0; j < 4; ++j) ss += (R.v[j].x * R.v[j].x + R.v[j].y * R.v[j].y) + (R.v[j].z * R.v[j].z + R.v[j].w * R.v[j].w);
    const float rstd = __builtin_amdgcn_rsqf(wave_sum(ss) * (1.f / D) + NORM_EPS);
    if (MODE == 2) { GAS f32x4* o = (GAS f32x4*)(out + (size_t)(row - NCX) * D) + F.lane;
#pragma unroll
        for (int j = 0; j < 4; ++j) o[64 * j] = R.v[j] * rstd * P.ng[j];
    } else { GAS v2u* o = (GAS v2u*)(h1 + (size_t)row * D) + F.lane;
#pragma unroll
        for (int j = 0; j < 4; ++j) { const f32x4 y = (R.v[j] * rstd * P.ng[j]) * (P.sc[j] + 1.0f) + P.sh[j];
            v2u w; w.x = pk2(y.x, y.y); w.y = pk2(y.z, y.w); o[64 * j] = w; }
    }
}
template <int MODE>
__device__ __forceinline__ void p_norm1_blk(Frame& F, const Inputs& I, int l, float* out) {
    constexpr int RPW = (MODE == 2) ? NXR / 2048 : NT / 2048;
    static_assert(NXR % 2048 == 0 && NT % 2048 == 0, "row blocks");
    const int r0 = ((MODE == 2) ? NCX : 0) + F.gw * RPW;
    int cur_s = row_seq(r0); NParams P; np_load<MODE>(F, I, l, cur_s, P);
    NRec rc0, rc1; NRow A, B;
#define NROWC(k_) (r0 + (((k_) < RPW) ? (k_) : RPW - 1))
#define NFIN(k_, R_) do { const int row_ = r0 + (k_); const int s_ = row_seq(row_); if (s_ != cur_s) { cur_s = s_; np_load<MODE>(F, I, l, cur_s, P); } nrow_finish<MODE>(F, out, row_, R_, P); } while (0)
    if (MODE != 0) { nrec_load(F, NROWC(0), rc0); nrec_load(F, NROWC(1), rc1); }
    nrow_load<MODE>(F, I, NROWC(0), rc0, A);
#pragma unroll 1
    for (int k = 0; k < RPW; k += 2) {
        if (MODE != 0) nrec_load(F, NROWC(k + 2), rc0);
        nrow_load<MODE>(F, I, NROWC(k + 1), rc1, B);
        NFIN(k, A);
        if (MODE != 0) nrec_load(F, NROWC(k + 3), rc1);
        nrow_load<MODE>(F, I, NROWC(k + 2), rc0, A);
        if (k + 1 < RPW) NFIN(k + 1, B);
    }
#undef NROWC
#undef NFIN
}
template <int MODE>
__device__ __forceinline__ void p_norm1(Frame& F, const Inputs& I, int l, float* out, int reps = 1) {
    if (F.G == 256 && reps == 1) { p_norm1_blk<MODE>(F, I, l, out); return; }
    const int nrows = reps * NT;
    NormRow A, B;
    norm_row_load<MODE>(F, I, F.gw, nrows, A);
    for (int rr = F.gw; rr < nrows; rr += 2 * F.NGW) {
        norm_row_load<MODE>(F, I, rr + F.NGW, nrows, B);
        norm_row_finish<MODE>(F, I, l, out, A);
        norm_row_load<MODE>(F, I, rr + 2 * F.NGW, nrows, A);
        norm_row_finish<MODE>(F, I, l, out, B);
    }
}

template <int NN>
struct StaticOrderT {
    int nM, nwg, G, c, pm0;
    __device__ void init(int M, int  , int G_, int c_, int pm0_ = 0) { nM = M / 256; nwg = nM * NN; G = G_; c = c_; pm0 = pm0_; }
    __device__ bool next(int i, pg8::Unit& u) const {
        const int L = i * G + c; if (L >= nwg) return false;
        const int grp = L / (8 * NN), rem = L % (8 * NN);
        u.pm = pm0 + grp * 8 + (rem & 7); u.pn = rem >> 3; u.boff = 0; return true;
    }
};

constexpr float QSCALE = 0.125f * 1.4426950408889634f;
struct EpiZ {
    static constexpr bool PERM = true;
    bf16* O; int ldc; unsigned char* ws;
    __device__ __forceinline__ void operator()(const pg8::f32x4 (&acc)[2][2][4][2], const pg8::Unit& u, int wr, int wc, int fr, int fq) const {
        const int row0 = u.pm * 256 + wr * 64 + fr;
        if (u.pn >= 6) {
            const int col0 = u.pn * 256 + wc * 32 + 8 * fq;
#pragma unroll
            for (int ai = 0; ai < 2; ++ai)
#pragma unroll
                for (int m = 0; m < 4; ++m) { bf16* rowp = O + (size_t)(row0 + ai * 128 + m * 16) * ldc + col0;
#pragma unroll
                    for (int bj = 0; bj < 2; ++bj) { const pg8::f32x4 v0 = acc[ai][bj][m][0], v1 = acc[ai][bj][m][1];
                        v4u w; w.x = pg8::cvt_pk_bf16(v0[0], v0[1]); w.y = pg8::cvt_pk_bf16(v0[2], v0[3]); w.z = pg8::cvt_pk_bf16(v1[0], v1[1]); w.w = pg8::cvt_pk_bf16(v1[2], v1[3]);
                        *(v4u*)(rowp + bj * 128) = w; } }
            return;
        }
        const bool isctx = u.pm < (NCX / 256);
        const int b = isctx ? (u.pm * 256) / TC : (u.pm * 256 - NCX) / T;
        const int tb = isctx ? (u.pm * 256) % TC : (u.pm * 256 - NCX) % T;
        const int kind = u.pn >> 1;
        const float* rope = (const float*)(ws + WS_MOD) + MOD_ROPE;
        const int lane = fr + 16 * fq;
#pragma unroll
        for (int ai = 0; ai < 2; ++ai)
#pragma unroll
            for (int m = 0; m < 4; ++m) {
                const int t = tb + wr * 64 + fr + ai * 128 + m * 16;
#pragma unroll
                for (int bj = 0; bj < 2; ++bj) {
                    float v[8];
#pragma unroll
                    for (int n = 0; n < 2; ++n)
#pragma unroll
                        for (int e = 0; e < 4; ++e) v[4 * n + e] = acc[ai][bj][m][n][e];
                    if (kind == 2) {
                        const int h = 2 * (u.pn - 4) + bj, off = 32 * wc + 8 * fq;
                        v4u w; w.x = pg8::cvt_pk_bf16(v[0], v[1]); w.y = pg8::cvt_pk_bf16(v[2], v[3]); w.z = pg8::cvt_pk_bf16(v[4], v[5]); w.w = pg8::cvt_pk_bf16(v[6], v[7]);
                        *(v4u*)((bf16*)(ws + WS_VB) + ((size_t)(b * 4 + h) * TK + (isctx ? t : TC + t)) * 128 + off) = w;
                    } else {
                        const int hm = 4 * (u.pn & 1) + 2 * bj + (wc >> 1), o = 32 * (wc & 1) + 8 * fq;
                        if (!isctx) {
                            const int pos = (wc & 1) ? (t & 63) : (t >> 6);
                            const float* cs = rope + 2 * (pos * 16 + 8 * (fq & 1));
                            const bool second = fq >= 2;
#pragma unroll
                            for (int e = 0; e < 8; ++e) {
                                const auto sw = __builtin_amdgcn_permlane32_swap(__builtin_bit_cast(unsigned, v[e]), __builtin_bit_cast(unsigned, v[e]), false, false);
                                const float pv = __builtin_bit_cast(float, (lane < 32) ? sw[1] : sw[0]);
                                const float c = cs[2 * e], sn = cs[2 * e + 1];
                                v[e] = second ? (pv * sn + v[e] * c) : (v[e] * c - pv * sn);
                            }
                        }
                        if (kind == 0) {
#pragma unroll
                            for (int e = 0; e < 8; ++e) v[e] *= QSCALE; }
                        v4u w; w.x = pg8::cvt_pk_bf16(v[0], v[1]); w.y = pg8::cvt_pk_bf16(v[2], v[3]); w.z = pg8::cvt_pk_bf16(v[4], v[5]); w.w = pg8::cvt_pk_bf16(v[6], v[7]);
                        bf16* dst;
                        if (kind == 0) dst = isctx ? (bf16*)(ws + WS_QC) + ((size_t)(b * 8 + hm) * TC + t) * 64 + o : (bf16*)(ws + WS_QB) + ((size_t)(b * 8 + hm) * T + t) * 64 + o;
                        else dst = (bf16*)(ws + WS_KB) + ((size_t)(b * 8 + hm) * TK + (isctx ? t : TC + t)) * 64 + o;
                        *(v4u*)dst = w;
                    }
                }
            }
    }
};
struct EpiResid {
    static constexpr bool PERM = true; static constexpr bool NTB = false;
    bf16* X; const float* mod_g;
    const float* src_c; const float* src_x;
    __device__ __forceinline__ void operator()(const pg8::f32x4 (&acc)[2][2][4][2], const pg8::Unit& u, int wr, int wc, int fr, int fq) const {
        const int row0 = u.pm * 256 + wr * 64 + fr, col0 = u.pn * 256 + wc * 32 + 8 * fq;
        const int s = row_seq(u.pm * 256);
        pg8::f32x4 gv[2][2];
#pragma unroll
        for (int bj = 0; bj < 2; ++bj)
#pragma unroll
            for (int n = 0; n < 2; ++n) gv[bj][n] = *(const GAS pg8::f32x4*)(mod_g + (size_t)s * 6144 + col0 + bj * 128 + 4 * n);
#pragma unroll
        for (int ai = 0; ai < 2; ++ai)
#pragma unroll
            for (int m = 0; m < 4; ++m) { const int row = row0 + ai * 128 + m * 16; bf16* rowp = X + (size_t)row * D + col0;
#pragma unroll
                for (int bj = 0; bj < 2; ++bj) {
                    float r[8];
                    if (src_x) { const float* srcp = (row < NCX) ? src_c + (size_t)row * D + col0 : src_x + (size_t)(row - NCX) * D + col0;
                        const pg8::f32x4 a = *(const GAS pg8::f32x4*)(srcp + bj * 128), b = *(const GAS pg8::f32x4*)(srcp + bj * 128 + 4);
                        r[0] = a[0]; r[1] = a[1]; r[2] = a[2]; r[3] = a[3]; r[4] = b[0]; r[5] = b[1]; r[6] = b[2]; r[7] = b[3]; }
                    else { const v4u w = *(const GAS v4u*)(rowp + bj * 128); unpack8(w, r); }
#pragma unroll
                    for (int n = 0; n < 2; ++n)
#pragma unroll
                        for (int e = 0; e < 4; ++e) r[4 * n + e] += gv[bj][n][e] * acc[ai][bj][m][n][e];
                    v4u o; o.x = pg8::cvt_pk_bf16(r[0], r[1]); o.y = pg8::cvt_pk_bf16(r[2], r[3]); o.z = pg8::cvt_pk_bf16(r[4], r[5]); o.w = pg8::cvt_pk_bf16(r[6], r[7]);
                    *(GAS v4u*)(rowp + bj * 128) = o; } }
    }
};
struct EpiSwiGLU {
    static constexpr bool PERM = true;
    bf16* O;
    __device__ __forceinline__ void operator()(const pg8::f32x4 (&acc)[2][2][4][2], const pg8::Unit& u, int wr, int wc, int fr, int fq) const {
        const int row0 = u.pm * 256 + wr * 64 + fr, col0 = u.pn * 128 + wc * 32 + 8 * fq;
#pragma unroll
        for (int ai = 0; ai < 2; ++ai)
#pragma unroll
            for (int m = 0; m < 4; ++m) { bf16* rowp = O + (size_t)(row0 + ai * 128 + m * 16) * EH + col0;
                float a[8];
#pragma unroll
                for (int n = 0; n < 2; ++n)
#pragma unroll
                    for (int e = 0; e < 4; ++e) { const float g = acc[ai][0][m][n][e], up = acc[ai][1][m][n][e]; a[n * 4 + e] = siluf_(g) * up; }
                v4u w; w.x = pg8::cvt_pk_bf16(a[0], a[1]); w.y = pg8::cvt_pk_bf16(a[2], a[3]); w.z = pg8::cvt_pk_bf16(a[4], a[5]); w.w = pg8::cvt_pk_bf16(a[6], a[7]);
                *(v4u*)rowp = w; }
    }
};
struct EpiY16 {
    static constexpr bool PERM = true;
    bf16* O;
    __device__ __forceinline__ void operator()(const pg8::f32x4 (&acc)[2][2][4][2], const pg8::Unit& u, int wr, int wc, int fr, int fq) const {
        const int row0 = u.pm * 256 + wr * 64 + fr, col0 = u.pn * 256 + wc * 32 + 8 * fq;
#pragma unroll
        for (int ai = 0; ai < 2; ++ai)
#pragma unroll
            for (int m = 0; m < 4; ++m) { bf16* rowp = O + (size_t)(row0 + ai * 128 + m * 16) * D + col0;
#pragma unroll
                for (int bj = 0; bj < 2; ++bj) { const pg8::f32x4 v0 = acc[ai][bj][m][0], v1 = acc[ai][bj][m][1];
                    v4u w; w.x = pg8::cvt_pk_bf16(v0[0], v0[1]); w.y = pg8::cvt_pk_bf16(v0[2], v0[3]); w.z = pg8::cvt_pk_bf16(v1[0], v1[1]); w.w = pg8::cvt_pk_bf16(v1[2], v1[3]);
                    *(v4u*)(rowp + bj * 128) = w; } }
    }
};
struct EpiF32 {
    static constexpr bool PERM = false;
    float* C;
    __device__ __forceinline__ void operator()(const pg8::f32x4 (&acc)[2][2][4][2], const pg8::Unit& u, int wr, int wc, int fr, int fq) const {
        const int row0 = u.pm * 256 + wr * 64 + fr, col0 = u.pn * 256 + wc * 32 + 4 * fq;
#pragma unroll
        for (int ai = 0; ai < 2; ++ai)
#pragma unroll
            for (int m = 0; m < 4; ++m) { float* rowp = C + (size_t)(row0 + ai * 128 + m * 16) * D + col0;
#pragma unroll
                for (int bj = 0; bj < 2; ++bj)
#pragma unroll
                    for (int n = 0; n < 2; ++n) *(pg8::f32x4*)(rowp + bj * 128 + n * 16) = acc[ai][bj][m][n]; }
    }
};
struct MoeOrder {
    const volatile LAS int* blkend;
    int G, c; size_t wstride;
    __device__ bool next(int i, pg8::Unit& u) const {
        const int nblk = blkend[31];
        const long L = (long)i * G + c; if (L >= (long)nblk * 4) return false;
        const int rb = (int)(L >> 2); u.pm = rb; u.pn = (int)(L & 3);
        int e = 0;
#pragma unroll 1
        for (int k = 0; k < 31; ++k) e += (rb >= blkend[k]) ? 1 : 0;
        u.boff = (size_t)e * wstride; return true;
    }
};

__device__ __forceinline__ void p3_rope(Frame& F, int l) {
    const bf16* Z = (const bf16*)(F.ws + WS_Z);
    const float* rope = (const float*)(F.ws + WS_MOD) + MOD_ROPE;
    bf16* QB = (bf16*)(F.ws + WS_QB); bf16* QC = (bf16*)(F.ws + WS_QC); bf16* KB = (bf16*)(F.ws + WS_KB); bf16* VB = (bf16*)(F.ws + WS_VB);
    const int L = F.lane;
    const int hm = L >> 3, o = (L & 7) * 8;
    const int blk = o >> 5, p = o & 31;
    const int fi0 = p & 15; const bool second = p >= 16;
    for (int row = F.gw; row < NT; row += F.NGW) {
        const bf16* zr = Z + (size_t)row * NPAD;
        const v4u qw = *(const GAS v4u*)(zr + ZQ + 8 * L), kw = *(const GAS v4u*)(zr + ZK + 8 * L), vw = *(const GAS v4u*)(zr + ZV + 8 * L);
        if (row < NCX) {
            const int b = row >> 8, t = row & 255;
            { float qf[8]; unpack8(qw, qf); v4u qs; qs.x = pk2(qf[0] * QSCALE, qf[1] * QSCALE); qs.y = pk2(qf[2] * QSCALE, qf[3] * QSCALE); qs.z = pk2(qf[4] * QSCALE, qf[5] * QSCALE); qs.w = pk2(qf[6] * QSCALE, qf[7] * QSCALE);
              *(GAS v4u*)(QC + ((size_t)(b * 8 + hm) * TC + t) * 64 + o) = qs; }
            *(GAS v4u*)(KB + ((size_t)(b * 8 + hm) * TK + t) * 64 + o) = kw;
            *(GAS v4u*)(VB + ((size_t)(b * 4 + (L >> 4)) * TK + t) * 128 + (L & 15) * 8) = vw;
        } else {
            const int r2 = row - NCX, b = r2 >> 12, t = r2 & 4095;
            const int pos = blk ? (t & 63) : (t >> 6);
            float q[8], k[8], qp[8], kp[8];
            unpack8(qw, q); unpack8(kw, k);
#pragma unroll
            for (int e = 0; e < 8; ++e) { qp[e] = __builtin_bit_cast(float, __builtin_amdgcn_update_dpp(0, __builtin_bit_cast(int, q[e]), 0x4E, 0xF, 0xF, false)); kp[e] = __builtin_bit_cast(float, __builtin_amdgcn_update_dpp(0, __builtin_bit_cast(int, k[e]), 0x4E, 0xF, 0xF, false)); }
            float qo[8], ko[8];
#pragma unroll
            for (int e = 0; e < 8; ++e) { const float cs = rope[2 * (pos * 16 + fi0 + e)], sn = rope[2 * (pos * 16 + fi0 + e) + 1];
                qo[e] = second ? (qp[e] * sn + q[e] * cs) : (q[e] * cs - qp[e] * sn);
                ko[e] = second ? (kp[e] * sn + k[e] * cs) : (k[e] * cs - kp[e] * sn); }
#pragma unroll
            for (int e = 0; e < 8; ++e) qo[e] *= QSCALE;
            v4u qq, kk2; qq.x = pk2(qo[0], qo[1]); qq.y = pk2(qo[2], qo[3]); qq.z = pk2(qo[4], qo[5]); qq.w = pk2(qo[6], qo[7]);
            kk2.x = pk2(ko[0], ko[1]); kk2.y = pk2(ko[2], ko[3]); kk2.z = pk2(ko[4], ko[5]); kk2.w = pk2(ko[6], ko[7]);
            *(GAS v4u*)(QB + ((size_t)(b * 8 + hm) * T + t) * 64 + o) = qq;
            *(GAS v4u*)(KB + ((size_t)(b * 8 + hm) * TK + TC + t) * 64 + o) = kk2;
            *(GAS v4u*)(VB + ((size_t)(b * 4 + (L >> 4)) * TK + TC + t) * 128 + (L & 15) * 8) = vw;
        }
    }
}

__device__ __forceinline__ float zshift(const bf16* z0, const bf16* zm, const bf16* zp, bool hm_, bool hp_, int col, float mu) {
    const float a = bf2f(z0[col]); const float m = hm_ ? bf2f(zm[col]) : 0.f; const float p = hp_ ? bf2f(zp[col]) : 0.f;
    return a + mu * (0.5f * (m + p) - a);
}
__device__ __forceinline__ void ml_chunk_rows(int dir, int b, int cc, int& row0, int& t0, int& len) {
    if (cc < 2) { const int j = dir ? 1 - cc : cc; t0 = j * 128; len = TC; row0 = b * TC + t0; }
    else { const int j = dir ? 31 - (cc - 2) : (cc - 2); t0 = j * 128; len = T; row0 = NCX + b * T + t0; }
}
__device__ __forceinline__ float log_sigmoid_(float x) { return fminf(x, 0.f) - __logf(1.0f + __expf(-fabsf(x))); }
__device__ __forceinline__ void ml_gates(Frame& F, const Inputs& I, int l, int dir, int h, int row0, LAS float* gb, LAS float* gi) {
    const bf16* Z = (const bf16*)(F.ws + WS_Z);
    const float* gbias = I.ml_gate_b + l * 16;
    if (F.tid < 128) {
        const int s = F.tid, tau = dir ? 127 - s : s;
        const bf16* zr = Z + (size_t)(row0 + tau) * NPAD + ZML + 1024;
        gi[s] = bf2f(zr[dir * 8 + h]) + ((const GAS float*)gbias)[dir * 8 + h];
        gb[s] = log_sigmoid_(bf2f(zr[dir * 8 + 4 + h]) + ((const GAS float*)gbias)[dir * 8 + 4 + h]);
    }
    __syncthreads();
    if (F.wave == 0) {
        const float a = gb[2 * F.lane], c = gb[2 * F.lane + 1]; const float pr = a + c; float inc = pr;
#pragma unroll
        for (int o = 1; o < 64; o <<= 1) { const float n = __shfl_up(inc, o); if (F.lane >= o) inc += n; }
        const float ex = inc - pr; gb[2 * F.lane] = ex + a; gb[2 * F.lane + 1] = ex + pr;
    }
    __syncthreads();
}
__device__ __forceinline__ void ml_conv16(const bf16* Z, const Inputs& I, int l, int row, int t, int len, int colbase, float scale, float* outv) {
    const bf16* z0 = Z + (size_t)row * NPAD + ZML + colbase;
    const float* cw = I.ml_conv_w + (size_t)l * 3 * 512 + colbase; const float* cb = I.ml_conv_b + l * 512 + colbase;
    float a0[16], am[16], ap[16];
    { const v4u w0 = *(const GAS v4u*)z0, w1 = *(const GAS v4u*)(z0 + 8); unpack8(w0, a0); unpack8(w1, a0 + 8); }
    if (t > 0) { const v4u w0 = *(const GAS v4u*)(z0 - NPAD), w1 = *(const GAS v4u*)(z0 - NPAD + 8); unpack8(w0, am); unpack8(w1, am + 8); }
    else {
#pragma unroll
        for (int e = 0; e < 16; ++e) am[e] = 0.f; }
    if (t < len - 1) { const v4u w0 = *(const GAS v4u*)(z0 + NPAD), w1 = *(const GAS v4u*)(z0 + NPAD + 8); unpack8(w0, ap); unpack8(w1, ap + 8); }
    else {
#pragma unroll
        for (int e = 0; e < 16; ++e) ap[e] = 0.f; }
    float w0_[16], w1_[16], w2_[16], bb_[16];
#pragma unroll
    for (int q = 0; q < 4; ++q) { const f32x4 x0 = *(const GAS f32x4*)(cw + 4 * q), x1 = *(const GAS f32x4*)(cw + 512 + 4 * q), x2 = *(const GAS f32x4*)(cw + 1024 + 4 * q), x3 = *(const GAS f32x4*)(cb + 4 * q);
        w0_[4 * q] = x0.x; w0_[4 * q + 1] = x0.y; w0_[4 * q + 2] = x0.z; w0_[4 * q + 3] = x0.w; w1_[4 * q] = x1.x; w1_[4 * q + 1] = x1.y; w1_[4 * q + 2] = x1.z; w1_[4 * q + 3] = x1.w;
        w2_[4 * q] = x2.x; w2_[4 * q + 1] = x2.y; w2_[4 * q + 2] = x2.z; w2_[4 * q + 3] = x2.w; bb_[4 * q] = x3.x; bb_[4 * q + 1] = x3.y; bb_[4 * q + 2] = x3.z; bb_[4 * q + 3] = x3.w; }
#pragma unroll
    for (int e = 0; e < 16; ++e) { const float y = am[e] * w0_[e] + a0[e] * w1_[e] + ap[e] * w2_[e] + bb_[e]; outv[e] = siluf_(y) * scale; }
}
constexpr int MLS = 136;
constexpr int MLD = 72;
__device__ __forceinline__ bf16x8 lds_frag(const LAS bf16* p) { return *(const LAS bf16x8*)p; }


constexpr int RW_NCH = (TC + T) / 16;
constexpr int RWC_EL = 7424;
constexpr int RWC_PSI = 4096, RWC_RP = 5120, RWC_VT = 6144, RWC_OM = 7168;
constexpr int RWP_WAVE_LDS = 15744;
__device__ __forceinline__ bf16x8 frag16(const LAS bf16* base, int lr, int kg) {
    bf16x8 z = {0, 0, 0, 0, 0, 0, 0, 0};
    return (kg < 2) ? *(const LAS bf16x8*)(base + lr * 16 + kg * 8) : z;
}
#define WAVE_LDS_SYNC() asm volatile("s_waitcnt lgkmcnt(0)" ::: "memory")
__device__ __forceinline__ void rwkv_chunk_pre(Frame& F, const Inputs& I, int l, int reps) {
    const bf16* Z = (const bf16*)(F.ws + WS_Z);
    bf16* RWC = (bf16*)(F.ws + WS_RWC); float* RG = (float*)(F.ws + WS_RG); float* RBS = (float*)(F.ws + WS_RBS); float* RV = (float*)(F.ws + WS_RV);
    LAS unsigned char* wl = F.lds + F.wave * RWP_WAVE_LDS;
    LAS bf16* KH = (LAS bf16*)(wl); LAS bf16* RH = (LAS bf16*)(wl + 2304); LAS bf16* BC = (LAS bf16*)(wl + 4608); LAS bf16* KC = (LAS bf16*)(wl + 6912);
    LAS bf16* BTj = (LAS bf16*)(wl + 9216);
    LAS float* Aab = (LAS float*)(wl + 11264);
    LAS float* Bak = (LAS float*)(wl + 12352);
    LAS float* EC = (LAS float*)(wl + 13440);
    LAS bf16* VS = (LAS bf16*)(wl + 13696);
    LAS bf16* TT = KH; LAS bf16* AakT = KH + 256; LAS bf16* Bab = KH + 512; LAS bf16* Ws = KH + 768;
    LAS bf16* KHj = BC; LAS bf16* Pj = BC;
    const int L = F.lane, lr = L & 15, kg = L >> 4;
    const float* mu = I.rw_shift_mu + l * 960;
    for (int uu_ = F.gw; uu_ < reps * 64 * RW_NCH; uu_ += F.NGW) {
        const int u = uu_ % (64 * RW_NCH);
        const int chain = u / RW_NCH, ck = u % RW_NCH, dir = chain >> 5, b = (chain >> 2) & 7, h = chain & 3;
        const int c = h * 64 + L;
        int rowbase, tbase, len;
        if (ck < 16) { len = TC; tbase = dir ? TC - 1 - ck * 16 : ck * 16; rowbase = b * TC; }
        else { len = T; tbase = dir ? T - 1 - (ck - 16) * 16 : (ck - 16) * 16; rowbase = NCX + b * T; }
        const int tlo = dir ? tbase - 15 : tbase;
        const bf16* zb = Z + (size_t)(rowbase + tlo - 1) * NPAD + ZRW;
        const bool lo_ok = tlo > 0, hi_ok = tlo + 16 < len;
        const bf16* lora = (const bf16*)(F.ws + WS_LORA);
        if (dir == 0) {
            const float mug = ((const GAS float*)mu)[896 + L];
            float zg[18];
#pragma unroll
            for (int r = 0; r < 18; ++r) zg[r] = ((r == 0 && !lo_ok) || (r == 17 && !hi_ok)) ? 0.f : bf2f(zb[(size_t)r * NPAD + 896 + L]);
#pragma unroll
            for (int i = 0; i < 16; ++i) RH[i * 72 + L] = (bf16)f2bf(sigmoidf_(zg[i + 1] + mug * (0.5f * (zg[i] + zg[i + 2]) - zg[i + 1])));
            WAVE_LDS_SYNC();
            const bf16x8 ga0 = lds_frag(RH + lr * 72 + kg * 8), ga1 = lds_frag(RH + lr * 72 + 32 + kg * 8);
            WAVE_LDS_SYNC();
#pragma unroll
            for (int nt = 0; nt < 4; ++nt) { const bf16* gp = lora + LORA_G2T + ((size_t)(l * 256 + h * 64 + 16 * nt + lr)) * 64 + kg * 8;
                f32x4 acc = {0.f, 0.f, 0.f, 0.f};
                acc = __builtin_amdgcn_mfma_f32_16x16x32_bf16(ga0, *(const GAS bf16x8*)gp, acc, 0, 0, 0);
                acc = __builtin_amdgcn_mfma_f32_16x16x32_bf16(ga1, *(const GAS bf16x8*)(gp + 32), acc, 0, 0, 0);
#pragma unroll
                for (int r = 0; r < 4; ++r) RG[(size_t)(rowbase + tlo + 4 * kg + r) * 256 + h * 64 + 16 * nt + lr] = acc[r]; }
        }
        {
            const float w0c = ((const GAS float*)I.rw_w0)[(l * 2 + dir) * 256 + c], a0c = ((const GAS float*)I.rw_a0)[(l * 2 + dir) * 256 + c];
            const float kkc = ((const GAS float*)I.rw_k_k)[l * 256 + c], kac = ((const GAS float*)I.rw_k_a)[l * 256 + c], rkc = ((const GAS float*)I.rw_r_k)[l * 256 + c];
            const float mur = ((const GAS float*)mu)[c], muk = ((const GAS float*)mu)[256 + c], muv = ((const GAS float*)mu)[512 + c];
            const int lcol = (L < 32) ? (768 + dir * 32 + L) : (832 + dir * 32 + (L - 32));
            const float mul = ((const GAS float*)mu)[lcol];
            { float zr[18], zk[18], zv[18], zl[18];
#pragma unroll
              for (int r = 0; r < 18; ++r) { const bool ok = !((r == 0 && !lo_ok) || (r == 17 && !hi_ok)); const bf16* zp_ = zb + (size_t)r * NPAD;
                  zr[r] = ok ? bf2f(zp_[c]) : 0.f; zk[r] = ok ? bf2f(zp_[256 + c]) : 0.f; zv[r] = ok ? bf2f(zp_[512 + c]) : 0.f; zl[r] = ok ? bf2f(zp_[lcol]) : 0.f; }
#pragma unroll
              for (int i = 0; i < 16; ++i) {
                  const int s = dir ? 15 - i : i;
                  RH[s * 72 + L] = (bf16)f2bf(zr[i + 1] + mur * (0.5f * (zr[i] + zr[i + 2]) - zr[i + 1]));
                  KH[s * 72 + L] = (bf16)f2bf(zk[i + 1] + muk * (0.5f * (zk[i] + zk[i + 2]) - zk[i + 1]));
                  VS[s * 64 + L] = (bf16)f2bf(zv[i + 1] + muv * (0.5f * (zv[i] + zv[i + 2]) - zv[i + 1]));
                  const float lv = zl[i + 1] + mul * (0.5f * (zl[i] + zl[i + 2]) - zl[i + 1]);
                  BC[s * 72 + L] = (bf16)f2bf((L < 32) ? (1.0f - 2.0f * __builtin_amdgcn_rcpf(1.0f + __builtin_amdgcn_exp2f(2.8853900817779268f * lv))) : lv); } }
            WAVE_LDS_SYNC();
            { const bf16x8 fw_ = lds_frag(BC + lr * 72 + kg * 8), fa_ = lds_frag(BC + lr * 72 + 32 + kg * 8);
              WAVE_LDS_SYNC();
#pragma unroll
              for (int nt = 0; nt < 4; ++nt) { const size_t wrow = ((size_t)((l * 2 + dir) * 256 + h * 64 + 16 * nt + lr)) * 32 + kg * 8;
                  f32x4 aw_ = {0.f, 0.f, 0.f, 0.f}, aa_ = {0.f, 0.f, 0.f, 0.f};
                  aw_ = __builtin_amdgcn_mfma_f32_16x16x32_bf16(fw_, *(const GAS bf16x8*)(lora + wrow), aw_, 0, 0, 0);
                  aa_ = __builtin_amdgcn_mfma_f32_16x16x32_bf16(fa_, *(const GAS bf16x8*)(lora + LORA_A2T + wrow), aa_, 0, 0, 0);
#pragma unroll
                  for (int r = 0; r < 4; ++r) { KC[(4 * kg + r) * 72 + 16 * nt + lr] = (bf16)f2bf(aw_[r]); BC[(4 * kg + r) * 72 + 16 * nt + lr] = (bf16)f2bf(aa_[r]); } } }
            WAVE_LDS_SYNC();
            float E = 1.0f;
#pragma unroll 1
            for (int s = 0; s < 16; ++s) {
                const int i = dir ? 15 - s : s;
                const int row = rowbase + tlo + i;
                const float rr = bf2f(RH[s * 72 + L]), kq = bf2f(KH[s * 72 + L]), vv = bf2f(VS[s * 64 + L]);
                const float wp = w0c + bf2f(KC[s * 72 + L]), ap = a0c + bf2f(BC[s * 72 + L]);
                const float dec = __expf(-0.606531f * sigmoidf_(wp));
                const float a = sigmoidf_(ap);
                float kk = kq * kkc; const float nrm = __builtin_amdgcn_sqrtf(wave_sum(kk * kk)); kk = kk * __builtin_amdgcn_rcpf(fmaxf(nrm, 1e-12f));
                const float km = kq * (1.0f + (a - 1.0f) * kac);
                const float bb = kk * a;
                const float bsum = wave_sum(rr * rkc * km);
                if (L == 0) RBS[(size_t)row * 8 + dir * 4 + h] = bsum;
                if (dir == 0) RV[(size_t)row * 256 + c] = vv;
                const float Em1 = E; E *= dec; const float iE = __builtin_amdgcn_rcpf(E);
                KH[s * 72 + L] = (bf16)f2bf(kk * Em1); RH[s * 72 + L] = (bf16)f2bf(rr * E); BC[s * 72 + L] = (bf16)f2bf(bb * iE); KC[s * 72 + L] = (bf16)f2bf(km * iE);
            }
            EC[L] = E;
            WAVE_LDS_SYNC();
            { unsigned pb[8], pv[8];
#pragma unroll
              for (int q = 0; q < 8; ++q) { pb[q] = pk2(bf2f(BC[(2 * q) * 72 + L]) * E, bf2f(BC[(2 * q + 1) * 72 + L]) * E); pv[q] = (unsigned)VS[(2 * q) * 64 + L] | ((unsigned)VS[(2 * q + 1) * 64 + L] << 16); }
              *(LAS v4u*)(BTj + L * 16) = (v4u){pb[0], pb[1], pb[2], pb[3]}; *(LAS v4u*)(BTj + L * 16 + 8) = (v4u){pb[4], pb[5], pb[6], pb[7]};
              bf16* vt = RWC + (size_t)u * RWC_EL + RWC_VT + L * 16;
              *(GAS v4u*)vt = (v4u){pv[0], pv[1], pv[2], pv[3]}; *(GAS v4u*)(vt + 8) = (v4u){pv[4], pv[5], pv[6], pv[7]}; }
            WAVE_LDS_SYNC();
            f32x4 aab = {0.f, 0.f, 0.f, 0.f}, aak = aab, bab = aab, bak = aab;
            { bf16x8 fkh[2], frh[2], fbc[2], fkc[2];
#pragma unroll
              for (int ks = 0; ks < 2; ++ks) { fkh[ks] = lds_frag(KH + lr * 72 + ks * 32 + kg * 8); frh[ks] = lds_frag(RH + lr * 72 + ks * 32 + kg * 8); fbc[ks] = lds_frag(BC + lr * 72 + ks * 32 + kg * 8); fkc[ks] = lds_frag(KC + lr * 72 + ks * 32 + kg * 8); }
#pragma unroll
              for (int ks = 0; ks < 2; ++ks) { aab = __builtin_amdgcn_mfma_f32_16x16x32_bf16(fkh[ks], fbc[ks], aab, 0, 0, 0); aak = __builtin_amdgcn_mfma_f32_16x16x32_bf16(fkh[ks], fkc[ks], aak, 0, 0, 0);
                  bab = __builtin_amdgcn_mfma_f32_16x16x32_bf16(frh[ks], fbc[ks], bab, 0, 0, 0); bak = __builtin_amdgcn_mfma_f32_16x16x32_bf16(frh[ks], fkc[ks], bak, 0, 0, 0); } }
#pragma unroll
            for (int r = 0; r < 4; ++r) { const int t = 4 * kg + r; const bool st = lr < t, le = lr <= t;
                aab[r] = st ? aab[r] : 0.f; aak[r] = st ? aak[r] : 0.f; bab[r] = le ? bab[r] : 0.f; bak[r] = le ? bak[r] : 0.f;
                Aab[t * 17 + lr] = aab[r]; Bak[t * 17 + lr] = bak[r]; }
            { unsigned pk_[8];
#pragma unroll
              for (int s = 0; s < 16; ++s) KC[s * 72 + L] = (bf16)f2bf(bf2f(KC[s * 72 + L]) * E);
#pragma unroll
              for (int q = 0; q < 8; ++q) pk_[q] = (unsigned)KH[(2 * q) * 72 + L] | ((unsigned)KH[(2 * q + 1) * 72 + L] << 16);
              WAVE_LDS_SYNC();
              *(LAS v4u*)(KHj + L * 16) = (v4u){pk_[0], pk_[1], pk_[2], pk_[3]}; *(LAS v4u*)(KHj + L * 16 + 8) = (v4u){pk_[4], pk_[5], pk_[6], pk_[7]}; }
            { v2u w; w.x = pk2(aak[0], aak[1]); w.y = pk2(aak[2], aak[3]); *(LAS v2u*)(AakT + lr * 16 + 4 * kg) = w;
#pragma unroll
              for (int r = 0; r < 4; ++r) Bab[(4 * kg + r) * 16 + lr] = (bf16)f2bf(bab[r]); }
            WAVE_LDS_SYNC();
            { float Tc[16];
#pragma unroll
              for (int s = 15; s >= 0; --s) { float acc = (s == lr) ? 1.f : 0.f;
#pragma unroll
                  for (int uu = s + 1; uu < 16; ++uu) acc -= Aab[uu * 17 + s] * Tc[uu];
                  Tc[s] = acc; }
              if (kg == 0) { unsigned p[8];
#pragma unroll
                  for (int q = 0; q < 8; ++q) p[q] = pk2(Tc[2 * q], Tc[2 * q + 1]);
                  *(LAS v4u*)(TT + lr * 16) = (v4u){p[0], p[1], p[2], p[3]}; *(LAS v4u*)(TT + lr * 16 + 8) = (v4u){p[4], p[5], p[6], p[7]}; } }
            WAVE_LDS_SYNC();
            { const bf16x8 ftt = frag16(TT, lr, kg);
              bf16x8 fk[4];
#pragma unroll
              for (int mt = 0; mt < 4; ++mt) fk[mt] = frag16(KHj + mt * 256, lr, kg);
              const bf16x8 fa = frag16(AakT, lr, kg);
              WAVE_LDS_SYNC();
              f32x4 pa[4];
#pragma unroll
              for (int mt = 0; mt < 4; ++mt) { pa[mt] = (f32x4){0.f, 0.f, 0.f, 0.f}; pa[mt] = __builtin_amdgcn_mfma_f32_16x16x32_bf16(fk[mt], ftt, pa[mt], 0, 0, 0); }
              f32x4 wa = {0.f, 0.f, 0.f, 0.f}; wa = __builtin_amdgcn_mfma_f32_16x16x32_bf16(fa, ftt, wa, 0, 0, 0);
#pragma unroll
              for (int mt = 0; mt < 4; ++mt)
#pragma unroll
                  for (int r = 0; r < 4; ++r) Pj[(16 * mt + 4 * kg + r) * 16 + lr] = (bf16)f2bf(pa[mt][r]);
#pragma unroll
              for (int r = 0; r < 4; ++r) Ws[(4 * kg + r) * 16 + lr] = (bf16)f2bf(wa[r]); }
            WAVE_LDS_SYNC();
            { bf16* rec = RWC + (size_t)u * RWC_EL;
              bf16x8 fp[4], fb[4];
#pragma unroll
              for (int q = 0; q < 4; ++q) { fp[q] = frag16(Pj + q * 256, lr, kg); fb[q] = frag16(BTj + q * 256, lr, kg); }
              const bf16x8 fw = frag16(Ws, lr, kg), fbab = frag16(Bab, lr, kg);
#pragma unroll
              for (int mt = 0; mt < 4; ++mt)
#pragma unroll
                  for (int nt = 0; nt < 4; ++nt) { f32x4 acc = {0.f, 0.f, 0.f, 0.f}; acc = __builtin_amdgcn_mfma_f32_16x16x32_bf16(fp[mt], fb[nt], acc, 0, 0, 0);
                      float o[4];
#pragma unroll
                      for (int r = 0; r < 4; ++r) o[r] = ((mt == nt) && (4 * kg + r == lr) ? EC[16 * nt + lr] : 0.f) - acc[r];
                      v2u w; w.x = pk2(o[0], o[1]); w.y = pk2(o[2], o[3]); *(GAS v2u*)(rec + (16 * nt + lr) * 64 + 16 * mt + 4 * kg) = w; }
#pragma unroll
              for (int nt = 0; nt < 4; ++nt) { f32x4 acc = {0.f, 0.f, 0.f, 0.f}; acc = __builtin_amdgcn_mfma_f32_16x16x32_bf16(fw, fb[nt], acc, 0, 0, 0);
                  float o[4];
#pragma unroll
                  for (int r = 0; r < 4; ++r) o[r] = bf2f(KC[(4 * kg + r) * 72 + 16 * nt + lr]) - acc[r];
                  v2u w; w.x = pk2(o[0], o[1]); w.y = pk2(o[2], o[3]); *(GAS v2u*)(rec + RWC_PSI + (16 * nt + lr) * 16 + 4 * kg) = w; }
#pragma unroll
              for (int mt = 0; mt < 4; ++mt) { f32x4 acc = {0.f, 0.f, 0.f, 0.f}; acc = __builtin_amdgcn_mfma_f32_16x16x32_bf16(fp[mt], fbab, acc, 0, 0, 0);
                  float o[4];
#pragma unroll
                  for (int r = 0; r < 4; ++r) o[r] = bf2f(RH[lr * 72 + 16 * mt + 4 * kg + r]) - acc[r];
                  v2u w; w.x = pk2(o[0], o[1]); w.y = pk2(o[2], o[3]); *(GAS v2u*)(rec + RWC_RP + lr * 64 + 16 * mt + 4 * kg) = w; }
              { f32x4 acc = {0.f, 0.f, 0.f, 0.f}; acc = __builtin_amdgcn_mfma_f32_16x16x32_bf16(fw, fbab, acc, 0, 0, 0);
                  float o[4];
#pragma unroll
                  for (int r = 0; r < 4; ++r) o[r] = Bak[lr * 17 + 4 * kg + r] - acc[r];
                  v2u w; w.x = pk2(o[0], o[1]); w.y = pk2(o[2], o[3]); *(GAS v2u*)(rec + RWC_OM + lr * 16 + 4 * kg) = w; } }
            WAVE_LDS_SYNC();
        }
    }
}

__device__ __forceinline__ void p3_mlstate(Frame& F, const Inputs& I, int l) {
    const bf16* Z = (const bf16*)(F.ws + WS_Z);
    float* DC = (float*)(F.ws + WS_DC); float* DN = (float*)(F.ws + WS_DN); float* BT = DN + 64 * 34 * 64;
    LAS bf16* KT = (LAS bf16*)(F.lds);
    LAS bf16* VT = (LAS bf16*)(F.lds + 64 * MLS * 2);
    LAS float* gb = (LAS float*)(F.lds + 2 * 64 * MLS * 2);
    LAS float* gi = gb + 128;
    LAS float* sc = gi + 128;
    for (int u = F.vcu; u < 64 * 34; u += F.G) {
        const int chain = u / 34, cc = u % 34, dir = chain >> 5, b = (chain >> 2) & 7, h = chain & 3;
        int row0, t0, len; ml_chunk_rows(dir, b, cc, row0, t0, len);
        __syncthreads();
        ml_gates(F, I, l, dir, h, row0, gb, gi);
        if (F.tid < 128) sc[F.tid] = __expf(gb[127] - gb[F.tid] + gi[F.tid]);
        __syncthreads();
        { const int s = F.tid & 127, dg = F.tid >> 7, tau = dir ? 127 - s : s; const int row = row0 + tau, t = t0 + tau;
          float kv[16]; ml_conv16(Z, I, l, row, t, len, 256 + h * 64 + dg * 16, 0.125f, kv);
          const bf16* zv = Z + (size_t)row * NPAD + ZML + 512 + h * 64 + dg * 16;
          float vv[16]; { const v4u w0 = *(const GAS v4u*)zv, w1 = *(const GAS v4u*)(zv + 8); unpack8(w0, vv); unpack8(w1, vv + 8); }
          const float scs = sc[s];
#pragma unroll
          for (int e = 0; e < 16; ++e) { KT[(dg * 16 + e) * MLS + s] = (bf16)f2bf(kv[e]); VT[(dg * 16 + e) * MLS + s] = (bf16)f2bf(vv[e] * scs); } }
        __syncthreads();
        { const int te = F.wave >> 1, td0 = (F.wave & 1) * 2; const int lr = F.lane & 15, kg = F.lane >> 4;
          f32x4 acc[2] = {(f32x4){0.f, 0.f, 0.f, 0.f}, (f32x4){0.f, 0.f, 0.f, 0.f}};
#pragma unroll
          for (int ks = 0; ks < 4; ++ks) { const bf16x8 a = lds_frag(VT + (te * 16 + lr) * MLS + ks * 32 + kg * 8);
#pragma unroll
              for (int j = 0; j < 2; ++j) { const bf16x8 bb = lds_frag(KT + ((td0 + j) * 16 + lr) * MLS + ks * 32 + kg * 8);
                  acc[j] = __builtin_amdgcn_mfma_f32_16x16x32_bf16(a, bb, acc[j], 0, 0, 0); } }
          float* dc = DC + ((size_t)chain * 34 + cc) * 4096;
#pragma unroll
          for (int j = 0; j < 2; ++j)
#pragma unroll
              for (int r = 0; r < 4; ++r) dc[(te * 16 + 4 * kg + r) * 64 + (td0 + j) * 16 + lr] = acc[j][r]; }
        if (F.tid < 64) { float a = 0.f; for (int s = 0; s < 128; ++s) a += bf2f(KT[F.tid * MLS + s]) * sc[s]; DN[((size_t)chain * 34 + cc) * 64 + F.tid] = a; }
        if (F.tid == 0) BT[chain * 34 + cc] = gb[127];
    }
    __syncthreads();
}


__device__ __forceinline__ void cv_load(const float* W, int idx, int lane, float (&tv)[32]) {
    const GAS float* w_ = (const GAS float*)W + (size_t)(64 * (idx >> 5) + (lane >> 5)) * 1024 + 32 * (idx & 31) + (lane & 31);
#pragma unroll
    for (int i = 0; i < 32; ++i) tv[i] = w_[(size_t)(2 * i) * 1024];
}
__device__ __forceinline__ void cv_fin(bf16* WT, int K, bool rmap, LAS float* scr, int idx, int lane, const float (&tv)[32]) {
    const int k0 = 64 * (idx >> 5), n0 = 32 * (idx & 31);
#pragma unroll
    for (int i = 0; i < 32; ++i) scr[(2 * i + (lane >> 5)) * 33 + (lane & 31)] = tv[i];
    asm volatile("s_waitcnt lgkmcnt(0)" ::: "memory");
    const int c = lane & 7;
#pragma unroll
    for (int j = 0; j < 4; ++j) { const int n = (lane >> 3) + 8 * j; const LAS float* s_ = scr + (8 * c) * 33 + n;
        v4u o; o.x = pk2(s_[0 * 33], s_[1 * 33]); o.y = pk2(s_[2 * 33], s_[3 * 33]); o.z = pk2(s_[4 * 33], s_[5 * 33]); o.w = pk2(s_[6 * 33], s_[7 * 33]);
        int nn = n0 + n;
        if (rmap) nn = (nn < 512) ? ((nn >> 7) * 256 + (nn & 127)) : ((((nn - 512) >> 7) * 256) + 128 + ((nn - 512) & 127));
        *(GAS v4u*)(WT + (size_t)nn * K + k0 + 8 * c) = o; }
    asm volatile("s_waitcnt lgkmcnt(0)" ::: "memory");
}
constexpr int CONV_PER_CHAIN = 24576 / 64, CONV_PER_WAVE = CONV_PER_CHAIN / 8;
#define LDS_BARRIER() asm volatile("s_waitcnt lgkmcnt(0)\n\ts_barrier" ::: "memory")
template <bool CONV>
__device__ __forceinline__ void rwkv_seq(Frame& F, int chain, const float* cgu, const float* cdn, int convL) {
    const int dir = chain >> 5, b = (chain >> 2) & 7, h = chain & 3;
    const bf16* RWC = (const bf16*)(F.ws + WS_RWC) + (size_t)chain * RW_NCH * RWC_EL;
    float* RYS = (float*)(F.ws + WS_RYS);
    constexpr int CBUF = 16128;
    LAS unsigned char* cb0 = F.lds; LAS bf16* Sb = (LAS bf16*)(F.lds + 2 * CBUF);
    const int w = F.wave, mt = w >> 1, nt0 = (w & 1) * 2, lr = F.lane & 15, kg = F.lane >> 4;
    auto lds_off = [](int q) -> int { const int e = q * 8;
        if (e < 4096) return ((e >> 6) * 72 + (e & 63)) * 2;
        if (e < 5120) return 9216 + (e - 4096) * 2;
        if (e < 6144) { const int e2 = e - 5120; return 11264 + ((e2 >> 6) * 72 + (e2 & 63)) * 2; }
        if (e < 7168) return 13568 + (e - 6144) * 2;
        return 15616 + (e - 7168) * 2; };
    const int q0 = F.tid, q1 = F.tid + 512; const bool has1 = q1 < RWC_EL / 8;
    const int o0 = lds_off(q0), o1 = lds_off(has1 ? q1 : q0), q1c = has1 ? q1 : q0;
    v4u r0[8], r1[8];
    f32x4 S[2] = {(f32x4){0.f, 0.f, 0.f, 0.f}, (f32x4){0.f, 0.f, 0.f, 0.f}};
    __syncthreads();
    { const v4u a0 = *(const GAS v4u*)(RWC + q0 * 8); const v4u a1 = *(const GAS v4u*)(RWC + q1c * 8);
      *(LAS v4u*)(cb0 + o0) = a0; if (has1) *(LAS v4u*)(cb0 + o1) = a1; }
#pragma unroll
    for (int r = 1; r <= 8; ++r) { const bf16* nx = RWC + (size_t)r * RWC_EL; r0[r & 7] = *(const GAS v4u*)(nx + q0 * 8); r1[r & 7] = *(const GAS v4u*)(nx + q1c * 8); }
    LAS float* cscr = (LAS float*)(F.lds + 49152 + F.wave * 8448);
    float ta[32], tb[32]; int cvn = 0;
    bf16* aWT = nullptr; bf16* bWT = nullptr; int aK = D, bK = D, aidx = 0, bidx = 0; bool arm = true, brm = true, aon = false, bon = false;
#define CV_PICK(WT_, K_, IDX_, RM_, ON_, T_) do { ON_ = cvn < CONV_PER_WAVE; if (CONV) { const int it = chain * CONV_PER_CHAIN + ((cvn < CONV_PER_WAVE) ? cvn : CONV_PER_WAVE - 1) * 8 + F.wave; ++cvn; const float* cW;   \
        if (it < 16384) { const int le = convL * NEXP + (it >> 9); IDX_ = it & 511; cW = cgu + (size_t)le * D * 1024; WT_ = (bf16*)(F.ws + WS_WGU) + (size_t)le * 1024 * D; K_ = D; RM_ = true; }                  \
        else { const int i2 = it - 16384; const int le = convL * NEXP + (i2 >> 8); IDX_ = i2 & 255; cW = cdn + (size_t)le * EH * D; WT_ = (bf16*)(F.ws + WS_WDN) + (size_t)le * D * EH; K_ = EH; RM_ = false; } \
        cv_load(cW, IDX_, F.lane, T_); } } while (0)
#pragma unroll 1
    for (int ckb = 0; ckb < RW_NCH; ckb += 8) {
#pragma unroll
      for (int j = 0; j < 8; ++j) {
        const int ck = ckb + j;
        LAS unsigned char* cb = cb0 + (j & 1) * CBUF; LAS unsigned char* cbn = cb0 + ((j + 1) & 1) * CBUF;
#pragma unroll
        for (int jj = 0; jj < 2; ++jj)
#pragma unroll
            for (int r = 0; r < 4; ++r) Sb[(16 * mt + 4 * kg + r) * 72 + 16 * (nt0 + jj) + lr] = (bf16)f2bf(S[jj][r]);
        LDS_BARRIER();
        const LAS bf16* PhiT = (const LAS bf16*)cb; const LAS bf16* PsiT = (const LAS bf16*)(cb + 9216); const LAS bf16* RpT = (const LAS bf16*)(cb + 11264);
        const LAS bf16* VT = (const LAS bf16*)(cb + 13568); const LAS bf16* OmT = (const LAS bf16*)(cb + 15616);
        bf16x8 sA[2]; sA[0] = lds_frag(Sb + (16 * mt + lr) * 72 + kg * 8); sA[1] = lds_frag(Sb + (16 * mt + lr) * 72 + 32 + kg * 8);
        const bf16x8 vA = frag16(VT + mt * 256, lr, kg);
#pragma unroll
        for (int jj = 0; jj < 2; ++jj) { const int nt = nt0 + jj; f32x4 acc = {0.f, 0.f, 0.f, 0.f};
            acc = __builtin_amdgcn_mfma_f32_16x16x32_bf16(sA[0], lds_frag(PhiT + (16 * nt + lr) * 72 + kg * 8), acc, 0, 0, 0);
            acc = __builtin_amdgcn_mfma_f32_16x16x32_bf16(sA[1], lds_frag(PhiT + (16 * nt + lr) * 72 + 32 + kg * 8), acc, 0, 0, 0);
            acc = __builtin_amdgcn_mfma_f32_16x16x32_bf16(vA, frag16(PsiT + nt * 256, lr, kg), acc, 0, 0, 0);
            S[jj] = acc; }
        if ((w & 1) == 0) { f32x4 y = {0.f, 0.f, 0.f, 0.f};
            y = __builtin_amdgcn_mfma_f32_16x16x32_bf16(sA[0], lds_frag(RpT + lr * 72 + kg * 8), y, 0, 0, 0);
            y = __builtin_amdgcn_mfma_f32_16x16x32_bf16(sA[1], lds_frag(RpT + lr * 72 + 32 + kg * 8), y, 0, 0, 0);
            y = __builtin_amdgcn_mfma_f32_16x16x32_bf16(vA, frag16(OmT, lr, kg), y, 0, 0, 0);
            const int stp = ck * 16 + lr; int row;
            if (stp < TC) { const int t = dir ? TC - 1 - stp : stp; row = b * TC + t; } else { const int s2 = stp - TC; const int t = dir ? T - 1 - s2 : s2; row = NCX + b * T + t; }
            *(GAS f32x4*)(RYS + ((size_t)dir * NT + row) * 256 + h * 64 + 16 * mt + 4 * kg) = y; }
        if (ck + 1 < RW_NCH) { *(LAS v4u*)(cbn + o0) = r0[(j + 1) & 7]; if (has1) *(LAS v4u*)(cbn + o1) = r1[(j + 1) & 7]; }
        { const int rn = (ck + 9 < RW_NCH) ? ck + 9 : RW_NCH - 1; const bf16* nx = RWC + (size_t)rn * RWC_EL; r0[(j + 1) & 7] = *(const GAS v4u*)(nx + q0 * 8); r1[(j + 1) & 7] = *(const GAS v4u*)(nx + q1c * 8); }
        if (CONV) {
        if (j == 1) { if (bon) cv_fin(bWT, bK, brm, cscr, bidx, F.lane, tb); bon = false; }
        if (j == 5) { if (aon) cv_fin(aWT, aK, arm, cscr, aidx, F.lane, ta); aon = false; }
        if (j == 0) CV_PICK(aWT, aK, aidx, arm, aon, ta);
        if (j == 4) CV_PICK(bWT, bK, bidx, brm, bon, tb); }
        LDS_BARRIER();
      }
    }
    if (CONV) { if (bon) cv_fin(bWT, bK, brm, cscr, bidx, F.lane, tb);
        if (aon) cv_fin(aWT, aK, arm, cscr, aidx, F.lane, ta); }
#undef CV_PICK
}
__device__ __forceinline__ void ml_prefix(Frame& F, int chain) {
    const float* DC = (const float*)(F.ws + WS_DC); const float* DN = (const float*)(F.ws + WS_DN); const float* BT = DN + 64 * 34 * 64;
    float* CS = (float*)(F.ws + WS_CS); float* NS = (float*)(F.ws + WS_NS);
    f32x4 c0 = (f32x4){0.f, 0.f, 0.f, 0.f}, c1 = c0; float n = 0.f;
    for (int cc = 0; cc < 34; ++cc) {
        const size_t base = ((size_t)chain * 34 + cc) * 4096;
        *(GAS f32x4*)(CS + base + F.tid * 8) = c0; *(GAS f32x4*)(CS + base + F.tid * 8 + 4) = c1;
        if (F.tid < 64) NS[((size_t)chain * 34 + cc) * 64 + F.tid] = n;
        const float dec = __expf(BT[chain * 34 + cc]);
        const f32x4 d0 = *(const GAS f32x4*)(DC + base + F.tid * 8), d1 = *(const GAS f32x4*)(DC + base + F.tid * 8 + 4);
        c0 = c0 * dec + d0; c1 = c1 * dec + d1;
        if (F.tid < 64) n = n * dec + DN[((size_t)chain * 34 + cc) * 64 + F.tid];
    }
}

namespace att {
constexpr int QBLK = 32, KVBLK = 64;
constexpr float SCALE = 0.125f;
constexpr float THR = 8.f;
constexpr int SHM_V = KVBLK * 128 * 2, SHM_K = KVBLK * 64 * 2;
#define KSWZ(row, colB) ((row) * 128 + ((colB) ^ (((((row) & 7) ^ ((((row) >> 3) & 1) << 2))) << 4)))
#define SBAR() __builtin_amdgcn_sched_barrier(0)
__device__ __forceinline__ int crow(int r, int hi) { return (r & 3) + 8 * (r >> 2) + 4 * hi; }
__device__ __forceinline__ unsigned cvtpk(float lo, float hi) { unsigned r; asm volatile("v_cvt_pk_bf16_f32 %0, %1, %2" : "=v"(r) : "v"(lo), "v"(hi)); return r; }
__device__ __forceinline__ void partialSM(f32x16& p0, f32x16& p1) {
#pragma unroll
  for (int r = 0; r < 16; ++r) p0[r] = __builtin_amdgcn_exp2f(p0[r]);
}
__device__ __forceinline__ void finishSM(f32x16& p0, f32x16& p1, float& l_reg, bf16x8& pa0, bf16x8& pa1, bf16x8& pa2, bf16x8& pa3) {
#pragma unroll
  for (int r = 0; r < 16; ++r) p1[r] = __builtin_amdgcn_exp2f(p1[r]);
  float ps = 0;
#pragma unroll
  for (int r = 0; r < 16; ++r) ps += p0[r];
#pragma unroll
  for (int r = 0; r < 16; ++r) ps += p1[r];
  { auto rr = __builtin_amdgcn_permlane32_swap(__float_as_uint(ps), __float_as_uint(ps), false, false);
    ps = __uint_as_float(rr[0]) + __uint_as_float(rr[1]); }
  l_reg += ps;
#define PK4(P, BASE, OUT) do { v4u w = {cvtpk(P[BASE + 0], P[BASE + 1]), cvtpk(P[BASE + 2], P[BASE + 3]), cvtpk(P[BASE + 4], P[BASE + 5]), cvtpk(P[BASE + 6], P[BASE + 7])}; \
    OUT = *reinterpret_cast<bf16x8*>(&w); } while (0)
  PK4(p0, 0, pa0); PK4(p0, 8, pa1); PK4(p1, 0, pa2); PK4(p1, 8, pa3);
#undef PK4
}
__device__ __forceinline__ void qkt(f32x16& p0, f32x16& p1, const LAS char* Ks, const bf16x8* qr, int r32, int hi) {
  p0 = f32x16{}; p1 = f32x16{};
#pragma unroll
  for (int d0 = 0; d0 < 4; ++d0) { const int cb = (d0 * 16 + hi * 8) * 2;
    const bf16x8 b0 = *(const LAS bf16x8*)(Ks + KSWZ(r32, cb));
    const bf16x8 b1 = *(const LAS bf16x8*)(Ks + KSWZ(32 + r32, cb));
    p0 = __builtin_amdgcn_mfma_f32_32x32x16_bf16(b0, qr[d0], p0, 0, 0, 0);
    p1 = __builtin_amdgcn_mfma_f32_32x32x16_bf16(b1, qr[d0], p1, 0, 0, 0); }
}
__device__ __forceinline__ int v_st(int k, int c) { const int kk = (k & ~0xC) | ((k & 4) << 1) | ((k & 8) >> 1); return ((kk >> 3) * 4 + (c >> 5)) * 512 + ((kk & 7) * 32 + (c & 31)) * 2; }
__device__ __forceinline__ int v_rd_base(int lane) { return ((lane & 3) << 3) | (((lane >> 2) & 3) << 6) | (((lane >> 4) & 1) << 5) | (((lane >> 5) & 1) << 8); }
constexpr int v_rd_off(int d0, int ks, int half) { return d0 * 512 + ks * 4096 + half * 2048; }
template <int OFF> __device__ __forceinline__ s16x4 tr_read(int vb) {
  s16x4 r; asm volatile("ds_read_b64_tr_b16 %0, %1 offset:%2" : "=&v"(r) : "v"(vb), "i"(OFF) : "memory"); return r;
}
template <int D0> __device__ __forceinline__ void pv_one(f32x16& od, int vb, bf16x8 pa0, bf16x8 pa1, bf16x8 pa2, bf16x8 pa3) {
  const s16x4 l0 = tr_read<v_rd_off(D0, 0, 0)>(vb), h0 = tr_read<v_rd_off(D0, 0, 1)>(vb), l1 = tr_read<v_rd_off(D0, 1, 0)>(vb), h1 = tr_read<v_rd_off(D0, 1, 1)>(vb);
  const s16x4 l2 = tr_read<v_rd_off(D0, 2, 0)>(vb), h2 = tr_read<v_rd_off(D0, 2, 1)>(vb), l3 = tr_read<v_rd_off(D0, 3, 0)>(vb), h3 = tr_read<v_rd_off(D0, 3, 1)>(vb);
  asm volatile("s_waitcnt lgkmcnt(0)" ::: "memory"); SBAR();
#define PK(L, H) (bf16x8){L[0], L[1], L[2], L[3], H[0], H[1], H[2], H[3]}
  od = __builtin_amdgcn_mfma_f32_32x32x16_bf16(pa0, PK(l0, h0), od, 0, 0, 0);
  od = __builtin_amdgcn_mfma_f32_32x32x16_bf16(pa1, PK(l1, h1), od, 0, 0, 0);
  od = __builtin_amdgcn_mfma_f32_32x32x16_bf16(pa2, PK(l2, h2), od, 0, 0, 0);
  od = __builtin_amdgcn_mfma_f32_32x32x16_bf16(pa3, PK(l3, h3), od, 0, 0, 0);
#undef PK
}
__device__ __forceinline__ void pv_d0(f32x16* o, int vb, bf16x8 pa0, bf16x8 pa1, bf16x8 pa2, bf16x8 pa3) {
  pv_one<0>(o[0], vb, pa0, pa1, pa2, pa3); pv_one<1>(o[1], vb, pa0, pa1, pa2, pa3); pv_one<2>(o[2], vb, pa0, pa1, pa2, pa3); pv_one<3>(o[3], vb, pa0, pa1, pa2, pa3);
}
__device__ __forceinline__ void attn_unit(const bf16* __restrict__ Qb, const bf16* __restrict__ Kh, const bf16* __restrict__ Vh, float* __restrict__ Ob, int ldo, int seq, LAS char* lds) {
  int tid = threadIdx.x; asm volatile("" : "+v"(tid));
  const int wid = tid >> 6, lane = tid & 63, r32 = lane & 31, hi = lane >> 5;
  LAS char* V_lds = lds; LAS char* K_lds = lds + 2 * SHM_V;
  LAS float* ws = (LAS float*)(lds + 2 * SHM_V + 2 * SHM_K) + wid * 64; LAS float* li_l = ws; LAS float* al_l = ws + 32;
  float l_reg = 0; f32x16 o[4] = {}; bf16x8 qr[4];
  const bf16* Qw = Qb + (long)(wid * QBLK + r32) * 64 + hi * 8;
#pragma unroll
  for (int d0 = 0; d0 < 4; ++d0) qr[d0] = *(const GAS bf16x8*)(Qw + d0 * 16);
  const int sr = tid >> 4, sc = (tid & 15) * 8, vst0 = v_st(sr, sc), vst1 = v_st(32 + sr, sc);
  const int kr = tid >> 3, kc = (tid & 7) * 8; const int kst = KSWZ((kr & ~0xC) | ((kr & 4) << 1) | ((kr & 8) >> 1), kc * 2);
  const int vb0 = (int)(unsigned)(size_t)V_lds + v_rd_base(lane);
  bf16x8 vsA0, vsA1, ksA, vsB0, vsB1, ksB;
#define SLOADA(k0) do { vsA0 = *(const GAS bf16x8*)&Vh[(long)((k0) + sr) * 128 + sc]; vsA1 = *(const GAS bf16x8*)&Vh[(long)((k0) + 32 + sr) * 128 + sc]; ksA = *(const GAS bf16x8*)&Kh[(long)((k0) + kr) * 64 + kc]; } while (0)
#define SLOADB(k0) do { vsB0 = *(const GAS bf16x8*)&Vh[(long)((k0) + sr) * 128 + sc]; vsB1 = *(const GAS bf16x8*)&Vh[(long)((k0) + 32 + sr) * 128 + sc]; ksB = *(const GAS bf16x8*)&Kh[(long)((k0) + kr) * 64 + kc]; } while (0)
#define SWRITEA(b) do { *(LAS bf16x8*)(V_lds + (b) * SHM_V + vst0) = vsA0; *(LAS bf16x8*)(V_lds + (b) * SHM_V + vst1) = vsA1; *(LAS bf16x8*)(K_lds + (b) * SHM_K + kst) = ksA; } while (0)
#define SWRITEB(b) do { *(LAS bf16x8*)(V_lds + (b) * SHM_V + vst0) = vsB0; *(LAS bf16x8*)(V_lds + (b) * SHM_V + vst1) = vsB1; *(LAS bf16x8*)(K_lds + (b) * SHM_K + kst) = ksB; } while (0)
#define SWAIT() asm volatile("s_waitcnt vmcnt(3)" ::: "memory")
#define RESC(a) do { if (__any((a) < 1.f)) { if (hi == 0) al_l[r32] = (a); asm volatile("s_waitcnt lgkmcnt(0)" ::: "memory"); \
    _Pragma("unroll") for (int d = 0; d < 4; ++d) _Pragma("unroll") for (int r = 0; r < 16; ++r) o[d][r] *= al_l[crow(r, hi)]; } } while (0)
  f32x16 pA0, pA1, pB0, pB1; bf16x8 pa0, pa1, pa2, pa3; const int NTL = seq / KVBLK;
  __syncthreads();
  SLOADA(0); asm volatile("s_waitcnt vmcnt(0)" ::: "memory"); SWRITEA(0); __syncthreads();
  qkt(pA0, pA1, K_lds, qr, r32, hi); partialSM(pA0, pA1);
  SLOADB(KVBLK); SLOADA(2 * KVBLK);
  SWAIT(); SWRITEB(1); __syncthreads();
  for (int j = 1; j + 1 < NTL; j += 2) {
    SBAR(); qkt(pB0, pB1, K_lds + SHM_K, qr, r32, hi);
    finishSM(pA0, pA1, l_reg, pa0, pa1, pa2, pa3); SBAR();
    SLOADB((j + 2) * KVBLK); SBAR();
    pv_d0(o, vb0, pa0, pa1, pa2, pa3); partialSM(pB0, pB1);
    __syncthreads(); SWAIT(); SWRITEA(0);
    __syncthreads();
    SBAR(); qkt(pA0, pA1, K_lds, qr, r32, hi);
    finishSM(pB0, pB1, l_reg, pa0, pa1, pa2, pa3); SBAR();
    SLOADA(((j + 3 < NTL) ? j + 3 : NTL - 1) * KVBLK);     SBAR();
    pv_d0(o, vb0 + SHM_V, pa0, pa1, pa2, pa3); partialSM(pA0, pA1);
    __syncthreads(); SWAIT(); SWRITEB(1);
    __syncthreads();
  }
  SBAR(); qkt(pB0, pB1, K_lds + SHM_K, qr, r32, hi);
  finishSM(pA0, pA1, l_reg, pa0, pa1, pa2, pa3); SBAR();
  pv_d0(o, vb0, pa0, pa1, pa2, pa3); partialSM(pB0, pB1);
  __syncthreads();
  finishSM(pB0, pB1, l_reg, pa0, pa1, pa2, pa3); SBAR();
  pv_d0(o, vb0 + SHM_V, pa0, pa1, pa2, pa3);
  if (hi == 0) li_l[r32] = l_reg; asm volatile("s_waitcnt lgkmcnt(0)" ::: "memory");
  float rli[16];
#pragma unroll
  for (int r = 0; r < 16; ++r) rli[r] = __builtin_amdgcn_rcpf(li_l[crow(r, hi)]);
  float* Ow = Ob + (long)(wid * QBLK) * ldo;
#pragma unroll
  for (int r = 0; r < 16; ++r) { const int orow = crow(r, hi);
#pragma unroll
    for (int d0 = 0; d0 < 4; ++d0) Ow[(long)orow * ldo + d0 * 32 + r32] = o[d0][r] * rli[r]; }
  asm volatile("s_waitcnt vmcnt(0)" ::: "memory");
#undef SLOADA
#undef SLOADB
#undef SWRITEA
#undef SWRITEB
#undef SWAIT
#undef RESC
}
__device__ __forceinline__ void attn_unit2(const bf16* __restrict__ Q0, const bf16* __restrict__ K0, const bf16* __restrict__ Vh, bf16* __restrict__ Ob, int seq, size_t qmap_stride, size_t kmap_stride,
                                           float lam, float post_scale, const float* __restrict__ gsub, LAS char* lds) {
  int tid = threadIdx.x; asm volatile("" : "+v"(tid));
  const int wid = tid >> 6, lane = tid & 63, r32 = lane & 31, hi = lane >> 5, map = wid >> 2, wq = wid & 3;
  LAS char* V_lds = lds; LAS char* K_lds = lds + 3 * SHM_V;
  LAS float* ws = (LAS float*)(lds + 3 * SHM_V + 6 * SHM_K) + wid * 64; LAS float* li_l = ws;
  LAS float* EX = (LAS float*)lds;
  float l_reg = 0; f32x16 o[4] = {}; bf16x8 qr[4];
  const bf16* Qw = Q0 + (size_t)map * qmap_stride + (long)(wq * QBLK + r32) * 64 + hi * 8;
#pragma unroll
  for (int d0 = 0; d0 < 4; ++d0) qr[d0] = *(const GAS bf16x8*)(Qw + d0 * 16);
  const int sr = tid >> 4, sc = (tid & 15) * 8, vst0 = v_st(sr, sc), vst1 = v_st(32 + sr, sc);
  const int kr = tid >> 3, kc = (tid & 7) * 8; const int kst = KSWZ((kr & ~0xC) | ((kr & 4) << 1) | ((kr & 8) >> 1), kc * 2);
  const bf16* K1 = K0 + kmap_stride;
  const int vb0 = (int)(unsigned)(size_t)V_lds + v_rd_base(lane);
  const LAS char* Kmine = K_lds + map * SHM_K;
  bf16x8 vsA0, vsA1, ksA0, ksA1, vsB0, vsB1, ksB0, ksB1;
#define SLOADA(k0) do { vsA0 = *(const GAS bf16x8*)&Vh[(long)((k0) + sr) * 128 + sc]; vsA1 = *(const GAS bf16x8*)&Vh[(long)((k0) + 32 + sr) * 128 + sc]; ksA0 = *(const GAS bf16x8*)&K0[(long)((k0) + kr) * 64 + kc]; ksA1 = *(const GAS bf16x8*)&K1[(long)((k0) + kr) * 64 + kc]; } while (0)
#define SLOADB(k0) do { vsB0 = *(const GAS bf16x8*)&Vh[(long)((k0) + sr) * 128 + sc]; vsB1 = *(const GAS bf16x8*)&Vh[(long)((k0) + 32 + sr) * 128 + sc]; ksB0 = *(const GAS bf16x8*)&K0[(long)((k0) + kr) * 64 + kc]; ksB1 = *(const GAS bf16x8*)&K1[(long)((k0) + kr) * 64 + kc]; } while (0)
#define SWRITEA(b) do { *(LAS bf16x8*)(V_lds + (b) * SHM_V + vst0) = vsA0; *(LAS bf16x8*)(V_lds + (b) * SHM_V + vst1) = vsA1; *(LAS bf16x8*)(K_lds + ((b) * 2) * SHM_K + kst) = ksA0; *(LAS bf16x8*)(K_lds + ((b) * 2 + 1) * SHM_K + kst) = ksA1; } while (0)
#define SWRITEB(b) do { *(LAS bf16x8*)(V_lds + (b) * SHM_V + vst0) = vsB0; *(LAS bf16x8*)(V_lds + (b) * SHM_V + vst1) = vsB1; *(LAS bf16x8*)(K_lds + ((b) * 2) * SHM_K + kst) = ksB0; *(LAS bf16x8*)(K_lds + ((b) * 2 + 1) * SHM_K + kst) = ksB1; } while (0)
#define SWAIT() asm volatile("s_waitcnt vmcnt(4)" ::: "memory")
  f32x16 pA0, pA1, pB0, pB1; bf16x8 pa0, pa1, pa2, pa3; const int NTL = seq / KVBLK;
  __syncthreads();
  SLOADA(0); asm volatile("s_waitcnt vmcnt(0)" ::: "memory"); SWRITEA(0); __syncthreads();
  qkt(pA0, pA1, Kmine, qr, r32, hi); partialSM(pA0, pA1);
  SLOADB(KVBLK); SLOADA(2 * KVBLK);
  SWAIT(); SWRITEB(1); __syncthreads();
  int b_prev = 0, b_cur = 1, b_nxt = 2;
  for (int j = 1; j + 1 < NTL; j += 2) {
    SBAR(); qkt(pB0, pB1, Kmine + b_cur * 2 * SHM_K, qr, r32, hi);
    finishSM(pA0, pA1, l_reg, pa0, pa1, pa2, pa3); SBAR();
    SLOADB((j + 2) * KVBLK); SBAR();
    pv_d0(o, vb0 + b_prev * SHM_V, pa0, pa1, pa2, pa3); partialSM(pB0, pB1);
    SWAIT(); SWRITEA(b_nxt);
    __syncthreads();
    { const int t_ = b_prev; b_prev = b_cur; b_cur = b_nxt; b_nxt = t_; }
    SBAR(); qkt(pA0, pA1, Kmine + b_cur * 2 * SHM_K, qr, r32, hi);
    finishSM(pB0, pB1, l_reg, pa0, pa1, pa2, pa3); SBAR();
    SLOADA(((j + 3 < NTL) ? j + 3 : NTL - 1) * KVBLK);     SBAR();
    pv_d0(o, vb0 + b_prev * SHM_V, pa0, pa1, pa2, pa3); partialSM(pA0, pA1);
    SWAIT(); SWRITEB(b_nxt);
    __syncthreads();
    { const int t_ = b_prev; b_prev = b_cur; b_cur = b_nxt; b_nxt = t_; }
  }
  SBAR(); qkt(pB0, pB1, Kmine + b_cur * 2 * SHM_K, qr, r32, hi);
  finishSM(pA0, pA1, l_reg, pa0, pa1, pa2, pa3); SBAR();
  pv_d0(o, vb0 + b_prev * SHM_V, pa0, pa1, pa2, pa3); partialSM(pB0, pB1);
  finishSM(pB0, pB1, l_reg, pa0, pa1, pa2, pa3); SBAR();
  pv_d0(o, vb0 + b_cur * SHM_V, pa0, pa1, pa2, pa3);
  if (hi == 0) li_l[r32] = l_reg; asm volatile("s_waitcnt lgkmcnt(0)" ::: "memory");
  float rli[16];
#pragma unroll
  for (int r = 0; r < 16; ++r) rli[r] = __builtin_amdgcn_rcpf(li_l[crow(r, hi)]);
  __syncthreads();
  if (map == 1) {
#pragma unroll
    for (int d0 = 0; d0 < 4; ++d0)
#pragma unroll
      for (int r = 0; r < 16; ++r) EX[((wq * 4 + d0) * 16 + r) * 64 + lane] = o[d0][r] * (rli[r] * lam);
  }
  __syncthreads();
  if (map == 0) {
    float ss[16];
#pragma unroll
    for (int r = 0; r < 16; ++r) ss[r] = 0.f;
#pragma unroll
    for (int d0 = 0; d0 < 4; ++d0)
#pragma unroll
      for (int r = 0; r < 16; ++r) { const float v = o[d0][r] * rli[r] - EX[((wq * 4 + d0) * 16 + r) * 64 + lane]; o[d0][r] = v; ss[r] += v * v; }
    float gv[4];
#pragma unroll
    for (int d0 = 0; d0 < 4; ++d0) gv[d0] = gsub[d0 * 32 + r32] * post_scale;
#pragma unroll
    for (int r = 0; r < 16; ++r) { float t = row16_sum(ss[r]); t += __shfl_xor(t, 16); ss[r] = __builtin_amdgcn_rsqf(t * (1.f / 128.f) + 1e-6f); }
    bf16* Ow = Ob + (long)(wq * QBLK) * 1024;
#pragma unroll
    for (int r = 0; r < 16; ++r) { const int orow = crow(r, hi);
#pragma unroll
      for (int d0 = 0; d0 < 4; ++d0) Ow[(long)orow * 1024 + d0 * 32 + r32] = (bf16)f2bf(o[d0][r] * ss[r] * gv[d0]); }
  }
  asm volatile("s_waitcnt vmcnt(0)" ::: "memory");
#undef SLOADA
#undef SLOADB
#undef SWRITEA
#undef SWRITEB
#undef SWAIT
}
}

__device__ __forceinline__ void p5_att(Frame& F, const Inputs& I, int l, int row_lo) {
    const float* AO = (const float*)(F.ws + WS_ATTO); bf16* MIX = (bf16*)(F.ws + WS_MIX);
    const float lam = ((const float*)(F.ws + WS_MOD))[MOD_LAM + l];
    const float lam_init = 0.8f - 0.6f * expf(-0.3f * (float)l);
    const int L = F.lane, h = L >> 4, off = (L & 15) * 8;
    const f32x4 g0 = *(const GAS f32x4*)(I.da_subln_g + l * 128 + off), g1 = *(const GAS f32x4*)(I.da_subln_g + l * 128 + off + 4);
    for (int row = row_lo + F.gw; row < NT; row += F.NGW) {
        const float* p0 = AO + (size_t)row * 1024 + h * 256 + off; const float* p1 = p0 + 128;
        const f32x4 a0 = *(const GAS f32x4*)p0, a1 = *(const GAS f32x4*)(p0 + 4), b0 = *(const GAS f32x4*)p1, b1 = *(const GAS f32x4*)(p1 + 4);
        const f32x4 o0 = a0 - b0 * lam, o1 = a1 - b1 * lam;
        float ss = (o0.x * o0.x + o0.y * o0.y) + (o0.z * o0.z + o0.w * o0.w) + (o1.x * o1.x + o1.y * o1.y) + (o1.z * o1.z + o1.w * o1.w);
        ss = row16_sum(ss);
        const float sc = (1.0f / sqrtf(ss * (1.f / 128.f) + NORM_EPS)) * (1.0f - lam_init);
        const f32x4 y0 = o0 * g0 * sc, y1 = o1 * g1 * sc;
        v4u w; w.x = pk2(y0.x, y0.y); w.y = pk2(y0.z, y0.w); w.z = pk2(y1.x, y1.y); w.w = pk2(y1.z, y1.w);
        *(GAS v4u*)(MIX + (size_t)row * D + h * 128 + off) = w;
    }
}
__device__ __forceinline__ void p5_rwkv(Frame& F, const Inputs& I, int l, int row_begin, int row_end, int row_step) {
    const float* RYS = (const float*)(F.ws + WS_RYS); const float* RV = (const float*)(F.ws + WS_RV); const float* RG = (const float*)(F.ws + WS_RG); const float* RBS = (const float*)(F.ws + WS_RBS);
    bf16* MIX = (bf16*)(F.ws + WS_MIX);
    const int L = F.lane, c0 = 4 * L, h = L >> 4;
    const f32x4 lg = *(const GAS f32x4*)(I.rw_ln_g + l * 256 + c0), lb = *(const GAS f32x4*)(I.rw_ln_b + l * 256 + c0);
#pragma unroll 4
    for (int row = row_begin; row < row_end; row += row_step) {
        const f32x4 y = *(const GAS f32x4*)(RYS + (size_t)row * 256 + c0) + *(const GAS f32x4*)(RYS + ((size_t)NT + row) * 256 + c0);
        float s = (y.x + y.y) + (y.z + y.w);
        s = row16_sum(s);
        const float mu = s * (1.f / 64.f);
        const f32x4 d = y - mu;
        float q = (d.x * d.x + d.y * d.y) + (d.z * d.z + d.w * d.w);
        q = row16_sum(q);
        const float rstd = __builtin_amdgcn_rsqf(q * (1.f / 64.f) + 64e-5f);
        const f32x4 v = *(const GAS f32x4*)(RV + (size_t)row * 256 + c0);
        const f32x4 g = *(const GAS f32x4*)(RG + (size_t)row * 256 + c0);
        const float bs = RBS[(size_t)row * 8 + h] + RBS[(size_t)row * 8 + 4 + h];
        const f32x4 o = ((d * rstd) * lg + lb + v * bs) * g;
        v2u w; w.x = pk2(o.x, o.y); w.y = pk2(o.z, o.w);
        *(GAS v2u*)(MIX + (size_t)row * D + 512 + c0) = w;
    }
}
__device__ __forceinline__ void p5_mlout(Frame& F, const Inputs& I, int l, int u) {
    const bf16* Z = (const bf16*)(F.ws + WS_Z);
    const float* CS = (const float*)(F.ws + WS_CS); const float* NS = (const float*)(F.ws + WS_NS);
    bf16* MIX = (bf16*)(F.ws + WS_MIX);
    LAS bf16* QL = (LAS bf16*)(F.lds);
    LAS bf16* KL = (LAS bf16*)(F.lds + 18432);
    LAS bf16* VT = (LAS bf16*)(F.lds + 36864);
    LAS bf16* PL = (LAS bf16*)(F.lds + 54272);
    LAS bf16* CB = (LAS bf16*)(F.lds + 89088);
    LAS float* HL = (LAS float*)(F.lds + 100608);
    LAS float* gb = (LAS float*)(F.lds + 135424);
    LAS float* gi = gb + 128;
    const int w = F.wave;
    {
        int tid_ = threadIdx.x; asm volatile("" : "+v"(tid_));
        const int lane_ = tid_ & 63, lr = lane_ & 15, kg = lane_ >> 4;
        int b, j, h, row0, len;
        if (u < 64) { b = u >> 3; j = (u >> 2) & 1; h = u & 3; row0 = b * TC + j * 128; len = TC; }
        else { const int u2 = u - 64; b = u2 >> 7; j = (u2 >> 2) & 31; h = u2 & 3; row0 = NCX + b * T + j * 128; len = T; }
        const int t0 = j * 128;
        __syncthreads();
        { const int s = tid_ & 127, dg = tid_ >> 7; const int row = row0 + s, t = t0 + s;
          { float qv[16]; ml_conv16(Z, I, l, row, t, len, h * 64 + dg * 16, 1.0f, qv);
            v4u a, c;
            a.x = pk2(qv[0], qv[1]); a.y = pk2(qv[2], qv[3]); a.z = pk2(qv[4], qv[5]); a.w = pk2(qv[6], qv[7]);
            c.x = pk2(qv[8], qv[9]); c.y = pk2(qv[10], qv[11]); c.z = pk2(qv[12], qv[13]); c.w = pk2(qv[14], qv[15]);
            *(LAS v4u*)(QL + s * MLD + dg * 16) = a; *(LAS v4u*)(QL + s * MLD + dg * 16 + 8) = c; }
          asm volatile("" ::: "memory");
          { float kv[16]; ml_conv16(Z, I, l, row, t, len, 256 + h * 64 + dg * 16, 0.125f, kv);
            v4u a, c;
            a.x = pk2(kv[0], kv[1]); a.y = pk2(kv[2], kv[3]); a.z = pk2(kv[4], kv[5]); a.w = pk2(kv[6], kv[7]);
            c.x = pk2(kv[8], kv[9]); c.y = pk2(kv[10], kv[11]); c.z = pk2(kv[12], kv[13]); c.w = pk2(kv[14], kv[15]);
            *(LAS v4u*)(KL + s * MLD + dg * 16) = a; *(LAS v4u*)(KL + s * MLD + dg * 16 + 8) = c; }
          asm volatile("" ::: "memory");
          float vv[16];
          const bf16* zv = Z + (size_t)row * NPAD + ZML + 512 + h * 64 + dg * 16;
          { const v4u w0 = *(const GAS v4u*)zv, w1 = *(const GAS v4u*)(zv + 8); unpack8(w0, vv); unpack8(w1, vv + 8); }
#pragma unroll
          for (int e = 0; e < 16; ++e) VT[(dg * 16 + e) * MLS + s] = (bf16)f2bf(vv[e]); }
#pragma unroll 1
        for (int dir = 0; dir < 2; ++dir) {
            const int chain = dir * 32 + b * 4 + h;
            const int cc = (u < 64) ? (dir ? 1 - j : j) : 2 + (dir ? 31 - j : j);
            __syncthreads();
            ml_gates(F, I, l, dir, h, row0, gb, gi);
            { const float* cs = CS + ((size_t)chain * 34 + cc) * 4096; const int e = tid_ >> 3, d0 = (tid_ & 7) * 8;
              const f32x4 x0 = *(const GAS f32x4*)(cs + e * 64 + d0), x1 = *(const GAS f32x4*)(cs + e * 64 + d0 + 4);
              v4u o; o.x = pk2(x0.x, x0.y); o.y = pk2(x0.z, x0.w); o.z = pk2(x1.x, x1.y); o.w = pk2(x1.z, x1.w);
              *(LAS v4u*)(CB + e * MLD + d0) = o;
              if (tid_ < 64) CB[64 * MLD + tid_] = (bf16)f2bf(NS[((size_t)chain * 34 + cc) * 64 + tid_]);
              for (int i = tid_; i < 15 * 64; i += 512) CB[(65 + (i >> 6)) * MLD + (i & 63)] = 0; }
            __syncthreads();
            bf16x8 qa[2];
#pragma unroll
            for (int ks = 0; ks < 2; ++ks) qa[ks] = lds_frag(QL + (16 * w + lr) * MLD + ks * 32 + kg * 8);
            float bt[4], den[4];
#pragma unroll
            for (int r = 0; r < 4; ++r) { const int tq = 16 * w + 4 * kg + r; bt[r] = gb[dir ? 127 - tq : tq]; den[r] = 0.f; }
#pragma unroll 1
            for (int hf = 0; hf < 2; ++hf) {
                f32x4 sacc[4];
#pragma unroll
                for (int tc = 0; tc < 4; ++tc) sacc[tc] = (f32x4){0.f, 0.f, 0.f, 0.f};
#pragma unroll
                for (int tc = 0; tc < 4; ++tc)
#pragma unroll
                    for (int ks = 0; ks < 2; ++ks) sacc[tc] = __builtin_amdgcn_mfma_f32_16x16x32_bf16(qa[ks], lds_frag(KL + (16 * (hf * 4 + tc) + lr) * MLD + ks * 32 + kg * 8), sacc[tc], 0, 0, 0);
#pragma unroll
                for (int tc = 0; tc < 4; ++tc) { const int s = 16 * (hf * 4 + tc) + lr; const int sg = dir ? 127 - s : s; const float bs = gb[sg], is = gi[sg];
#pragma unroll
                    for (int r = 0; r < 4; ++r) { const int t = 16 * w + 4 * kg + r;
                        const float p = (dir ? (s >= t) : (s <= t)) ? sacc[tc][r] * __expf(bt[r] - bs + is) : 0.f;
                        den[r] += p; PL[t * MLS + s] = (bf16)f2bf(p); } }
            }
#pragma unroll
            for (int r = 0; r < 4; ++r) den[r] = row16_sum(den[r]);
            __syncthreads();
            f32x4 nacc[4], iacc[5];
#pragma unroll
            for (int te = 0; te < 4; ++te) nacc[te] = (f32x4){0.f, 0.f, 0.f, 0.f};
#pragma unroll
            for (int te = 0; te < 5; ++te) iacc[te] = (f32x4){0.f, 0.f, 0.f, 0.f};
#pragma unroll
            for (int ks = 0; ks < 4; ++ks) { const bf16x8 pa = lds_frag(PL + (16 * w + lr) * MLS + ks * 32 + kg * 8);
#pragma unroll
                for (int te = 0; te < 4; ++te) nacc[te] = __builtin_amdgcn_mfma_f32_16x16x32_bf16(pa, lds_frag(VT + (16 * te + lr) * MLS + ks * 32 + kg * 8), nacc[te], 0, 0, 0); }
#pragma unroll
            for (int ks = 0; ks < 2; ++ks)
#pragma unroll
                for (int te = 0; te < 5; ++te) iacc[te] = __builtin_amdgcn_mfma_f32_16x16x32_bf16(qa[ks], lds_frag(CB + (16 * te + lr) * MLD + ks * 32 + kg * 8), iacc[te], 0, 0, 0);
#pragma unroll
            for (int r = 0; r < 4; ++r) {
                const float et = __expf(bt[r]);
                const float qn = __shfl(iacc[4][r], lane_ & 48);
                const float dn = den[r] + et * qn;
                const float inv = __builtin_amdgcn_rcpf(fmaxf(fabsf(dn), 1.0f));
                const int tau = 16 * w + 4 * kg + r;
#pragma unroll
                for (int te = 0; te < 4; ++te) { const float hv = (nacc[te][r] + et * iacc[te][r]) * inv; LAS float* hp = HL + tau * 68 + 16 * te + lr;
                    if (dir == 0) *hp = hv; else *hp += hv; }
            }
        }
        __syncthreads();
        { const int tok = tid_ >> 2, q4 = tid_ & 3; const int row = row0 + tok;
          float y[16]; float s = 0.f;
#pragma unroll
          for (int e = 0; e < 16; ++e) { y[e] = HL[tok * 68 + q4 * 16 + e]; s += y[e]; }
          s = quad_sum(s);
          const float mu = s * (1.f / 64.f); float q = 0.f;
#pragma unroll
          for (int e = 0; e < 16; ++e) { y[e] -= mu; q += y[e] * y[e]; }
          q = quad_sum(q);
          const float rstd = __builtin_amdgcn_rsqf(q * (1.f / 64.f) + NORM_EPS);
          const bf16* zo = Z + (size_t)row * NPAD + ZML + 768 + h * 64 + q4 * 16;
          float og[16]; { const v4u w0 = *(const GAS v4u*)zo, w1 = *(const GAS v4u*)(zo + 8); unpack8(w0, og); unpack8(w1, og + 8); }
          int l2_ = l; asm volatile("" : "+s"(l2_));
          const float* ng = I.ml_norm_g + l2_ * 256 + h * 64 + q4 * 16;
          float o[16];
#pragma unroll
          for (int e = 0; e < 16; ++e) o[e] = sigmoidf_(og[e]) * (y[e] * rstd * ng[e]);
          v4u a, c;
          a.x = pk2(o[0], o[1]); a.y = pk2(o[2], o[3]); a.z = pk2(o[4], o[5]); a.w = pk2(o[6], o[7]);
          c.x = pk2(o[8], o[9]); c.y = pk2(o[10], o[11]); c.z = pk2(o[12], o[13]); c.w = pk2(o[14], o[15]);
          bf16* mp = MIX + (size_t)row * D + 768 + h * 64 + q4 * 16;
          *(GAS v4u*)mp = a; *(GAS v4u*)(mp + 8) = c; }
    }
    __syncthreads();
}

__device__ __forceinline__ void build_wm(Frame& F, const Inputs& I, int l) {
    const float* mod = (const float*)(F.ws + WS_MOD); float* WM = (float*)(F.ws + WS_WM);
    bf16* WMh = (bf16*)(F.ws + WS_WM + WMB_HI); bf16* WMl = (bf16*)(F.ws + WS_WM + WMB_LO);
    const float* we = I.router_we + (size_t)l * D * 32; const float* wg = I.router_wg + (size_t)l * D * 4;
    for (int i = F.gw * 64 + F.lane; i < 9 * 48 * 1024; i += F.NGW * 64) {
        const int k = i & 1023, n = (i >> 10) % 48, s = i / (48 * 1024);
        const float G = I.norm2_g[l * D + k] * (1.0f + mod[(size_t)(l * 9 + s) * 6144 + 4096 + k]);
        const float w = (n < 32) ? we[k * 32 + n] : ((n < 36) ? wg[k * 4 + (n - 32)] : 0.f);
        const float v = G * w; const unsigned hi = f2bf(v); const float r = v - bf2f((unsigned short)hi);
        WMh[i] = (bf16)hi; WMl[i] = (bf16)f2bf(r);
    }
    for (int p = F.gw; p < 9 * 36; p += F.NGW) {
        const int s = p / 36, n = p % 36; const float* sh = mod + (size_t)(l * 9 + s) * 6144 + 3072;
        float a = 0.f;
        for (int k = F.lane; k < D; k += 64) a += sh[k] * ((n < 32) ? we[k * 32 + n] : wg[k * 4 + (n - 32)]);
        a = wave_sum(a);
        if (F.lane == 0) WM[WM_CB + s * 48 + n] = a + ((n < 32) ? I.router_be[l * 32 + n] : I.router_bg[l * 4 + (n - 32)]);
    }
}
template <bool DRY, bool KONLY = false>
__device__ __forceinline__ void p7_route(Frame& F, const Inputs& I, int l, int row_lo) {
    const bf16* xs = (const bf16*)(F.ws + WS_XS); const float* WM = (const float*)(F.ws + WS_WM);
    const bf16* WMh = (const bf16*)(F.ws + WS_WM + WMB_HI); const bf16* WMl = (const bf16*)(F.ws + WS_WM + WMB_LO);
    int* route = (int*)(F.ws + WS_ROUTE);
    unsigned* cnt = (unsigned*)(F.ctl + CW_CNT + 64 * l);
    LAS float* XL = (LAS float*)(F.lds + F.wave * 16640);
    LAS float* LG = XL;
    LAS float* rs = LG + 16 * 49;
    LAS unsigned* lc = (LAS unsigned*)(F.lds + 133120);
    LAS unsigned* gbase = lc + 32;
    const int L = F.lane, lr = L & 15, kg = L >> 4;
    const int nunits = (NT - row_lo) / 16; const int nfull = (nunits >= 8 * F.G) ? 8 * F.G : 0;
    const int nextra = nunits - nfull;
    int nxr = 0; for (int r_ = nextra; r_ > 0; r_ -= 8 * F.G) ++nxr;
    const int niter = 1 + ((nextra > 0) ? ((nextra <= F.G) ? 1 : nxr) : 0);
    for (int it = 0; it < niter; ++it) {
        if (F.tid < 32) lc[F.tid] = 0u;
        __syncthreads();
        const bool shared_it = (it > 0) && (nextra <= F.G);
        int u; bool have;
        if (it == 0) { u = F.vcu * 8 + F.wave; have = u < nfull; }
        else if (shared_it) { u = nfull + F.vcu; have = F.vcu < nextra; }
        else { u = nfull + ((it - 1) * F.G + F.vcu) * 8 + F.wave; have = u < nunits; }
        if (!have) u = 0;
        const int row0 = row_lo + u * 16; const int s = row_seq(row0);
        const int hs0 = shared_it ? F.wave : 0, nhs = shared_it ? 1 : 8;
        const bf16* xrow = xs + (size_t)(row0 + (L >> 4)) * D + 8 * (L & 15);
        const bf16* bh = WMh + ((size_t)s * 48 + lr) * 1024 + 8 * kg; const bf16* bl = WMl + ((size_t)s * 48 + lr) * 1024 + 8 * kg;
        f32x4 acc[3] = {(f32x4){0.f, 0.f, 0.f, 0.f}, (f32x4){0.f, 0.f, 0.f, 0.f}, (f32x4){0.f, 0.f, 0.f, 0.f}};
        float ssq = 0.f;
        v4u pre[4];
#pragma unroll
        for (int jj = 0; jj < 4; ++jj) pre[jj] = *(const GAS v4u*)(xrow + (size_t)(4 * jj) * D + hs0 * 128);
#define ROUTE_KSTEP(FBH, FBL) do {                                                                                                                            \
                const f32x4 a0 = *(const LAS f32x4*)(XL + lr * 132 + ks * 32 + 8 * kg), a1 = *(const LAS f32x4*)(XL + lr * 132 + ks * 32 + 8 * kg + 4);                  \
                ssq += (a0.x * a0.x + a0.y * a0.y) + (a0.z * a0.z + a0.w * a0.w) + (a1.x * a1.x + a1.y * a1.y) + (a1.z * a1.z + a1.w * a1.w);                          \
                const float xv[8] = {a0.x, a0.y, a0.z, a0.w, a1.x, a1.y, a1.z, a1.w};                                                                                    \
                unsigned hh[4], ll[4];                                                                                                                                    \
                _Pragma("unroll") for (int q = 0; q < 4; ++q) hh[q] = (__builtin_bit_cast(unsigned, xv[2 * q]) >> 16) | (__builtin_bit_cast(unsigned, xv[2 * q + 1]) & 0xffff0000u);   \
                (void)ll; const v4u hv = {hh[0], hh[1], hh[2], hh[3]};                         \
                const bf16x8 fah = __builtin_bit_cast(bf16x8, hv);                                                                                                        \
                _Pragma("unroll") for (int nt = 0; nt < 3; ++nt) {                                                                                                        \
                    acc[nt] = __builtin_amdgcn_mfma_f32_16x16x32_bf16(fah, FBH[nt], acc[nt], 0, 0, 0);                                                                    \
                    acc[nt] = __builtin_amdgcn_mfma_f32_16x16x32_bf16(fah, FBL[nt], acc[nt], 0, 0, 0); } } while (0)
        if (!shared_it) {
            LAS unsigned char* Bb = F.lds + 8448;
            const int uw = (it == 0) ? F.vcu * 8 : nfull + ((it - 1) * F.G + F.vcu) * 8;
            const int sB = row_seq(row_lo + ((uw < nunits) ? uw : 0) * 16);
            const bf16* gsrc[3]; int ldst[3]; v4u bc[3];
#pragma unroll
            for (int q = 0; q < 3; ++q) { const int c = F.tid + 512 * q, wh = (c >= 768) ? 1 : 0, cc = c - 768 * wh, n = cc >> 4, kc = cc & 15;
                gsrc[q] = (wh ? WMl : WMh) + ((size_t)sB * 48 + n) * 1024 + kc * 8; const int R = wh * 48 + n; ldst[q] = (R >> 4) * 16640 + (R & 15) * 272 + kc * 16;
                bc[q] = *(const GAS v4u*)(gsrc[q]); }
            const int fro = lr * 272 + kg * 16;
#pragma unroll 1
            for (int hq = 0; hq < 8; ++hq) {
                asm volatile("s_waitcnt lgkmcnt(0)\n\ts_barrier" ::: "memory");
#pragma unroll
                for (int q = 0; q < 3; ++q) *(LAS v4u*)(Bb + ldst[q]) = bc[q];
#pragma unroll
                for (int jj = 0; jj < 4; ++jj) { float f_[8]; unpack8(pre[jj], f_); LAS float* dst_ = XL + (4 * jj + (L >> 4)) * 132 + 8 * (L & 15);
                    *(LAS f32x4*)dst_ = (f32x4){f_[0], f_[1], f_[2], f_[3]}; *(LAS f32x4*)(dst_ + 4) = (f32x4){f_[4], f_[5], f_[6], f_[7]}; }
                if (hq + 1 < 8) {
#pragma unroll
                    for (int q = 0; q < 3; ++q) bc[q] = *(const GAS v4u*)(gsrc[q] + (hq + 1) * 128);
#pragma unroll
                    for (int jj = 0; jj < 4; ++jj) pre[jj] = *(const GAS v4u*)(xrow + (size_t)(4 * jj) * D + (hq + 1) * 128); }
                asm volatile("s_waitcnt lgkmcnt(0)\n\ts_barrier" ::: "memory");
#pragma unroll
                for (int ks = 0; ks < 4; ++ks) {
                    bf16x8 fbh[3], fbl[3];
#pragma unroll
                    for (int nt = 0; nt < 3; ++nt) { fbh[nt] = *(const LAS bf16x8*)(Bb + fro + nt * 16640 + ks * 64); fbl[nt] = *(const LAS bf16x8*)(Bb + fro + (3 + nt) * 16640 + ks * 64); }
                    ROUTE_KSTEP(fbh, fbl);
                }
            }
            WAVE_LDS_SYNC();
        } else {
#pragma unroll 1
        for (int hq = 0; hq < nhs; ++hq) {
            const int hs = hs0 + hq;
#pragma unroll
            for (int jj = 0; jj < 4; ++jj) { float f_[8]; unpack8(pre[jj], f_); LAS float* dst_ = XL + (4 * jj + (L >> 4)) * 132 + 8 * (L & 15);
                    *(LAS f32x4*)dst_ = (f32x4){f_[0], f_[1], f_[2], f_[3]}; *(LAS f32x4*)(dst_ + 4) = (f32x4){f_[4], f_[5], f_[6], f_[7]}; }
            if (hq + 1 < nhs) {
#pragma unroll
                for (int jj = 0; jj < 4; ++jj) pre[jj] = *(const GAS v4u*)(xrow + (size_t)(4 * jj) * D + (hs + 1) * 128); }
            WAVE_LDS_SYNC();
#pragma unroll
            for (int ks = 0; ks < 4; ++ks) {
                const int kk = hs * 128 + ks * 32;
                bf16x8 fbh[3], fbl[3];
#pragma unroll
                for (int nt = 0; nt < 3; ++nt) { fbh[nt] = *(const GAS bf16x8*)(bh + (size_t)nt * 16 * 1024 + kk); fbl[nt] = *(const GAS bf16x8*)(bl + (size_t)nt * 16 * 1024 + kk); }
                ROUTE_KSTEP(fbh, fbl);
            }
            WAVE_LDS_SYNC();
        }
        }
#undef ROUTE_KSTEP
        if (shared_it) {
            LAS float* PA = (LAS float*)(F.lds + F.wave * 16640);
#pragma unroll
            for (int nt = 0; nt < 3; ++nt)
#pragma unroll
                for (int r = 0; r < 4; ++r) PA[(nt * 4 + r) * 64 + L] = acc[nt][r];
            PA[12 * 64 + L] = ssq;
            __syncthreads();
            if (F.wave == 0) {
#pragma unroll 1
                for (int w2 = 1; w2 < 8; ++w2) { const LAS float* PB = (const LAS float*)(F.lds + w2 * 16640);
#pragma unroll
                    for (int nt = 0; nt < 3; ++nt)
#pragma unroll
                        for (int r = 0; r < 4; ++r) acc[nt][r] += PB[(nt * 4 + r) * 64 + L];
                    ssq += PB[12 * 64 + L]; } }
            __syncthreads();
            have = have && (F.wave == 0);
        }
        ssq += __shfl_xor(ssq, 16); ssq += __shfl_xor(ssq, 32);
        const float rstd = __builtin_amdgcn_rsqf(ssq * (1.f / D) + NORM_EPS);
        if (KONLY) { if (L == 0 && have) ((float*)(route + (size_t)NT * 8))[u & 1023] = acc[0][0] + acc[1][1] + acc[2][2] + rstd; }
        if (kg == 0) rs[lr] = rstd;
        WAVE_LDS_SYNC();
#pragma unroll
        for (int nt = 0; nt < 3; ++nt)
#pragma unroll
            for (int r = 0; r < 4; ++r) { const int i = 4 * kg + r; LG[i * 49 + nt * 16 + lr] = rs[i] * acc[nt][r] + WM[WM_CB + s * 48 + nt * 16 + lr]; }
        WAVE_LDS_SYNC();
        int e0 = 0, e1 = 0; unsigned lp0 = 0u, lp1 = 0u; float w0 = 0.f, w1 = 0.f;
        if (L < 16 && !KONLY && have) {
            const LAS float* lg = LG + L * 49;
            float gl[4];
#pragma unroll
            for (int q = 0; q < 4; ++q) gl[q] = lg[32 + q];
            int gs = 0; float gm = gl[0];
#pragma unroll
            for (int q = 1; q < 4; ++q) { const bool gt = gl[q] > gm; gm = gt ? gl[q] : gm; gs = gt ? q : gs; }
            float gsum = 0.f;
#pragma unroll
            for (int q = 0; q < 4; ++q) gsum += __expf(gl[q] - gm);
            const float gw_ = 1.0f / gsum;
            float el[8];
#pragma unroll
            for (int e = 0; e < 8; ++e) el[e] = lg[gs * 8 + e];
            int i0 = 0; float m0 = el[0];
#pragma unroll
            for (int e = 1; e < 8; ++e) { const bool gt = el[e] > m0; m0 = gt ? el[e] : m0; i0 = gt ? e : i0; }
            int i1 = -1; float m1 = -3.0e38f;
#pragma unroll
            for (int e = 0; e < 8; ++e) { const bool gt = (e != i0) && (el[e] > m1); m1 = gt ? el[e] : m1; i1 = gt ? e : i1; }
            const float p1 = __expf(m1 - m0);
            w0 = gw_ / (1.0f + p1); w1 = gw_ * p1 / (1.0f + p1);
            e0 = gs * 8 + i0; e1 = gs * 8 + i1;
            lp0 = atomicAdd((unsigned*)(lc + e0), 1u); lp1 = atomicAdd((unsigned*)(lc + e1), 1u);
        }
        __syncthreads();
        if (F.tid < 32) { const unsigned c = lc[F.tid]; gbase[F.tid] = (c && !DRY) ? atomicAdd(cnt + F.tid, c) : 0u; }
        __syncthreads();
        if (L < 16 && !KONLY && have) {
            const int row = row0 + L;
            int* rp = DRY ? (route + (size_t)NT * 8 + (size_t)(row & 1023) * 8) : (route + (size_t)row * 8);
            rp[0] = e0; rp[1] = e1; rp[2] = (int)(gbase[e0] + lp0); rp[3] = (int)(gbase[e1] + lp1); rp[4] = __builtin_bit_cast(int, w0); rp[5] = __builtin_bit_cast(int, w1);
            if (!DRY) ((float*)(route + ROUTE_RSTD))[row] = rs[L];
        }
        __syncthreads();
    }
}
__device__ __forceinline__ void p8_scatter(Frame& F, const Inputs& I, int l, int row_lo) {
    const bf16* xs = (const bf16*)(F.ws + WS_XS); const float* mod = (const float*)(F.ws + WS_MOD);
    int* route = (int*)(F.ws + WS_ROUTE); bf16* xsrt = (bf16*)(F.ws + WS_XSORT);
    const unsigned* cnt = (const unsigned*)(F.ctl + CW_CNT + 64 * l);
    int blocks = 0; if (F.lane < 32) blocks = (int)((__hip_atomic_load(cnt + F.lane, RLX_AGENT) + 255u) >> 8);
    int inc = blocks;
#pragma unroll
    for (int o = 1; o < 32; o <<= 1) { const int n = __shfl_up(inc, o); if (F.lane >= o) inc += n; }
    const int padoff = (inc - blocks) * 256;
    const GAS f32x4* ng = (const GAS f32x4*)(I.norm2_g + l * D) + F.lane;
    v2u xa[4], xb[4];
    auto ld = [&](int row, v2u (&x)[4]) { const int r_ = row < NT ? row : NT - 1; const GAS v2u* xr = (const GAS v2u*)(xs + (size_t)r_ * D) + F.lane;
#pragma unroll
        for (int j = 0; j < 4; ++j) x[j] = xr[64 * j]; };
    auto fin = [&](int row, const v2u (&x)[4]) { if (row >= NT) return;
        int* rp = route + (size_t)row * 8;
        const int e0 = rp[0], e1 = rp[1], q0 = rp[2], q1 = rp[3];
        const int d0 = __shfl(padoff, e0) + q0, d1 = __shfl(padoff, e1) + q1;
        const float rstd = ((const float*)(route + ROUTE_RSTD))[row];
        const int s = row_seq(row);
        const GAS f32x4* sh = (const GAS f32x4*)(mod + (size_t)(l * 9 + s) * 6144 + 3072) + F.lane;
        const GAS f32x4* sc = (const GAS f32x4*)(mod + (size_t)(l * 9 + s) * 6144 + 4096) + F.lane;
        GAS v2u* p0 = (GAS v2u*)(xsrt + (size_t)d0 * D) + F.lane; GAS v2u* p1 = (GAS v2u*)(xsrt + (size_t)d1 * D) + F.lane;
#pragma unroll
        for (int j = 0; j < 4; ++j) { const f32x4 xv = {bflo(x[j].x), bfhi(x[j].x), bflo(x[j].y), bfhi(x[j].y)};
            const f32x4 y = (xv * rstd * ng[64 * j]) * (sc[64 * j] + 1.0f) + sh[64 * j];
            v2u w; w.x = pk2(y.x, y.y); w.y = pk2(y.z, y.w); p0[64 * j] = w; p1[64 * j] = w; }
        if (F.lane == 0) { rp[6] = d0; rp[7] = d1; } };
    if (F.G == 256) {
        struct SRow { v2u x[4]; int e0, e1, q0, q1; float rstd; };
        const int rpw = (NT - row_lo) >> 11, r0 = row_lo + F.gw * rpw;
        f32x4 pg[4], ph[4], pc[4]; int cur_s = -1;
        auto lp = [&](int s_) { const GAS f32x4* sh = (const GAS f32x4*)(mod + (size_t)(l * 9 + s_) * 6144 + 3072) + F.lane; const GAS f32x4* sc = (const GAS f32x4*)(mod + (size_t)(l * 9 + s_) * 6144 + 4096) + F.lane;
#pragma unroll
            for (int j = 0; j < 4; ++j) { ph[j] = sh[64 * j]; pc[j] = sc[64 * j]; } };
#pragma unroll
        for (int j = 0; j < 4; ++j) pg[j] = ng[64 * j];
        cur_s = row_seq(r0); lp(cur_s);
        auto ldr = [&](int k, SRow& R) { const int row = r0 + ((k < rpw) ? k : rpw - 1); const GAS v2u* xr = (const GAS v2u*)(xs + (size_t)row * D) + F.lane;
#pragma unroll
            for (int j = 0; j < 4; ++j) R.x[j] = xr[64 * j];
            const GAS int* rp = (const GAS int*)route + (size_t)row * 8; R.e0 = rp[0]; R.e1 = rp[1]; R.q0 = rp[2]; R.q1 = rp[3];
            R.rstd = ((const GAS float*)(route + ROUTE_RSTD))[row]; };
        auto fnr = [&](int k, const SRow& R) { const int row = r0 + k; const int s_ = row_seq(row); if (s_ != cur_s) { cur_s = s_; lp(s_); }
            const int d0 = __shfl(padoff, R.e0) + R.q0, d1 = __shfl(padoff, R.e1) + R.q1;
            GAS v2u* p0 = (GAS v2u*)(xsrt + (size_t)d0 * D) + F.lane; GAS v2u* p1 = (GAS v2u*)(xsrt + (size_t)d1 * D) + F.lane;
#pragma unroll
            for (int j = 0; j < 4; ++j) { const f32x4 xv = {bflo(R.x[j].x), bfhi(R.x[j].x), bflo(R.x[j].y), bfhi(R.x[j].y)};
                const f32x4 y = (xv * R.rstd * pg[j]) * (pc[j] + 1.0f) + ph[j];
                v2u w; w.x = pk2(y.x, y.y); w.y = pk2(y.z, y.w); p0[64 * j] = w; p1[64 * j] = w; }
            if (F.lane == 0) { int* rp = route + (size_t)row * 8; rp[6] = d0; rp[7] = d1; } };
        SRow A, B;
        ldr(0, A);
#pragma unroll 1
        for (int k = 0; k < rpw; k += 2) {
            ldr(k + 1, B); fnr(k, A);
            ldr(k + 2, A); if (k + 1 < rpw) fnr(k + 1, B);
        }
        return;
    }
    ld(row_lo + F.gw, xa);
    for (int row = row_lo + F.gw; row < NT; row += 2 * F.NGW) {
        ld(row + F.NGW, xb); fin(row, xa);
        ld(row + 2 * F.NGW, xa); fin(row + F.NGW, xb);
    }
}
__device__ __forceinline__ void moe_table(Frame& F, int l, volatile LAS int* blkend) {
    const unsigned* cnt = (const unsigned*)(F.ctl + CW_CNT + 64 * l);
    if (F.wave == 0) {
        int blocks = 0; if (F.lane < 32) blocks = (int)((__hip_atomic_load(cnt + F.lane, RLX_AGENT) + 255u) >> 8);
        int inc = blocks;
#pragma unroll
        for (int o = 1; o < 32; o <<= 1) { const int n = __shfl_up(inc, o); if (F.lane >= o) inc += n; }
        if (F.lane < 32) blkend[F.lane] = inc;
    }
    __syncthreads();
}

constexpr int PH_PER_LAYER = 10, PH_FINAL = 1 + DEPTH * PH_PER_LAYER, N_PHASES = PH_FINAL + 1;
constexpr int MOE_TAB_OFF = 131072;
constexpr int N_ATT_X = NB * 4 * 32, N_ATT_C = NB * 4 * 2;

__global__ void __launch_bounds__(NWAVES * 64, 2) mk_fwd(Args args) {
    extern __shared__ __attribute__((aligned(16))) unsigned char lds[];
    Frame F;
    F.lds = (LAS unsigned char*)lds;
    F.MISC = (volatile LAS unsigned*)(F.lds + MISC_OFF);
    F.tid = threadIdx.x; F.lane = F.tid & 63; F.wave = __builtin_amdgcn_readfirstlane(F.tid >> 6);
    F.G = gridDim.x; { const int bx = blockIdx.x; F.vcu = (F.G % 8 == 0) ? (bx % 8) * (F.G / 8) + bx / 8 : bx; }
    F.gw = F.vcu * NWAVES + F.wave; F.NGW = F.G * NWAVES;
    F.ws = args.ws; F.ctl = (gu32*)(args.ws + WS_CTL);
    const float* const volatile* kp_ = (const float* const volatile*)__builtin_amdgcn_kernarg_segment_ptr();
    for (int u = F.tid; u < (LDS_BYTES - LDSCTL_OFF) / 4; u += NWAVES * 64) ((LAS unsigned*)(F.lds + LDSCTL_OFF))[u] = 0u;
    __syncthreads();
    XcdBarrier bar; bar.bar = (unsigned*)(F.ctl + CW_BAR); bar.x = 0; bar.st = nullptr;
    const int lo = args.ph_lo, hi = args.ph_hi;
    const bool fused = (hi - lo) > 1;
    if (fused) bar = xcd_barrier_post((unsigned*)(F.ctl + CW_BAR), F.MISC + 8);
#ifndef PH_ENABLE
#define PH_ENABLE 0xFFFFu
#endif
#ifndef REP_PH
#define REP_PH -1
#endif
#ifndef REP_N
#define REP_N 2
#endif
#define NREP(p) ((p) == (REP_PH) ? (REP_N) : 1)
#define REPEAT(p) _Pragma("unroll") for (int rep_ = 0; rep_ < NREP(p); ++rep_)
#define EN(p) (((PH_ENABLE) >> (p)) & 1)
#define IN(k) (lo <= (k) && (k) < hi)
#define SEAM(k) do { if (IN(k) && IN((k) + 1)) xcd_barrier(bar); } while (0)
    float* mod = (float*)(F.ws + WS_MOD);
    volatile LAS int* blkend = (volatile LAS int*)(F.lds + MOE_TAB_OFF);

#define PHASE_BEGIN() frame_refresh(F); Inputs I; I.x = uni_ptr(kp_[0]); I.c = uni_ptr(kp_[1]); I.ctx = uni_ptr(kp_[2]); I.c_ctx = uni_ptr(kp_[3]); I.ada_w = uni_ptr(kp_[4]); I.ada_b = uni_ptr(kp_[5]); I.norm1_g = uni_ptr(kp_[6]); I.norm2_g = uni_ptr(kp_[7]); I.w_in = uni_ptr(kp_[8]); I.w_out = uni_ptr(kp_[9]); I.da_lambda = uni_ptr(kp_[10]); I.da_subln_g = uni_ptr(kp_[11]); I.rw_shift_mu = uni_ptr(kp_[12]); I.rw_w0 = uni_ptr(kp_[13]); I.rw_w2 = uni_ptr(kp_[14]); I.rw_a0 = uni_ptr(kp_[15]); I.rw_a2 = uni_ptr(kp_[16]); I.rw_g2 = uni_ptr(kp_[17]); I.rw_k_k = uni_ptr(kp_[18]); I.rw_k_a = uni_ptr(kp_[19]); I.rw_r_k = uni_ptr(kp_[20]); I.rw_ln_g = uni_ptr(kp_[21]); I.rw_ln_b = uni_ptr(kp_[22]); I.ml_conv_w = uni_ptr(kp_[23]); I.ml_conv_b = uni_ptr(kp_[24]); I.ml_gate_b = uni_ptr(kp_[25]); I.ml_norm_g = uni_ptr(kp_[26]); I.router_wg = uni_ptr(kp_[27]); I.router_bg = uni_ptr(kp_[28]); I.router_we = uni_ptr(kp_[29]); I.router_be = uni_ptr(kp_[30]); I.exp_w_gu = uni_ptr(kp_[31]); I.exp_w_down = uni_ptr(kp_[32]); I.final_g = uni_ptr(kp_[33]);
    if (EN(10) && IN(0)) { PHASE_BEGIN(); REPEAT(10) p0_prologue(F, I); SEAM(0); }
#pragma unroll 1
    for (int l = 0; l < DEPTH; ++l) {
        const int pb = 1 + l * PH_PER_LAYER;
        const bool last = (l == DEPTH - 1);
        if (EN(0) && IN(pb + 0)) { PHASE_BEGIN(); if (l == 0) p_norm1<0>(F, I, l, args.out); else p_norm1<1>(F, I, l, args.out);
            if (NREP(0) > 1) p_norm1<0>(F, I, l, args.out, NREP(0) - 1);
            build_wm(F, I, l);
            if (fused && NREP(50) > 1) { for (int rb_ = 0; rb_ < 10; ++rb_) xcd_barrier(bar); }
            SEAM(pb + 0); }
        if (EN(1) && IN(pb + 1)) { PHASE_BEGIN();
            pg8::Gemm g{(const bf16*)(F.ws + WS_H1), (const bf16*)(F.ws + WS_WIN) + (size_t)l * NPAD * D, D};
            StaticOrderT<NPAD / 256> S; S.init(NT, NPAD, F.G, F.vcu);
            EpiZ E{(bf16*)(F.ws + WS_Z), NPAD, F.ws};
            REPEAT(1) pg8::gemm_phase<EpiZ, StaticOrderT<NPAD / 256>>(F.lds, g, S, E);
            SEAM(pb + 1);
        }
        if (EN(2) && IN(pb + 2)) { PHASE_BEGIN(); rwkv_chunk_pre(F, I, l, NREP(21)); REPEAT(22) p3_mlstate(F, I, l);
            asm volatile("s_waitcnt vmcnt(0)" ::: "memory"); __syncthreads();
            if (F.tid == 0) { __builtin_amdgcn_fence(__ATOMIC_RELEASE, "agent"); asm volatile("s_waitcnt vmcnt(0)" ::: "memory");
                __hip_atomic_fetch_add((unsigned*)(F.ctl + CW_PREP + 64 * l), 1u, RLX_AGENT); }
        }
        if (EN(3) && IN(pb + 3)) { PHASE_BEGIN();
            if (F.vcu < 128) {
                if (F.tid == 0) { unsigned* p = (unsigned*)(F.ctl + CW_PREP + 64 * l); unsigned sp = 0;
                    while (__hip_atomic_load(p, RLX_AGENT) < (unsigned)F.G) { __builtin_amdgcn_s_sleep(2);
                        if (++sp > (1u << 22)) { atomicAdd((unsigned*)(F.ctl + CW_BAR) + XB_TMO, 1u); break; } }
                    __builtin_amdgcn_fence(__ATOMIC_ACQUIRE, "agent"); asm volatile("s_waitcnt vmcnt(0)" ::: "memory"); }
                __syncthreads();
            }
            for (int ch = F.vcu; ch < 64; ch += F.G) { if (last) rwkv_seq<false>(F, ch, I.exp_w_gu, I.exp_w_down, 0); else rwkv_seq<true>(F, ch, I.exp_w_gu, I.exp_w_down, l + 1); publish_done(F, CW_FLAG + (l * 128 + ch) * 64); }
            for (int ch = F.vcu; ch < 128; ch += F.G) if (ch >= 64) { ml_prefix(F, ch - 64); publish_done(F, CW_FLAG + (l * 128 + ch) * 64); }
            const int n_att = last ? N_ATT_X : N_ATT_X + N_ATT_C;
            constexpr int N_CONV = 384; const int n_conv = 0;
            REPEAT(32)
            for (;;) {
                __syncthreads();
                if (F.tid == 0) F.MISC[0] = __hip_atomic_fetch_add((unsigned*)(F.ctl + CW_QUEUE + 64 * l + 8 * rep_), 1u, RLX_AGENT);
                __syncthreads();
                int u = __builtin_amdgcn_readfirstlane((int)F.MISC[0]);
                if (u >= n_att + n_conv) break;
                if (n_conv) {
                    const int j = u / 3;
                    if (u - 3 * j == 2 && j < N_CONV) { conv_unit(F, I, l + 1, j); continue; }
                    const int nc = (u + 1) / 3; u -= (nc < N_CONV) ? nc : N_CONV;
                }
                const bf16 *Qp, *Kp, *Vp; bf16* Op; int seq; size_t qstr;
                if (u < N_ATT_X) { const int b = u >> 7, h = (u >> 5) & 3, qb = u & 31;
                    Qp = (const bf16*)(F.ws + WS_QB) + ((size_t)(b * 8 + h * 2) * T + qb * 128) * 64; qstr = (size_t)T * 64;
                    Kp = (const bf16*)(F.ws + WS_KB) + (size_t)(b * 8 + h * 2) * TK * 64;
                    Vp = (const bf16*)(F.ws + WS_VB) + (size_t)(b * 4 + h) * TK * 128;
                    Op = (bf16*)(F.ws + WS_MIX) + (size_t)(NCX + b * T + qb * 128) * 1024 + h * 128; seq = TK; }
                else { const int u2 = u - N_ATT_X, b = u2 >> 3, h = (u2 >> 1) & 3, qb = u2 & 1;
                    Qp = (const bf16*)(F.ws + WS_QC) + ((size_t)(b * 8 + h * 2) * TC + qb * 128) * 64; qstr = (size_t)TC * 64;
                    Kp = (const bf16*)(F.ws + WS_KB) + (size_t)(b * 8 + h * 2) * TK * 64;
                    Vp = (const bf16*)(F.ws + WS_VB) + (size_t)(b * 4 + h) * TK * 128;
                    Op = (bf16*)(F.ws + WS_MIX) + (size_t)(b * TC + qb * 128) * 1024 + h * 128; seq = TC; }
                att::attn_unit2(Qp, Kp, Vp, Op, seq, qstr, (size_t)TK * 64, mod[MOD_LAM + l], 1.0f - (0.8f - 0.6f * __expf(-0.3f * (float)l)), I.da_subln_g + l * 128, (LAS char*)F.lds);
            }
            { PHASE_BEGIN();
            wait_all_done(F, CW_FLAG + l * 128 * 64);
            { const int u_lo = last ? 64 : 0, n_ml = 1088 - u_lo;
              for (;;) {
                __syncthreads();
                if (F.tid == 0) F.MISC[0] = __hip_atomic_fetch_add((unsigned*)(F.ctl + CW_QUEUE + 64 * l + 16), 1u, RLX_AGENT);
                __syncthreads();
                const int u = (int)F.MISC[0];
                if (u >= n_ml) break;
                p5_mlout(F, I, l, u_lo + u);
              } }
            { const int r_lo = last ? NCX : 0, n_rw = (NT - r_lo) / 128;
              for (;;) {
                __syncthreads();
                if (F.tid == 0) F.MISC[0] = __hip_atomic_fetch_add((unsigned*)(F.ctl + CW_QUEUE + 64 * l + 32), 1u, RLX_AGENT);
                __syncthreads();
                const int u = (int)F.MISC[0];
                if (u >= n_rw) break;
                const int rb = r_lo + u * 128 + F.wave * 16;
                p5_rwkv(F, I, l, rb, rb + 16, 1);
              } }
            }
            SEAM(pb + 3);
        }
        if (EN(5) && IN(pb + 5)) { PHASE_BEGIN();
            pg8::Gemm g{(const bf16*)(F.ws + WS_MIX), (const bf16*)(F.ws + WS_WOUT) + (size_t)l * D * D, D};
            StaticOrderT<D / 256> S; if (last) S.init(NXR, D, F.G, F.vcu, NCX / 256); else S.init(NT, D, F.G, F.vcu);
            EpiResid E{(bf16*)(F.ws + WS_XS), mod + (size_t)l * 9 * 6144 + 2048, (l == 0) ? I.ctx : nullptr, (l == 0) ? I.x : nullptr};
            pg8::gemm_phase<EpiResid, StaticOrderT<D / 256>>(F.lds, g, S, E);
            REPEAT(5) { if (rep_ > 0) { EpiF32 E2{(float*)(F.ws + WS_YS)}; pg8::gemm_phase<EpiF32, StaticOrderT<D / 256>>(F.lds, g, S, E2); } }
            SEAM(pb + 5);
        }
        if (EN(6) && IN(pb + 6)) { PHASE_BEGIN(); p7_route<false>(F, I, l, last ? NCX : 0); REPEAT(6) { if (rep_ > 0) p7_route<true>(F, I, l, 0); } REPEAT(61) { if (rep_ > 0) p7_route<true, true>(F, I, l, 0); } SEAM(pb + 6); }
        if (EN(7) && IN(pb + 7)) { PHASE_BEGIN(); REPEAT(7) p8_scatter(F, I, l, last ? NCX : 0); SEAM(pb + 7); }
        if (EN(8) && IN(pb + 8)) { PHASE_BEGIN();
            moe_table(F, l, blkend);
            pg8::Gemm g{(const bf16*)(F.ws + WS_XSORT), (const bf16*)(F.ws + WS_WGU) + (size_t)l * NEXP * 1024 * D, D};
            MoeOrder S{blkend, F.G, F.vcu, (size_t)1024 * D * 2};
            EpiSwiGLU E{(bf16*)(F.ws + WS_ACT)};
            REPEAT(8) pg8::gemm_phase<EpiSwiGLU, MoeOrder>(F.lds, g, S, E);
            SEAM(pb + 8);
        }
        if (EN(9) && IN(pb + 9)) { PHASE_BEGIN();
            moe_table(F, l, blkend);
            pg8::Gemm g{(const bf16*)(F.ws + WS_ACT), (const bf16*)(F.ws + WS_WDN) + (size_t)l * NEXP * D * EH, EH};
            MoeOrder S{blkend, F.G, F.vcu, (size_t)D * EH * 2};
            EpiY16 E{(bf16*)(F.ws + WS_YS)};
            REPEAT(9) pg8::gemm_phase<EpiY16, MoeOrder>(F.lds, g, S, E);
            SEAM(pb + 9);
        }
    }
    if (EN(11) && IN(PH_FINAL)) { PHASE_BEGIN(); p_norm1<2>(F, I, DEPTH, args.out); }
#undef IN
#undef SEAM
}

extern "C" void kernel_launch(void* const* d_in, const int* in_sizes, int n_in, void* d_out, int out_size, void* d_ws, size_t ws_size, hipStream_t stream) {
    static int grid = 0;
    if (grid == 0) {
        if (n_in != 34 || in_sizes[0] != NXR * D || out_size != NXR * D || ws_size < WS_END) {
            fprintf(stderr, "kernel_launch: unexpected shapes: n_in %d in0 %d out %d ws %zu (need %zu)\n", n_in, n_in > 0 ? in_sizes[0] : -1, out_size, ws_size, (size_t)WS_END); grid = -1; return; }
        int dev = 0, cus = 0, per_cu = 0;
        if (hipGetDevice(&dev) != hipSuccess || hipDeviceGetAttribute(&cus, hipDeviceAttributeMultiprocessorCount, dev) != hipSuccess) { grid = -1; return; }
        if (hipFuncSetAttribute((const void*)mk_fwd, hipFuncAttributeMaxDynamicSharedMemorySize, LDS_BYTES) != hipSuccess) { fprintf(stderr, "kernel_launch: hipFuncSetAttribute failed\n"); grid = -1; return; }
        if (hipOccupancyMaxActiveBlocksPerMultiprocessor(&per_cu, (const void*)mk_fwd, NWAVES * 64, LDS_BYTES) != hipSuccess || per_cu < 1)
            fprintf(stderr, "kernel_launch: occupancy query reports %d blocks per CU\n", per_cu);
        (void)hipGetLastError();
        grid = cus;
    }
    if (grid < 0) return;
    if (hipMemsetAsync((char*)d_ws + WS_CTL, 0, CTL_ZERO_BYTES, stream) != hipSuccess) return;
    Args a{};
    const float** ip = (const float**)&a.in;
    for (int i = 0; i < 34; ++i) ip[i] = (const float*)d_in[i];
    a.out = (float*)d_out; a.ws = (unsigned char*)d_ws;
#if MK_N_LAUNCHES == 1
    a.ph_lo = 0; a.ph_hi = N_PHASES;
    hipLaunchKernelGGL(mk_fwd, dim3(grid), dim3(NWAVES * 64), LDS_BYTES, stream, a);
#else
    for (int p = 0; p < N_PHASES; ++p) { a.ph_lo = p; a.ph_hi = p + 1;
        hipLaunchKernelGGL(mk_fwd, dim3(grid), dim3(NWAVES * 64), LDS_BYTES, stream, a); }
#endif
    const hipError_t le = hipPeekAtLastError();
    if (le != hipSuccess) fprintf(stderr, "kernel_launch: launch failed: %s\n", hipGetErrorName(le));
}
```

```cpp
#include <hip/hip_runtime.h>
#include <cstdio>
#include <cstdint>

#ifndef MK_N_LAUNCHES
#define MK_N_LAUNCHES 1
#endif

namespace pg8 {
#define PG8_LAS __attribute__((address_space(3)))
typedef unsigned short bf16_t;
typedef short bf16x8 __attribute__((ext_vector_type(8)));
typedef float f32x4 __attribute__((ext_vector_type(4)));
typedef unsigned u32x4 __attribute__((ext_vector_type(4)));
constexpr int BM = 256, BK = 64, HALF = 128, HTB = HALF * BK * 2, STAGE_BYTES = 8 * HTB;

__host__ __device__ __forceinline__ int lds_byte(int r, int c) { const int st = (r >> 4) * 2 + (c >> 5), rr = r & 15, cc = c & 31, ob = rr * 64 + cc * 2; return st * 1024 + (ob ^ (((ob >> 9) & 1) << 5)); }
__host__ __device__ __forceinline__ void stage_rc(int b, int& R, int& C) { const int st = b / 1024, sb = b % 1024, swz = sb ^ (((sb >> 9) & 1) << 5); R = (st >> 1) * 16 + swz / 64; C = (st & 1) * 32 + (swz % 64) / 2; }
__host__ __device__ __forceinline__ int perm32(int rho) { const int n = rho >> 4, i = rho & 15; return 8 * (i >> 2) + 4 * n + (i & 3); }

struct Unit { int pm, pn; size_t boff; };
struct Gemm { const bf16_t* A; const bf16_t* Bt; int K; };

__device__ __forceinline__ unsigned cvt_pk_bf16(float lo, float hi) { unsigned r; asm volatile("v_cvt_pk_bf16_f32 %0, %1, %2" : "=v"(r) : "v"(lo), "v"(hi)); return r; }

template <class Epi, class Sched, bool ALIGN_EPI = true, bool SP2 = true>
__device__ __forceinline__ void gemm_phase(PG8_LAS unsigned char* lds, const Gemm g, const Sched& S, const Epi& E) {
    int tid = threadIdx.x; asm volatile("" : "+v"(tid));
    const int wid = __builtin_amdgcn_readfirstlane(tid >> 6), lane = tid & 63, wr = wid >> 2, wc = wid & 3, fr = lane & 15, fq = lane >> 4;
    const int K = g.K, nt = K / BK;
    unsigned voffA[2], voffB[2];
#pragma unroll
    for (int i = 0; i < 2; ++i) { int R, C; stage_rc(tid * 16 + i * 8192, R, C); const int Rb = Epi::PERM ? ((R & ~31) + perm32(R & 31)) : R;
        voffA[i] = (unsigned)(R * K + C) * 2u; voffB[i] = (unsigned)(Rb * K + C) * 2u; }
    const size_t kstep = (size_t)(BK * 2);
    const size_t hstep = (size_t)HALF * K * 2;
    const size_t tstep = 2 * hstep;
    const unsigned ldsw = (unsigned)wid * 1024u;
    const int aoff = lds_byte(wr * 64 + fr, fq * 8), boff = lds_byte(wc * 32 + fr, fq * 8);
#define PG8_SA(b, h) (((b) * 2 + (h)) * HTB)
#define PG8_SB(b, h) ((4 + (b) * 2 + (h)) * HTB)
#define PG8_STAGE(bufoff, gbase, voff) do { _Pragma("unroll") for (int _i = 0; _i < 2; ++_i) \
        __builtin_amdgcn_global_load_lds((const unsigned*)((const char*)(gbase) + (voff)[_i]), (PG8_LAS unsigned*)(lds + (bufoff) + ldsw + _i * 8192), 16, 0, 0); } while (0)
#define PG8_LDA(dst, b, h) do { _Pragma("unroll") for (int m = 0; m < 4; ++m) _Pragma("unroll") for (int k = 0; k < 2; ++k) dst[m][k] = *(const PG8_LAS bf16x8*)(lds + PG8_SA(b, h) + aoff + m * 2048 + k * 1024); } while (0)
#define PG8_LDB(dst, b, h) do { _Pragma("unroll") for (int n = 0; n < 2; ++n) _Pragma("unroll") for (int k = 0; k < 2; ++k) dst[n][k] = *(const PG8_LAS bf16x8*)(lds + PG8_SB(b, h) + boff + n * 2048 + k * 1024); } while (0)
#define PG8_MMA(ai, bj, At, Bt) do { __builtin_amdgcn_s_setprio(1); _Pragma("unroll") for (int m = 0; m < 4; ++m) _Pragma("unroll") for (int n = 0; n < 2; ++n) _Pragma("unroll") for (int k = 0; k < 2; ++k) \
        acc[ai][bj][m][n] = __builtin_amdgcn_mfma_f32_16x16x32_bf16(Bt[n][k], At[m][k], acc[ai][bj][m][n], 0, 0, 0); __builtin_amdgcn_s_setprio(0); } while (0)
#define PG8_WAIT_V(n) asm volatile("s_waitcnt vmcnt(" #n ")" ::: "memory")
#define PG8_WAIT_L(n) asm volatile("s_waitcnt lgkmcnt(" #n ")" ::: "memory")
#define PG8_BAR __builtin_amdgcn_s_barrier()
#define PG8_SCHED __builtin_amdgcn_sched_barrier(0)
    Unit cur, nxt; int ui = 0;
    if (!S.next(0, cur)) return;
    f32x4 acc[2][2][4][2];
#pragma unroll
    for (int a = 0; a < 2; ++a)
#pragma unroll
        for (int b = 0; b < 2; ++b)
#pragma unroll
            for (int m = 0; m < 4; ++m)
#pragma unroll
                for (int n = 0; n < 2; ++n) acc[a][b][m][n] = (f32x4){0.f, 0.f, 0.f, 0.f};
    bf16x8 At[4][2], B0[2][2], B1[2][2];
    const char* cA = (const char*)g.A + (size_t)cur.pm * tstep; const char* cB = (const char*)g.Bt + cur.boff + (size_t)cur.pn * tstep;
    if constexpr (SP2) {
        PG8_STAGE(PG8_SB(0, 0), cB, voffB); PG8_STAGE(PG8_SB(0, 1), cB + hstep, voffB); PG8_STAGE(PG8_SA(0, 0), cA, voffA); PG8_STAGE(PG8_SA(0, 1), cA + hstep, voffA);
        if (wr == 1) PG8_BAR;
        PG8_WAIT_V(2); PG8_BAR;
        PG8_STAGE(PG8_SB(1, 0), cB + kstep, voffB); PG8_STAGE(PG8_SA(1, 0), cA + kstep, voffA); PG8_STAGE(PG8_SB(1, 1), cB + hstep + kstep, voffB);
        PG8_WAIT_V(6); PG8_BAR;
    } else {
        PG8_STAGE(PG8_SB(0, 0), cB, voffB); PG8_STAGE(PG8_SA(0, 0), cA, voffA); PG8_STAGE(PG8_SB(0, 1), cB + hstep, voffB); PG8_STAGE(PG8_SA(0, 1), cA + hstep, voffA);
        if (wr == 1) PG8_BAR;
        PG8_WAIT_V(4); PG8_BAR;
        PG8_STAGE(PG8_SB(1, 0), cB + kstep, voffB); PG8_STAGE(PG8_SA(1, 0), cA + kstep, voffA); PG8_STAGE(PG8_SB(1, 1), cB + hstep + kstep, voffB);
        PG8_WAIT_V(6); PG8_BAR;
    }
    for (;;) {
        const bool has_next = S.next(ui + 1, nxt);
        const char* nA = has_next ? (const char*)g.A + (size_t)nxt.pm * tstep : cA; const char* nB = has_next ? (const char*)g.Bt + nxt.boff + (size_t)nxt.pn * tstep : cB;
        for (int t = 0; t < nt; t += 2) {
            const bool last = (t == nt - 2);
            const char* a1 = cA + (size_t)(t + 1) * kstep;
            const char* a2 = last ? nA : cA + (size_t)(t + 2) * kstep; const char* b2 = last ? nB : cB + (size_t)(t + 2) * kstep;
            const char* a3 = a2 + kstep; const char* b3 = b2 + kstep;
            if constexpr (SP2) {
            PG8_LDB(B0, 0, 0); PG8_LDB(B1, 0, 1); PG8_SCHED; PG8_LDA(At, 0, 0); PG8_STAGE(PG8_SA(1, 1), a1 + hstep, voffA);
            PG8_WAIT_V(8); PG8_WAIT_L(0); PG8_BAR; PG8_MMA(0, 0, At, B0); PG8_MMA(0, 1, At, B1); PG8_BAR; PG8_SCHED;
            PG8_LDA(At, 0, 1); PG8_STAGE(PG8_SB(0, 0), b2, voffB); PG8_STAGE(PG8_SB(0, 1), b2 + hstep, voffB); PG8_STAGE(PG8_SA(0, 0), a2, voffA);
            PG8_WAIT_V(8); PG8_WAIT_L(0); PG8_BAR; PG8_MMA(1, 0, At, B0); PG8_MMA(1, 1, At, B1); PG8_BAR; PG8_SCHED;
            PG8_LDB(B0, 1, 0); PG8_LDB(B1, 1, 1); PG8_SCHED; PG8_LDA(At, 1, 0); PG8_STAGE(PG8_SA(0, 1), a2 + hstep, voffA);
            PG8_WAIT_V(8); PG8_WAIT_L(0); PG8_BAR; PG8_MMA(0, 0, At, B0); PG8_MMA(0, 1, At, B1); PG8_BAR; PG8_SCHED;
            PG8_LDA(At, 1, 1); PG8_STAGE(PG8_SB(1, 0), b3, voffB); PG8_STAGE(PG8_SB(1, 1), b3 + hstep, voffB); PG8_STAGE(PG8_SA(1, 0), a3, voffA);
            PG8_WAIT_V(8); PG8_WAIT_L(0); PG8_BAR; PG8_MMA(1, 0, At, B0); PG8_MMA(1, 1, At, B1); PG8_BAR; PG8_SCHED;
            } else {
            PG8_LDB(B0, 0, 0); PG8_SCHED; PG8_LDA(At, 0, 0); PG8_STAGE(PG8_SA(1, 1), a1 + hstep, voffA);
            PG8_WAIT_L(8); PG8_BAR; PG8_WAIT_L(0); PG8_MMA(0, 0, At, B0); PG8_BAR; PG8_SCHED;
            PG8_LDB(B1, 0, 1); PG8_STAGE(PG8_SB(0, 0), b2, voffB);
            PG8_BAR; PG8_WAIT_L(0); PG8_MMA(0, 1, At, B1); PG8_BAR;
            PG8_LDA(At, 0, 1); PG8_STAGE(PG8_SA(0, 0), a2, voffA);
            PG8_BAR; PG8_WAIT_L(0); PG8_MMA(1, 0, At, B0); PG8_BAR; PG8_SCHED;
            PG8_STAGE(PG8_SB(0, 1), b2 + hstep, voffB);
            PG8_WAIT_V(6); PG8_BAR; PG8_MMA(1, 1, At, B1); PG8_BAR;
            PG8_LDB(B0, 1, 0); PG8_SCHED; PG8_LDA(At, 1, 0); PG8_STAGE(PG8_SA(0, 1), a2 + hstep, voffA);
            PG8_WAIT_L(8); PG8_BAR; PG8_WAIT_L(0); PG8_MMA(0, 0, At, B0); PG8_BAR; PG8_SCHED;
            PG8_LDB(B1, 1, 1); PG8_STAGE(PG8_SB(1, 0), b3, voffB);
            PG8_BAR; PG8_WAIT_L(0); PG8_MMA(0, 1, At, B1); PG8_BAR;
            PG8_LDA(At, 1, 1); PG8_STAGE(PG8_SA(1, 0), a3, voffA);
            PG8_BAR; PG8_WAIT_L(0); PG8_MMA(1, 0, At, B0); PG8_BAR; PG8_SCHED;
            PG8_STAGE(PG8_SB(1, 1), b3 + hstep, voffB);
            PG8_WAIT_V(6); PG8_BAR; PG8_MMA(1, 1, At, B1); PG8_BAR;
            }
        }
        if constexpr (ALIGN_EPI) { if (wr == 0) PG8_BAR; }
        E(acc, cur, wr, wc, fr, fq);
        if (!has_next) break;
#pragma unroll
        for (int a = 0; a < 2; ++a)
#pragma unroll
            for (int b = 0; b < 2; ++b)
#pragma unroll
                for (int m = 0; m < 4; ++m)
#pragma unroll
                    for (int n = 0; n < 2; ++n) acc[a][b][m][n] = (f32x4){0.f, 0.f, 0.f, 0.f};
        cur = nxt; cA = nA; cB = nB; ++ui;
        if constexpr (ALIGN_EPI) { if (wr == 1) PG8_BAR; }
    }
    PG8_WAIT_V(0);
    if constexpr (!ALIGN_EPI) { if (wr == 0) PG8_BAR; }
    PG8_BAR;
#undef PG8_SA
#undef PG8_SB
#undef PG8_STAGE
#undef PG8_LDA
#undef PG8_LDB
#undef PG8_MMA
#undef PG8_WAIT_V
#undef PG8_WAIT_L
#undef PG8_BAR
#undef PG8_SCHED
}
}

constexpr int D = 1024, NB = 8, T = 4096, TC = 256, DEPTH = 4, GRID_W = 64;
constexpr int NCX = NB * TC;
constexpr int NXR = NB * T;
constexpr int NT = NCX + NXR;
constexpr int IN_COLS = 3536, NPAD = 3584;
constexpr int ZQ = 0, ZK = 512, ZV = 1024, ZRW = 1536, ZML = 2496;
constexpr int TK = TC + T;
constexpr int NEXP = 32, EH = 512;
constexpr int MOE_ROWS = 2 * NT + NEXP * 256;
constexpr int NWAVES = 8;
constexpr float NORM_EPS = 1e-6f;

constexpr size_t MiB = 1u << 20;
constexpr size_t WS_CTL = 0, CTL_ZERO_BYTES = 1 * MiB;
constexpr size_t WS_XS = 1 * MiB;
constexpr size_t WS_WIN = 137 * MiB;
constexpr size_t WS_WOUT = 165 * MiB;
constexpr size_t WS_WGU = 173 * MiB;
constexpr size_t WS_WDN = 429 * MiB;
constexpr size_t WS_MOD = 557 * MiB;
constexpr size_t WS_H1 = 558 * MiB;
constexpr size_t WS_ROUTE = 626 * MiB;
constexpr size_t WS_A = 628 * MiB;
constexpr size_t WS_Z = WS_A;
constexpr size_t WS_QB = WS_A + 238 * MiB;
constexpr size_t WS_QC = WS_A + 270 * MiB;
constexpr size_t WS_KB = WS_A + 272 * MiB;
constexpr size_t WS_VB = WS_A + 306 * MiB;
constexpr size_t WS_ATTO = WS_A + 340 * MiB;
constexpr size_t WS_RWC = WS_A + 476 * MiB;
constexpr size_t WS_RV = WS_A + 723 * MiB;
constexpr size_t WS_RG = WS_A + 782 * MiB;
constexpr size_t WS_RBS = WS_A + 757 * MiB;
constexpr size_t WS_RYS = WS_A + 817 * MiB;
constexpr size_t WS_DC = WS_A + 885 * MiB;
constexpr size_t WS_CS = WS_A + 919 * MiB;
constexpr size_t WS_DN = WS_A + 953 * MiB;
constexpr size_t WS_NS = WS_A + 954 * MiB;
constexpr size_t WS_MIX = WS_A + 955 * MiB;
constexpr size_t WS_XSORT = WS_A;
constexpr size_t WS_ACT = WS_A + 152 * MiB;
constexpr size_t WS_YS = WS_A + 228 * MiB;
constexpr size_t WS_WM = WS_A + 1023 * MiB;
constexpr size_t WS_LORA = WS_A + 1025 * MiB;
constexpr size_t WS_END = WS_A + 1026 * MiB;
static_assert(WS_YS + (size_t)MOE_ROWS * 1024 * 4 <= WS_END, "ws map");
constexpr int MOD_LAM = 4 * 9 * 6144;
constexpr int MOD_ROPE = MOD_LAM + 64;
constexpr int LORA_A2T = 4 * 2 * 256 * 32, LORA_G2T = 2 * LORA_A2T;
constexpr int WM_CB = 0;
constexpr size_t WMB_HI = 4096, WMB_LO = 4096 + 9 * 48 * 1024 * 2;
constexpr int ROUTE_RSTD = 327680;
constexpr int CW_TMO = 0;
constexpr int CW_BAR = 4096;
constexpr int CW_QUEUE = 8192;
constexpr int CW_CNT = 9216;
constexpr int CW_PREP = 24576;
constexpr int CW_FLAG = 32768;
constexpr int RING_BYTES = 131072;
constexpr int LDSCTL_OFF = 139264, MISC_OFF = LDSCTL_OFF + 320;
constexpr int LDS_BYTES = 147456;

#define GAS __attribute__((address_space(1)))
#define LAS __attribute__((address_space(3)))
typedef unsigned short bf16;
typedef unsigned v4u __attribute__((ext_vector_type(4)));
typedef unsigned v2u __attribute__((ext_vector_type(2)));
typedef float f32x4 __attribute__((ext_vector_type(4)));
typedef float f32x16 __attribute__((ext_vector_type(16)));
typedef short bf16x8 __attribute__((ext_vector_type(8)));
typedef short s16x4 __attribute__((ext_vector_type(4)));
typedef GAS unsigned gu32;
#define RLX_AGENT __ATOMIC_RELAXED, __HIP_MEMORY_SCOPE_AGENT
__device__ __forceinline__ unsigned pk2(float lo, float hi) { unsigned r; asm volatile("v_cvt_pk_bf16_f32 %0, %1, %2" : "=v"(r) : "v"(lo), "v"(hi)); return r; }
__device__ __forceinline__ unsigned f2bf(float f) { return (__builtin_bit_cast(unsigned, f) + 0x8000u) >> 16; }
__device__ __forceinline__ float bf2f(unsigned short b) { return __builtin_bit_cast(float, ((unsigned)b) << 16); }
__device__ __forceinline__ float bflo(unsigned w) { return __builtin_bit_cast(float, w << 16); }
__device__ __forceinline__ float bfhi(unsigned w) { return __builtin_bit_cast(float, w & 0xffff0000u); }
__device__ __forceinline__ void unpack8(const v4u w, float* f) { f[0] = bflo(w.x); f[1] = bfhi(w.x); f[2] = bflo(w.y); f[3] = bfhi(w.y); f[4] = bflo(w.z); f[5] = bfhi(w.z); f[6] = bflo(w.w); f[7] = bfhi(w.w); }
__device__ __forceinline__ float sigmoidf_(float x) { return __builtin_amdgcn_rcpf(1.f + __builtin_amdgcn_exp2f(-1.4426950408889634f * x)); }
__device__ __forceinline__ float siluf_(float x) { return x * __builtin_amdgcn_rcpf(1.f + __builtin_amdgcn_exp2f(-1.4426950408889634f * x)); }
__device__ __forceinline__ float rl_f(float v, int lane_) { return __builtin_bit_cast(float, __builtin_amdgcn_readlane(__builtin_bit_cast(int, v), lane_)); }
#define DPP_ADD(v, ctrl, rmask) ((v) + __builtin_bit_cast(float, __builtin_amdgcn_update_dpp(0, __builtin_bit_cast(int, (v)), (ctrl), (rmask), 0xF, false)))
__device__ __forceinline__ float quad_sum(float v) { v = DPP_ADD(v, 0xB1, 0xF); v = DPP_ADD(v, 0x4E, 0xF); return v; }
__device__ __forceinline__ float row8_sum(float v) { v = quad_sum(v); v = DPP_ADD(v, 0x141, 0xF); return v; }
__device__ __forceinline__ float row16_sum(float v) { v = row8_sum(v); v = DPP_ADD(v, 0x140, 0xF); return v; }
__device__ __forceinline__ float wave_sum(float v) {
    v = row16_sum(v); v = DPP_ADD(v, 0x142, 0xA); v = DPP_ADD(v, 0x143, 0xC);
    return __builtin_bit_cast(float, __builtin_amdgcn_readlane(__builtin_bit_cast(int, v), 63));
}

#define XB_TMO      128
#define XB_XCNT(j)  (256  + 64 * (j))
#define XB_XSUB(j)  (1280 + 64 * (j))
#define XB_XGEN(j)  (2304 + 64 * (j))
#define XB_TOP      3328
#define XB_TOPGEN   3392
#define XCD_BAR_WORDS 3456
#define XB_SPIN_CAP (1u << 22)
__device__ __forceinline__ unsigned xb_ld(unsigned* p)              { return __hip_atomic_load(p, __ATOMIC_RELAXED, __HIP_MEMORY_SCOPE_AGENT); }
__device__ __forceinline__ unsigned xb_add(unsigned* p, unsigned v) { return __hip_atomic_fetch_add(p, v, __ATOMIC_RELAXED, __HIP_MEMORY_SCOPE_AGENT); }
__device__ __forceinline__ unsigned xb_xcc_id() { return (unsigned)__builtin_amdgcn_s_getreg((3 << 11) | 20) & 0xFu; }
#define XB_SPIN(cond, bar) do { unsigned _sp = 0; while (cond) { __builtin_amdgcn_s_sleep(1); \
    if ((++_sp & 255u) == 0u) { if (xb_ld(&(bar)[XB_TMO])) break; if (_sp > XB_SPIN_CAP) { atomicAdd(&(bar)[XB_TMO], 1u); break; } } } } while (0)
struct XcdBarrier { unsigned* bar; unsigned x; volatile LAS unsigned* st; };
__device__ __forceinline__ XcdBarrier xcd_barrier_post(unsigned* bar, volatile LAS unsigned* st) {
    XcdBarrier b; b.bar = bar; b.x = xb_xcc_id(); b.st = st;
    if (threadIdx.x == 0) (void)xb_add(&bar[XB_XCNT(b.x)], 1u);
    return b;
}
__device__ __forceinline__ void xcd_barrier_complete(unsigned* bar, unsigned x, unsigned& nloc, unsigned& nx) {
    const unsigned G = gridDim.x * gridDim.y * gridDim.z;
    unsigned sum, cnt, mine, sp = 0u;
    for (;;) {
        sum = 0u; cnt = 0u; mine = 0u;
#pragma unroll
        for (unsigned j = 0; j < 16; ++j) { const unsigned c = xb_ld(&bar[XB_XCNT(j)]); sum += c; cnt += (c > 0u) ? 1u : 0u; mine = (j == x) ? c : mine; }
        if (sum == G) break;
        __builtin_amdgcn_s_sleep(1);
        if ((++sp & 255u) == 0u) { if (xb_ld(&bar[XB_TMO])) break; if (sp > XB_SPIN_CAP) { atomicAdd(&bar[XB_TMO], 1u); break; } }
    }
    nloc = mine > 0u ? mine : 1u; nx = cnt > 0u ? cnt : 1u;
}
__device__ __forceinline__ void xcd_barrier(const XcdBarrier& b) {
    asm volatile("s_waitcnt vmcnt(0)" ::: "memory");
    __syncthreads();
    if (threadIdx.x == 0) {
        unsigned* bar = b.bar;
        __builtin_amdgcn_s_waitcnt(0);
        unsigned nloc = b.st[0], nx = b.st[1];
        if (nloc == 0u) { xcd_barrier_complete(bar, b.x, nloc, nx); b.st[0] = nloc; b.st[1] = nx; }
        const unsigned old = xb_add(&bar[XB_XSUB(b.x)], 1u);
        const unsigned gen = old / nloc;
        if (old + 1u == (gen + 1u) * nloc) {
            __builtin_amdgcn_fence(__ATOMIC_RELEASE, "agent");
            asm volatile("s_waitcnt vmcnt(0)" ::: "memory");
            const unsigned og = xb_add(&bar[XB_TOP], 1u);
            const unsigned tg = og / nx;
            if (og + 1u == (tg + 1u) * nx) xb_add(&bar[XB_TOPGEN], 1u);
            else XB_SPIN(xb_ld(&bar[XB_TOPGEN]) == tg, bar);
            __builtin_amdgcn_fence(__ATOMIC_ACQUIRE, "agent");
            xb_add(&bar[XB_XGEN(b.x)], 1u);
            asm volatile("s_waitcnt vmcnt(0)" ::: "memory");
        } else {
            XB_SPIN(xb_ld(&bar[XB_XGEN(b.x)]) == gen, bar);
            __builtin_amdgcn_fence(__ATOMIC_ACQUIRE, "agent");
            asm volatile("s_waitcnt vmcnt(0)" ::: "memory");
        }
    }
    __syncthreads();
}

struct Inputs {
    const float *x, *c, *ctx, *c_ctx, *ada_w, *ada_b, *norm1_g, *norm2_g, *w_in, *w_out, *da_lambda, *da_subln_g,
                *rw_shift_mu, *rw_w0, *rw_w2, *rw_a0, *rw_a2, *rw_g2, *rw_k_k, *rw_k_a, *rw_r_k, *rw_ln_g, *rw_ln_b,
                *ml_conv_w, *ml_conv_b, *ml_gate_b, *ml_norm_g, *router_wg, *router_bg, *router_we, *router_be,
                *exp_w_gu, *exp_w_down, *final_g;
};
struct Args { Inputs in; float* out; unsigned char* ws; int ph_lo, ph_hi; };
struct Frame {
    LAS unsigned char* lds;
    volatile LAS unsigned* MISC;
    gu32* ctl;
    unsigned char* ws;
    int tid, lane, wave, vcu, G, gw, NGW;
};
__device__ __forceinline__ const float* uni_ptr(const float* p) {
    const unsigned long long u = (unsigned long long)p; const unsigned lo = __builtin_amdgcn_readfirstlane((unsigned)u), hi = __builtin_amdgcn_readfirstlane((unsigned)(u >> 32));
    return (const float*)(((unsigned long long)hi << 32) | lo); }
__device__ __forceinline__ void frame_refresh(Frame& F) {
    int t = threadIdx.x; asm volatile("" : "+v"(t));
    F.tid = t; F.lane = t & 63; F.wave = __builtin_amdgcn_readfirstlane(t >> 6); F.gw = F.vcu * NWAVES + F.wave;
}
__device__ __forceinline__ void publish_done(Frame& F, int flag_word) {
    asm volatile("s_waitcnt vmcnt(0)" ::: "memory");
    __syncthreads();
    if (threadIdx.x == 0) {
        __builtin_amdgcn_fence(__ATOMIC_RELEASE, "agent");
        asm volatile("s_waitcnt vmcnt(0)" ::: "memory");
        __hip_atomic_store((unsigned*)(F.ctl + flag_word), 1u, RLX_AGENT);
    }
}
__device__ __forceinline__ void wait_all_done(Frame& F, int flag_base) {
    int t_ = threadIdx.x; asm volatile("" : "+v"(t_));
    if (t_ < 128) {
        unsigned* p = (unsigned*)(F.ctl + flag_base + 64 * t_); unsigned sp = 0;
        while (__hip_atomic_load(p, RLX_AGENT) == 0u) { __builtin_amdgcn_s_sleep(2);
            if (++sp > (1u << 22)) { atomicAdd((unsigned*)(F.ctl + CW_BAR) + XB_TMO, 1u); break; } }
    }
    __syncthreads();
    if (threadIdx.x == 0) { __builtin_amdgcn_fence(__ATOMIC_ACQUIRE, "agent"); asm volatile("s_waitcnt vmcnt(0)" ::: "memory"); }
    __syncthreads();
}
__device__ __forceinline__ int row_seq(int row) { return row < NCX ? 8 : ((row - NCX) >> 12); }

template <int RMAP>
__device__ __forceinline__ void transpose_item(const float* W, int K, int N, bf16* WT, LAS float* scr, int item, int lane) {
    const int nblk = (N + 31) / 32, kb = item / nblk, nb = item % nblk, k0 = 64 * kb, n0 = 32 * nb;
    const int ncol = n0 + (lane & 31);
    float tv[32];
#pragma unroll
    for (int i = 0; i < 32; ++i) { const int kk = 2 * i + (lane >> 5); tv[i] = (ncol < N) ? W[(size_t)(k0 + kk) * N + ncol] : 0.f; }
#pragma unroll
    for (int i = 0; i < 32; ++i) { const int kk = 2 * i + (lane >> 5); scr[kk * 33 + (lane & 31)] = tv[i]; }
    asm volatile("s_waitcnt lgkmcnt(0)" ::: "memory");
    const int c = lane & 7;
#pragma unroll
    for (int j = 0; j < 4; ++j) { const int n = (lane >> 3) + 8 * j; const LAS float* s = scr + (8 * c) * 33 + n;
        v4u o; o.x = pk2(s[0 * 33], s[1 * 33]); o.y = pk2(s[2 * 33], s[3 * 33]); o.z = pk2(s[4 * 33], s[5 * 33]); o.w = pk2(s[6 * 33], s[7 * 33]);
        int nn = n0 + n;
        if (nn < N) {
            if (RMAP == 1) { nn = (nn < 512) ? ((nn >> 7) * 256 + (nn & 127)) : ((((nn - 512) >> 7) * 256) + 128 + ((nn - 512) & 127)); }
            *(GAS v4u*)(WT + (size_t)nn * K + k0 + 8 * c) = o; } }
    asm volatile("s_waitcnt lgkmcnt(0)" ::: "memory");
}

__device__ __forceinline__ void p0_prologue(Frame& F, const Inputs& I) {
    LAS float* scr = (LAS float*)(F.lds + F.wave * 16384);
    unsigned char* ws = F.ws;
    constexpr int I_IN = 16 * 111, I_OUT = 16 * 32, I_GU = 16 * 32, I_DN = 8 * 32;
    constexpr int N_IN = DEPTH * I_IN, N_OUT = DEPTH * I_OUT, N_GU = NEXP * I_GU, N_DN = NEXP * I_DN;
    for (int it = F.gw; it < N_IN + N_OUT + N_GU + N_DN; it += F.NGW) {
        int r = it;
        if (r < N_IN) { const int l = r / I_IN; transpose_item<0>(I.w_in + (size_t)l * D * IN_COLS, D, IN_COLS, (bf16*)(ws + WS_WIN) + (size_t)l * NPAD * D, scr, r % I_IN, F.lane); continue; } r -= N_IN;
        if (r < N_OUT) { const int l = r / I_OUT; transpose_item<0>(I.w_out + (size_t)l * D * D, D, D, (bf16*)(ws + WS_WOUT) + (size_t)l * D * D, scr, r % I_OUT, F.lane); continue; } r -= N_OUT;
        if (r < N_GU) { const int le = r / I_GU; transpose_item<1>(I.exp_w_gu + (size_t)le * D * 1024, D, 1024, (bf16*)(ws + WS_WGU) + (size_t)le * 1024 * D, scr, r % I_GU, F.lane); continue; } r -= N_GU;
        { const int le = r / I_DN; transpose_item<0>(I.exp_w_down + (size_t)le * EH * D, EH, D, (bf16*)(ws + WS_WDN) + (size_t)le * D * EH, scr, r % I_DN, F.lane); }
    }
    for (int i = F.gw * 64 + F.lane; i < DEPTH * (NPAD - IN_COLS) * D / 8; i += F.NGW * 64) {
        const int l = i / ((NPAD - IN_COLS) * D / 8), r = i % ((NPAD - IN_COLS) * D / 8);
        *(GAS v4u*)((bf16*)(ws + WS_WIN) + (size_t)l * NPAD * D + (size_t)IN_COLS * D + (size_t)r * 8) = (v4u){0u, 0u, 0u, 0u};
    }
    float* mod = (float*)(ws + WS_MOD);
    __syncthreads();
    for (int it = F.vcu; it < DEPTH * 96; it += F.G) {
        const int l = it / 96, j = (it % 96) * 64 + F.lane;
        float acc[9];
#pragma unroll
        for (int s = 0; s < 9; ++s) acc[s] = 0.f;
        const float* aw = I.ada_w + (size_t)l * D * 6144 + j;
#pragma unroll 1
        for (int kb = 0; kb < 2; ++kb) {
            const int k0 = F.wave * 128 + kb * 64;
            float sv[9];
#pragma unroll
            for (int s = 0; s < 9; ++s) { const float cv = (s < 8) ? I.c[s * D + k0 + F.lane] : I.c_ctx[k0 + F.lane]; sv[s] = siluf_(cv); }
            float wv[64];
#pragma unroll
            for (int kk = 0; kk < 64; ++kk) wv[kk] = aw[(size_t)(k0 + kk) * 6144];
#pragma unroll
            for (int kk = 0; kk < 64; ++kk)
#pragma unroll
                for (int s = 0; s < 9; ++s) acc[s] += rl_f(sv[s], kk) * wv[kk];
        }
        LAS float* red = (LAS float*)F.lds;
#pragma unroll
        for (int s = 0; s < 9; ++s) red[(F.wave * 9 + s) * 64 + F.lane] = acc[s];
        __syncthreads();
        for (int i = F.tid; i < 9 * 64; i += 512) { float t = 0.f;
#pragma unroll
            for (int w = 0; w < 8; ++w) t += red[w * 576 + i];
            const int s = i >> 6, jj = (it % 96) * 64 + (i & 63);
            mod[(size_t)(l * 9 + s) * 6144 + jj] = t + I.ada_b[l * 6144 + jj]; }
        __syncthreads();
    }
    { bf16* lora = (bf16*)(ws + WS_LORA);
      for (int i = F.gw * 64 + F.lane; i < 4 * 2 * 256 * 32; i += F.NGW * 64) { const int r = i & 31, c = (i >> 5) & 255, ld = i >> 13;
          lora[i] = (bf16)f2bf(I.rw_w2[((size_t)ld * 32 + r) * 256 + c]); lora[LORA_A2T + i] = (bf16)f2bf(I.rw_a2[((size_t)ld * 32 + r) * 256 + c]); }
      for (int i = F.gw * 64 + F.lane; i < 4 * 256 * 64; i += F.NGW * 64) { const int r = i & 63, c = (i >> 6) & 255, l = i >> 14;
          lora[LORA_G2T + i] = (bf16)f2bf(I.rw_g2[((size_t)l * 64 + r) * 256 + c]); } }
    if (F.gw == 0) {
        for (int l = 0; l < DEPTH; ++l) {
            const float* dl = I.da_lambda + l * 256;
            const float s1 = wave_sum(dl[F.lane] * dl[64 + F.lane]), s2 = wave_sum(dl[128 + F.lane] * dl[192 + F.lane]);
            const float lam_init = 0.8f - 0.6f * expf(-0.3f * (float)l);
            if (F.lane == 0) mod[MOD_LAM + l] = expf(s1) - expf(s2) + lam_init;
        }
    }
    if (F.gw == 1) {
        for (int i = F.lane; i < 1024; i += 64) { const int pos = i >> 4, fi = i & 15;
            const float inv = powf(10000.0f, -(float)fi / 16.0f); const float ang = (float)pos * inv;
            mod[MOD_ROPE + 2 * i] = cosf(ang); mod[MOD_ROPE + 2 * i + 1] = sinf(ang); }
    }
}

__device__ __forceinline__ void conv_unit(Frame& F, const Inputs& I, int lsrc, int j) {
    LAS float* scr = (LAS float*)(F.lds + F.wave * 16384);
    if (j < 256) {
#pragma unroll 1
        for (int i = 0; i < 8; ++i) { const int r = j * 64 + i * 8 + F.wave; const int le = lsrc * NEXP + (r >> 9);
            transpose_item<1>(I.exp_w_gu + (size_t)le * D * 1024, D, 1024, (bf16*)(F.ws + WS_WGU) + (size_t)le * 1024 * D, scr, r & 511, F.lane); }
    } else {
#pragma unroll 1
        for (int i = 0; i < 8; ++i) { const int r = (j - 256) * 64 + i * 8 + F.wave; const int le = lsrc * NEXP + (r >> 8);
            transpose_item<0>(I.exp_w_down + (size_t)le * EH * D, EH, D, (bf16*)(F.ws + WS_WDN) + (size_t)le * D * EH, scr, r & 255, F.lane); }
    }
}

struct NormRow { f32x4 v[4]; v2u xb[4]; v2u ya[4], yb[4]; float w0, w1; int row, s; bool ok; };
template <int MODE>
__device__ __forceinline__ void norm_row_load(Frame& F, const Inputs& I, int rr, int nrows, NormRow& R) {
    R.ok = rr < nrows; const int row = R.ok ? rr % NT : NCX; R.row = row; R.s = row_seq(row);
    if (MODE == 2 && row < NCX) R.ok = false;
    const bf16* xs = (const bf16*)(F.ws + WS_XS);
    if (MODE == 0) { const GAS f32x4* xin = (row < NCX) ? (const GAS f32x4*)(I.ctx + (size_t)row * D) + F.lane : (const GAS f32x4*)(I.x + (size_t)(row - NCX) * D) + F.lane;
#pragma unroll
        for (int j = 0; j < 4; ++j) R.v[j] = xin[64 * j]; }
    else { const GAS v2u* xin = (const GAS v2u*)(xs + (size_t)row * D) + F.lane;
#pragma unroll
        for (int j = 0; j < 4; ++j) R.xb[j] = xin[64 * j]; }
    if (MODE != 0) {
        const int* route = (const int*)(F.ws + WS_ROUTE); const bf16* ys = (const bf16*)(F.ws + WS_YS);
        const int d0 = route[row * 8 + 6], d1 = route[row * 8 + 7];
        R.w0 = __builtin_bit_cast(float, route[row * 8 + 4]); R.w1 = __builtin_bit_cast(float, route[row * 8 + 5]);
        const GAS v2u* y0 = (const GAS v2u*)(ys + (size_t)d0 * D) + F.lane; const GAS v2u* y1 = (const GAS v2u*)(ys + (size_t)d1 * D) + F.lane;
#pragma unroll
        for (int j = 0; j < 4; ++j) { R.ya[j] = y0[64 * j]; R.yb[j] = y1[64 * j]; }
    }
}
template <int MODE>
__device__ __forceinline__ void norm_row_finish(Frame& F, const Inputs& I, int l, float* out, NormRow& R) {
    if (!R.ok) return;
    bf16* xs = (bf16*)(F.ws + WS_XS); const float* mod = (const float*)(F.ws + WS_MOD); bf16* h1 = (bf16*)(F.ws + WS_H1);
    const int row = R.row, s = R.s;
    if (MODE != 0) {
        GAS v2u* xr = (GAS v2u*)(xs + (size_t)row * D) + F.lane;
        const GAS f32x4* g2 = (const GAS f32x4*)(mod + (size_t)((l - 1) * 9 + s) * 6144 + 5120) + F.lane;
#pragma unroll
        for (int j = 0; j < 4; ++j) { const v2u ua = R.ya[j], ub = R.yb[j]; const f32x4 g = g2[64 * j];
            const f32x4 a = {bflo(ua.x), bfhi(ua.x), bflo(ua.y), bfhi(ua.y)}, b = {bflo(ub.x), bfhi(ub.x), bflo(ub.y), bfhi(ub.y)};
            const v2u ux = R.xb[j]; const f32x4 x0 = {bflo(ux.x), bfhi(ux.x), bflo(ux.y), bfhi(ux.y)};
            R.v[j] = x0 + g * (a * R.w0 + b * R.w1);
            if (MODE == 1) { v2u w; w.x = pk2(R.v[j].x, R.v[j].y); w.y = pk2(R.v[j].z, R.v[j].w); xr[64 * j] = w;
                R.v[j] = (f32x4){bflo(w.x), bfhi(w.x), bflo(w.y), bfhi(w.y)}; } }
    }
    float ss = 0.f;
#pragma unroll
    for (int j = 0; j < 4; ++j) ss += (R.v[j].x * R.v[j].x + R.v[j].y * R.v[j].y) + (R.v[j].z * R.v[j].z + R.v[j].w * R.v[j].w);
    const float rstd = __builtin_amdgcn_rsqf(wave_sum(ss) * (1.f / D) + NORM_EPS);
    if (MODE == 2) {
        GAS f32x4* o = (GAS f32x4*)(out + (size_t)(row - NCX) * D) + F.lane;
        const GAS f32x4* fg = (const GAS f32x4*)I.final_g + F.lane;
#pragma unroll
        for (int j = 0; j < 4; ++j) o[64 * j] = R.v[j] * rstd * fg[64 * j];
    } else {
        const GAS f32x4* ng = (const GAS f32x4*)(I.norm1_g + l * D) + F.lane;
        const GAS f32x4* sh = (const GAS f32x4*)(mod + (size_t)(l * 9 + s) * 6144) + F.lane;
        const GAS f32x4* sc = (const GAS f32x4*)(mod + (size_t)(l * 9 + s) * 6144 + 1024) + F.lane;
        GAS v2u* o = (GAS v2u*)(h1 + (size_t)row * D) + F.lane;
#pragma unroll
        for (int j = 0; j < 4; ++j) { const f32x4 y = (R.v[j] * rstd * ng[64 * j]) * (sc[64 * j] + 1.0f) + sh[64 * j];
            v2u w; w.x = pk2(y.x, y.y); w.y = pk2(y.z, y.w); o[64 * j] = w; }
    }
}
struct NParams { f32x4 g2[4], ng[4], sh[4], sc[4]; };
struct NRec { int d0, d1; float w0, w1; };
struct NRow { f32x4 v[4]; v2u xb[4], ya[4], yb[4]; float w0, w1; };
template <int MODE>
__device__ __forceinline__ void np_load(Frame& F, const Inputs& I, int l, int s, NParams& P) {
    const float* mod = (const float*)(F.ws + WS_MOD);
    if (MODE != 0) { const GAS f32x4* g2 = (const GAS f32x4*)(mod + (size_t)((l - 1) * 9 + s) * 6144 + 5120) + F.lane;
#pragma unroll
        for (int j = 0; j < 4; ++j) P.g2[j] = g2[64 * j]; }
    if (MODE == 2) { const GAS f32x4* fg = (const GAS f32x4*)I.final_g + F.lane;
#pragma unroll
        for (int j = 0; j < 4; ++j) P.ng[j] = fg[64 * j]; }
    else { const GAS f32x4* ng = (const GAS f32x4*)(I.norm1_g + l * D) + F.lane;
        const GAS f32x4* sh = (const GAS f32x4*)(mod + (size_t)(l * 9 + s) * 6144) + F.lane; const GAS f32x4* sc = (const GAS f32x4*)(mod + (size_t)(l * 9 + s) * 6144 + 1024) + F.lane;
#pragma unroll
        for (int j = 0; j < 4; ++j) { P.ng[j] = ng[64 * j]; P.sh[j] = sh[64 * j]; P.sc[j] = sc[64 * j]; } }
}
__device__ __forceinline__ void nrec_load(Frame& F, int row, NRec& R) {
    const GAS int* rp = (const GAS int*)(F.ws + WS_ROUTE) + (size_t)row * 8;
    R.d0 = rp[6]; R.d1 = rp[7]; R.w0 = __builtin_bit_cast(float, rp[4]); R.w1 = __builtin_bit_cast(float, rp[5]);
}
template <int MODE>
__device__ __forceinline__ void nrow_load(Frame& F, const Inputs& I, int row, const NRec& rec, NRow& R) {
    if (MODE == 0) { const GAS f32x4* xin = (row < NCX) ? (const GAS f32x4*)(I.ctx + (size_t)row * D) + F.lane : (const GAS f32x4*)(I.x + (size_t)(row - NCX) * D) + F.lane;
#pragma unroll
        for (int j = 0; j < 4; ++j) R.v[j] = xin[64 * j]; }
    else { const bf16* xs = (const bf16*)(F.ws + WS_XS); const bf16* ys = (const bf16*)(F.ws + WS_YS);
        const GAS v2u* xin = (const GAS v2u*)(xs + (size_t)row * D) + F.lane;
        const GAS v2u* y0 = (const GAS v2u*)(ys + (size_t)rec.d0 * D) + F.lane; const GAS v2u* y1 = (const GAS v2u*)(ys + (size_t)rec.d1 * D) + F.lane;
#pragma unroll
        for (int j = 0; j < 4; ++j) { R.xb[j] = xin[64 * j]; R.ya[j] = y0[64 * j]; R.yb[j] = y1[64 * j]; }
        R.w0 = rec.w0; R.w1 = rec.w1; }
}
template <int MODE>
__device__ __forceinline__ void nrow_finish(Frame& F, float* out, int row, NRow& R, const NParams& P) {
    bf16* xs = (bf16*)(F.ws + WS_XS); bf16* h1 = (bf16*)(F.ws + WS_H1);
    if (MODE != 0) {
        GAS v2u* xr = (GAS v2u*)(xs + (size_t)row * D) + F.lane;
#pragma unroll
        for (int j = 0; j < 4; ++j) { const v2u ua = R.ya[j], ub = R.yb[j];
            const f32x4 a = {bflo(ua.x), bfhi(ua.x), bflo(ua.y), bfhi(ua.y)}, b = {bflo(ub.x), bfhi(ub.x), bflo(ub.y), bfhi(ub.y)};
            const v2u ux = R.xb[j]; const f32x4 x0 = {bflo(ux.x), bfhi(ux.x), bflo(ux.y), bfhi(ux.y)};
            R.v[j] = x0 + P.g2[j] * (a * R.w0 + b * R.w1);
            if (MODE == 1) { v2u w; w.x = pk2(R.v[j].x, R.v[j].y); w.y = pk2(R.v[j].z, R.v[j].w); xr[64 * j] = w;
                R.v[j] = (f32x4){bflo(w.x), bfhi(w.x), bflo(w.y), bfhi(w.y)}; } }
    }
    float ss = 0.f;
#pragma unroll
    for (int j = 0; j < 4; ++j) ss += (R.v[j].x * R.v[j].x + R.v[j].y * R.v[j].y) + (R.v[j].z * R.v[j].z + R.v[j].w * R.v[j].w);
    const float rstd = __builtin_amdgcn_rsqf(wave_sum(ss) * (1.f / D) + NORM_EPS);
    if (MODE == 2) { GAS f32x4* o = (GAS f32x4*)(out + (size_t)(row - NCX) * D) + F.lane;
#pragma unroll
        for (int j = 0; j < 4; ++j) o[64 * j] = R.v[j] * rstd * P.ng[j];
    } else { GAS v2u* o = (GAS v2u*)(h1 + (size_t)row * D) + F.lane;
#pragma unroll
        for (int j = 0; j < 4; ++j) { const f32x4 y = (R.v[j] * rstd * P.ng[j]) * (P.sc[j] + 1.0f) + P.sh[j];
            v2u w; w.x = pk2(y.x, y.y); w.y = pk2(y.z, y.w); o[64 * j] = w; }
    }
}
template <int MODE>
__device__ __forceinline__ void p_norm1_blk(Frame& F, const Inputs& I, int l, float* out) {
    constexpr int RPW = (MODE == 2) ? NXR / 2048 : NT / 2048;
    static_assert(NXR % 2048 == 0 && NT % 2048 == 0, "row blocks");
    const int r0 = ((MODE == 2) ? NCX : 0) + F.gw * RPW;
    int cur_s = row_seq(r0); NParams P; np_load<MODE>(F, I, l, cur_s, P);
    NRec rc0, rc1; NRow A, B;
#define NROWC(k_) (r0 + (((k_) < RPW) ? (k_) : RPW - 1))
#define NFIN(k_, R_) do { const int row_ = r0 + (k_); const int s_ = row_seq(row_); if (s_ != cur_s) { cur_s = s_; np_load<MODE>(F, I, l, cur_s, P); } nrow_finish<MODE>(F, out, row_, R_, P); } while (0)
    if (MODE != 0) { nrec_load(F, NROWC(0), rc0); nrec_load(F, NROWC(1), rc1); }
    nrow_load<MODE>(F, I, NROWC(0), rc0, A);
#pragma unroll 1
    for (int k = 0; k < RPW; k += 2) {
        if (MODE != 0) nrec_load(F, NROWC(k + 2), rc0);
        nrow_load<MODE>(F, I, NROWC(k + 1), rc1, B);
        NFIN(k, A);
        if (MODE != 0) nrec_load(F, NROWC(k + 3), rc1);
        nrow_load<MODE>(F, I, NROWC(k + 2), rc0, A);
        if (k + 1 < RPW) NFIN(k + 1, B);
    }
#undef NROWC
#undef NFIN
}
template <int MODE>
__device__ __forceinline__ void p_norm1(Frame& F, const Inputs& I, int l, float* out, int reps = 1) {
    if (F.G == 256 && reps == 1) { p_norm1_blk<MODE>(F, I, l, out); return; }
    const int nrows = reps * NT;
    NormRow A, B;
    norm_row_load<MODE>(F, I, F.gw, nrows, A);
    for (int rr = F.gw; rr < nrows; rr += 2 * F.NGW) {
        norm_row_load<MODE>(F, I, rr + F.NGW, nrows, B);
        norm_row_finish<MODE>(F, I, l, out, A);
        norm_row_load<MODE>(F, I, rr + 2 * F.NGW, nrows, A);
        norm_row_finish<MODE>(F, I, l, out, B);
    }
}

template <int NN>
struct StaticOrderT {
    int nM, nwg, G, c, pm0;
    __device__ void init(int M, int  , int G_, int c_, int pm0_ = 0) { nM = M / 256; nwg = nM * NN; G = G_; c = c_; pm0 = pm0_; }
    __device__ bool next(int i, pg8::Unit& u) const {
        const int L = i * G + c; if (L >= nwg) return false;
        const int grp = L / (8 * NN), rem = L % (8 * NN);
        u.pm = pm0 + grp * 8 + (rem & 7); u.pn = rem >> 3; u.boff = 0; return true;
    }
};

constexpr float QSCALE = 0.125f * 1.4426950408889634f;
struct EpiZ {
    static constexpr bool PERM = true;
    bf16* O; int ldc; unsigned char* ws;
    __device__ __forceinline__ void operator()(const pg8::f32x4 (&acc)[2][2][4][2], const pg8::Unit& u, int wr, int wc, int fr, int fq) const {
        const int row0 = u.pm * 256 + wr * 64 + fr;
        if (u.pn >= 6) {
            const int col0 = u.pn * 256 + wc * 32 + 8 * fq;
#pragma unroll
            for (int ai = 0; ai < 2; ++ai)
#pragma unroll
                for (int m = 0; m < 4; ++m) { bf16* rowp = O + (size_t)(row0 + ai * 128 + m * 16) * ldc + col0;
#pragma unroll
                    for (int bj = 0; bj < 2; ++bj) { const pg8::f32x4 v0 = acc[ai][bj][m][0], v1 = acc[ai][bj][m][1];
                        v4u w; w.x = pg8::cvt_pk_bf16(v0[0], v0[1]); w.y = pg8::cvt_pk_bf16(v0[2], v0[3]); w.z = pg8::cvt_pk_bf16(v1[0], v1[1]); w.w = pg8::cvt_pk_bf16(v1[2], v1[3]);
                        *(v4u*)(rowp + bj * 128) = w; } }
            return;
        }
        const bool isctx = u.pm < (NCX / 256);
        const int b = isctx ? (u.pm * 256) / TC : (u.pm * 256 - NCX) / T;
        const int tb = isctx ? (u.pm * 256) % TC : (u.pm * 256 - NCX) % T;
        const int kind = u.pn >> 1;
        const float* rope = (const float*)(ws + WS_MOD) + MOD_ROPE;
        const int lane = fr + 16 * fq;
#pragma unroll
        for (int ai = 0; ai < 2; ++ai)
#pragma unroll
            for (int m = 0; m < 4; ++m) {
                const int t = tb + wr * 64 + fr + ai * 128 + m * 16;
#pragma unroll
                for (int bj = 0; bj < 2; ++bj) {
                    float v[8];
#pragma unroll
                    for (int n = 0; n < 2; ++n)
#pragma unroll
                        for (int e = 0; e < 4; ++e) v[4 * n + e] = acc[ai][bj][m][n][e];
                    if (kind == 2) {
                        const int h = 2 * (u.pn - 4) + bj, off = 32 * wc + 8 * fq;
                        v4u w; w.x = pg8::cvt_pk_bf16(v[0], v[1]); w.y = pg8::cvt_pk_bf16(v[2], v[3]); w.z = pg8::cvt_pk_bf16(v[4], v[5]); w.w = pg8::cvt_pk_bf16(v[6], v[7]);
                        *(v4u*)((bf16*)(ws + WS_VB) + ((size_t)(b * 4 + h) * TK + (isctx ? t : TC + t)) * 128 + off) = w;
                    } else {
                        const int hm = 4 * (u.pn & 1) + 2 * bj + (wc >> 1), o = 32 * (wc & 1) + 8 * fq;
                        if (!isctx) {
                            const int pos = (wc & 1) ? (t & 63) : (t >> 6);
                            const float* cs = rope + 2 * (pos * 16 + 8 * (fq & 1));
                            const bool second = fq >= 2;
#pragma unroll
                            for (int e = 0; e < 8; ++e) {
                                const auto sw = __builtin_amdgcn_permlane32_swap(__builtin_bit_cast(unsigned, v[e]), __builtin_bit_cast(unsigned, v[e]), false, false);
                                const float pv = __builtin_bit_cast(float, (lane < 32) ? sw[1] : sw[0]);
                                const float c = cs[2 * e], sn = cs[2 * e + 1];
                                v[e] = second ? (pv * sn + v[e] * c) : (v[e] * c - pv * sn);
                            }
                        }
                        if (kind == 0) {
#pragma unroll
                            for (int e = 0; e < 8; ++e) v[e] *= QSCALE; }
                        v4u w; w.x = pg8::cvt_pk_bf16(v[0], v[1]); w.y = pg8::cvt_pk_bf16(v[2], v[3]); w.z = pg8::cvt_pk_bf16(v[4], v[5]); w.w = pg8::cvt_pk_bf16(v[6], v[7]);
                        bf16* dst;
                        if (kind == 0) dst = isctx ? (bf16*)(ws + WS_QC) + ((size_t)(b * 8 + hm) * TC + t) * 64 + o : (bf16*)(ws + WS_QB) + ((size_t)(b * 8 + hm) * T + t) * 64 + o;
                        else dst = (bf16*)(ws + WS_KB) + ((size_t)(b * 8 + hm) * TK + (isctx ? t : TC + t)) * 64 + o;
                        *(v4u*)dst = w;
                    }
                }
            }
    }
};
struct EpiResid {
    static constexpr bool PERM = true; static constexpr bool NTB = false;
    bf16* X; const float* mod_g;
    const float* src_c; const float* src_x;
    __device__ __forceinline__ void operator()(const pg8::f32x4 (&acc)[2][2][4][2], const pg8::Unit& u, int wr, int wc, int fr, int fq) const {
        const int row0 = u.pm * 256 + wr * 64 + fr, col0 = u.pn * 256 + wc * 32 + 8 * fq;
        const int s = row_seq(u.pm * 256);
        pg8::f32x4 gv[2][2];
#pragma unroll
        for (int bj = 0; bj < 2; ++bj)
#pragma unroll
            for (int n = 0; n < 2; ++n) gv[bj][n] = *(const GAS pg8::f32x4*)(mod_g + (size_t)s * 6144 + col0 + bj * 128 + 4 * n);
#pragma unroll
        for (int ai = 0; ai < 2; ++ai)
#pragma unroll
            for (int m = 0; m < 4; ++m) { const int row = row0 + ai * 128 + m * 16; bf16* rowp = X + (size_t)row * D + col0;
#pragma unroll
                for (int bj = 0; bj < 2; ++bj) {
                    float r[8];
                    if (src_x) { const float* srcp = (row < NCX) ? src_c + (size_t)row * D + col0 : src_x + (size_t)(row - NCX) * D + col0;
                        const pg8::f32x4 a = *(const GAS pg8::f32x4*)(srcp + bj * 128), b = *(const GAS pg8::f32x4*)(srcp + bj * 128 + 4);
                        r[0] = a[0]; r[1] = a[1]; r[2] = a[2]; r[3] = a[3]; r[4] = b[0]; r[5] = b[1]; r[6] = b[2]; r[7] = b[3]; }
                    else { const v4u w = *(const GAS v4u*)(rowp + bj * 128); unpack8(w, r); }
#pragma unroll
                    for (int n = 0; n < 2; ++n)
#pragma unroll
                        for (int e = 0; e < 4; ++e) r[4 * n + e] += gv[bj][n][e] * acc[ai][bj][m][n][e];
                    v4u o; o.x = pg8::cvt_pk_bf16(r[0], r[1]); o.y = pg8::cvt_pk_bf16(r[2], r[3]); o.z = pg8::cvt_pk_bf16(r[4], r[5]); o.w = pg8::cvt_pk_bf16(r[6], r[7]);
                    *(GAS v4u*)(rowp + bj * 128) = o; } }
    }
};
struct EpiSwiGLU {
    static constexpr bool PERM = true;
    bf16* O;
    __device__ __forceinline__ void operator()(const pg8::f32x4 (&acc)[2][2][4][2], const pg8::Unit& u, int wr, int wc, int fr, int fq) const {
        const int row0 = u.pm * 256 + wr * 64 + fr, col0 = u.pn * 128 + wc * 32 + 8 * fq;
#pragma unroll
        for (int ai = 0; ai < 2; ++ai)
#pragma unroll
            for (int m = 0; m < 4; ++m) { bf16* rowp = O + (size_t)(row0 + ai * 128 + m * 16) * EH + col0;
                float a[8];
#pragma unroll
                for (int n = 0; n < 2; ++n)
#pragma unroll
                    for (int e = 0; e < 4; ++e) { const float g = acc[ai][0][m][n][e], up = acc[ai][1][m][n][e]; a[n * 4 + e] = siluf_(g) * up; }
                v4u w; w.x = pg8::cvt_pk_bf16(a[0], a[1]); w.y = pg8::cvt_pk_bf16(a[2], a[3]); w.z = pg8::cvt_pk_bf16(a[4], a[5]); w.w = pg8::cvt_pk_bf16(a[6], a[7]);
                *(v4u*)rowp = w; }
    }
};
struct EpiY16 {
    static constexpr bool PERM = true;
    bf16* O;
    __device__ __forceinline__ void operator()(const pg8::f32x4 (&acc)[2][2][4][2], const pg8::Unit& u, int wr, int wc, int fr, int fq) const {
        const int row0 = u.pm * 256 + wr * 64 + fr, col0 = u.pn * 256 + wc * 32 + 8 * fq;
#pragma unroll
        for (int ai = 0; ai < 2; ++ai)
#pragma unroll
            for (int m = 0; m < 4; ++m) { bf16* rowp = O + (size_t)(row0 + ai * 128 + m * 16) * D + col0;
#pragma unroll
                for (int bj = 0; bj < 2; ++bj) { const pg8::f32x4 v0 = acc[ai][bj][m][0], v1 = acc[ai][bj][m][1];
                    v4u w; w.x = pg8::cvt_pk_bf16(v0[0], v0[1]); w.y = pg8::cvt_pk_bf16(v0[2], v0[3]); w.z = pg8::cvt_pk_bf16(v1[0], v1[1]); w.w = pg8::cvt_pk_bf16(v1[2], v1[3]);
                    *(v4u*)(rowp + bj * 128) = w; } }
    }
};
struct EpiF32 {
    static constexpr bool PERM = false;
    float* C;
    __device__ __forceinline__ void operator()(const pg8::f32x4 (&acc)[2][2][4][2], const pg8::Unit& u, int wr, int wc, int fr, int fq) const {
        const int row0 = u.pm * 256 + wr * 64 + fr, col0 = u.pn * 256 + wc * 32 + 4 * fq;
#pragma unroll
        for (int ai = 0; ai < 2; ++ai)
#pragma unroll
            for (int m = 0; m < 4; ++m) { float* rowp = C + (size_t)(row0 + ai * 128 + m * 16) * D + col0;
#pragma unroll
                for (int bj = 0; bj < 2; ++bj)
#pragma unroll
                    for (int n = 0; n < 2; ++n) *(pg8::f32x4*)(rowp + bj * 128 + n * 16) = acc[ai][bj][m][n]; }
    }
};
struct MoeOrder {
    const volatile LAS int* blkend;
    int G, c; size_t wstride;
    __device__ bool next(int i, pg8::Unit& u) const {
        const int nblk = blkend[31];
        const long L = (long)i * G + c; if (L >= (long)nblk * 4) return false;
        const int rb = (int)(L >> 2); u.pm = rb; u.pn = (int)(L & 3);
        int e = 0;
#pragma unroll 1
        for (int k = 0; k < 31; ++k) e += (rb >= blkend[k]) ? 1 : 0;
        u.boff = (size_t)e * wstride; return true;
    }
};

__device__ __forceinline__ void p3_rope(Frame& F, int l) {
    const bf16* Z = (const bf16*)(F.ws + WS_Z);
    const float* rope = (const float*)(F.ws + WS_MOD) + MOD_ROPE;
    bf16* QB = (bf16*)(F.ws + WS_QB); bf16* QC = (bf16*)(F.ws + WS_QC); bf16* KB = (bf16*)(F.ws + WS_KB); bf16* VB = (bf16*)(F.ws + WS_VB);
    const int L = F.lane;
    const int hm = L >> 3, o = (L & 7) * 8;
    const int blk = o >> 5, p = o & 31;
    const int fi0 = p & 15; const bool second = p >= 16;
    for (int row = F.gw; row < NT; row += F.NGW) {
        const bf16* zr = Z + (size_t)row * NPAD;
        const v4u qw = *(const GAS v4u*)(zr + ZQ + 8 * L), kw = *(const GAS v4u*)(zr + ZK + 8 * L), vw = *(const GAS v4u*)(zr + ZV + 8 * L);
        if (row < NCX) {
            const int b = row >> 8, t = row & 255;
            { float qf[8]; unpack8(qw, qf); v4u qs; qs.x = pk2(qf[0] * QSCALE, qf[1] * QSCALE); qs.y = pk2(qf[2] * QSCALE, qf[3] * QSCALE); qs.z = pk2(qf[4] * QSCALE, qf[5] * QSCALE); qs.w = pk2(qf[6] * QSCALE, qf[7] * QSCALE);
              *(GAS v4u*)(QC + ((size_t)(b * 8 + hm) * TC + t) * 64 + o) = qs; }
            *(GAS v4u*)(KB + ((size_t)(b * 8 + hm) * TK + t) * 64 + o) = kw;
            *(GAS v4u*)(VB + ((size_t)(b * 4 + (L >> 4)) * TK + t) * 128 + (L & 15) * 8) = vw;
        } else {
            const int r2 = row - NCX, b = r2 >> 12, t = r2 & 4095;
            const int pos = blk ? (t & 63) : (t >> 6);
            float q[8], k[8], qp[8], kp[8];
            unpack8(qw, q); unpack8(kw, k);
#pragma unroll
            for (int e = 0; e < 8; ++e) { qp[e] = __builtin_bit_cast(float, __builtin_amdgcn_update_dpp(0, __builtin_bit_cast(int, q[e]), 0x4E, 0xF, 0xF, false)); kp[e] = __builtin_bit_cast(float, __builtin_amdgcn_update_dpp(0, __builtin_bit_cast(int, k[e]), 0x4E, 0xF, 0xF, false)); }
            float qo[8], ko[8];
#pragma unroll
            for (int e = 0; e < 8; ++e) { const float cs = rope[2 * (pos * 16 + fi0 + e)], sn = rope[2 * (pos * 16 + fi0 + e) + 1];
                qo[e] = second ? (qp[e] * sn + q[e] * cs) : (q[e] * cs - qp[e] * sn);
                ko[e] = second ? (kp[e] * sn + k[e] * cs) : (k[e] * cs - kp[e] * sn); }
#pragma unroll
            for (int e = 0; e < 8; ++e) qo[e] *= QSCALE;
            v4u qq, kk2; qq.x = pk2(qo[0], qo[1]); qq.y = pk2(qo[2], qo[3]); qq.z = pk2(qo[4], qo[5]); qq.w = pk2(qo[6], qo[7]);
            kk2.x = pk2(ko[0], ko[1]); kk2.y = pk2(ko[2], ko[3]); kk2.z = pk2(ko[4], ko[5]); kk2.w = pk2(ko[6], ko[7]);
            *(GAS v4u*)(QB + ((size_t)(b * 8 + hm) * T + t) * 64 + o) = qq;
            *(GAS v4u*)(KB + ((size_t)(b * 8 + hm) * TK + TC + t) * 64 + o) = kk2;
            *(GAS v4u*)(VB + ((size_t)(b * 4 + (L >> 4)) * TK + TC + t) * 128 + (L & 15) * 8) = vw;
        }
    }
}

__device__ __forceinline__ float zshift(const bf16* z0, const bf16* zm, const bf16* zp, bool hm_, bool hp_, int col, float mu) {
    const float a = bf2f(z0[col]); const float m = hm_ ? bf2f(zm[col]) : 0.f; const float p = hp_ ? bf2f(zp[col]) : 0.f;
    return a + mu * (0.5f * (m + p) - a);
}
__device__ __forceinline__ void ml_chunk_rows(int dir, int b, int cc, int& row0, int& t0, int& len) {
    if (cc < 2) { const int j = dir ? 1 - cc : cc; t0 = j * 128; len = TC; row0 = b * TC + t0; }
    else { const int j = dir ? 31 - (cc - 2) : (cc - 2); t0 = j * 128; len = T; row0 = NCX + b * T + t0; }
}
__device__ __forceinline__ float log_sigmoid_(float x) { return fminf(x, 0.f) - __logf(1.0f + __expf(-fabsf(x))); }
__device__ __forceinline__ void ml_gates(Frame& F, const Inputs& I, int l, int dir, int h, int row0, LAS float* gb, LAS float* gi) {
    const bf16* Z = (const bf16*)(F.ws + WS_Z);
    const float* gbias = I.ml_gate_b + l * 16;
    if (F.tid < 128) {
        const int s = F.tid, tau = dir ? 127 - s : s;
        const bf16* zr = Z + (size_t)(row0 + tau) * NPAD + ZML + 1024;
        gi[s] = bf2f(zr[dir * 8 + h]) + ((const GAS float*)gbias)[dir * 8 + h];
        gb[s] = log_sigmoid_(bf2f(zr[dir * 8 + 4 + h]) + ((const GAS float*)gbias)[dir * 8 + 4 + h]);
    }
    __syncthreads();
    if (F.wave == 0) {
        const float a = gb[2 * F.lane], c = gb[2 * F.lane + 1]; const float pr = a + c; float inc = pr;
#pragma unroll
        for (int o = 1; o < 64; o <<= 1) { const float n = __shfl_up(inc, o); if (F.lane >= o) inc += n; }
        const float ex = inc - pr; gb[2 * F.lane] = ex + a; gb[2 * F.lane + 1] = ex + pr;
    }
    __syncthreads();
}
__device__ __forceinline__ void ml_conv16(const bf16* Z, const Inputs& I, int l, int row, int t, int len, int colbase, float scale, float* outv) {
    const bf16* z0 = Z + (size_t)row * NPAD + ZML + colbase;
    const float* cw = I.ml_conv_w + (size_t)l * 3 * 512 + colbase; const float* cb = I.ml_conv_b + l * 512 + colbase;
    float a0[16], am[16], ap[16];
    { const v4u w0 = *(const GAS v4u*)z0, w1 = *(const GAS v4u*)(z0 + 8); unpack8(w0, a0); unpack8(w1, a0 + 8); }
    if (t > 0) { const v4u w0 = *(const GAS v4u*)(z0 - NPAD), w1 = *(const GAS v4u*)(z0 - NPAD + 8); unpack8(w0, am); unpack8(w1, am + 8); }
    else {
#pragma unroll
        for (int e = 0; e < 16; ++e) am[e] = 0.f; }
    if (t < len - 1) { const v4u w0 = *(const GAS v4u*)(z0 + NPAD), w1 = *(const GAS v4u*)(z0 + NPAD + 8); unpack8(w0, ap); unpack8(w1, ap + 8); }
    else {
#pragma unroll
        for (int e = 0; e < 16; ++e) ap[e] = 0.f; }
    float w0_[16], w1_[16], w2_[16], bb_[16];
#pragma unroll
    for (int q = 0; q < 4; ++q) { const f32x4 x0 = *(const GAS f32x4*)(cw + 4 * q), x1 = *(const GAS f32x4*)(cw + 512 + 4 * q), x2 = *(const GAS f32x4*)(cw + 1024 + 4 * q), x3 = *(const GAS f32x4*)(cb + 4 * q);
        w0_[4 * q] = x0.x; w0_[4 * q + 1] = x0.y; w0_[4 * q + 2] = x0.z; w0_[4 * q + 3] = x0.w; w1_[4 * q] = x1.x; w1_[4 * q + 1] = x1.y; w1_[4 * q + 2] = x1.z; w1_[4 * q + 3] = x1.w;
        w2_[4 * q] = x2.x; w2_[4 * q + 1] = x2.y; w2_[4 * q + 2] = x2.z; w2_[4 * q + 3] = x2.w; bb_[4 * q] = x3.x; bb_[4 * q + 1] = x3.y; bb_[4 * q + 2] = x3.z; bb_[4 * q + 3] = x3.w; }
#pragma unroll
    for (int e = 0; e < 16; ++e) { const float y = am[e] * w0_[e] + a0[e] * w1_[e] + ap[e] * w2_[e] + bb_[e]; outv[e] = siluf_(y) * scale; }
}
constexpr int MLS = 136;
constexpr int MLD = 72;
__device__ __forceinline__ bf16x8 lds_frag(const LAS bf16* p) { return *(const LAS bf16x8*)p; }


constexpr int RW_NCH = (TC + T) / 16;
constexpr int RWC_EL = 7424;
constexpr int RWC_PSI = 4096, RWC_RP = 5120, RWC_VT = 6144, RWC_OM = 7168;
constexpr int RWP_WAVE_LDS = 15744;
__device__ __forceinline__ bf16x8 frag16(const LAS bf16* base, int lr, int kg) {
    bf16x8 z = {0, 0, 0, 0, 0, 0, 0, 0};
    return (kg < 2) ? *(const LAS bf16x8*)(base + lr * 16 + kg * 8) : z;
}
#define WAVE_LDS_SYNC() asm volatile("s_waitcnt lgkmcnt(0)" ::: "memory")
__device__ __forceinline__ void rwkv_chunk_pre(Frame& F, const Inputs& I, int l, int reps) {
    const bf16* Z = (const bf16*)(F.ws + WS_Z);
    bf16* RWC = (bf16*)(F.ws + WS_RWC); float* RG = (float*)(F.ws + WS_RG); float* RBS = (float*)(F.ws + WS_RBS); float* RV = (float*)(F.ws + WS_RV);
    LAS unsigned char* wl = F.lds + F.wave * RWP_WAVE_LDS;
    LAS bf16* KH = (LAS bf16*)(wl); LAS bf16* RH = (LAS bf16*)(wl + 2304); LAS bf16* BC = (LAS bf16*)(wl + 4608); LAS bf16* KC = (LAS bf16*)(wl + 6912);
    LAS bf16* BTj = (LAS bf16*)(wl + 9216);
    LAS float* Aab = (LAS float*)(wl + 11264);
    LAS float* Bak = (LAS float*)(wl + 12352);
    LAS float* EC = (LAS float*)(wl + 13440);
    LAS bf16* VS = (LAS bf16*)(wl + 13696);
    LAS bf16* TT = KH; LAS bf16* AakT = KH + 256; LAS bf16* Bab = KH + 512; LAS bf16* Ws = KH + 768;
    LAS bf16* KHj = BC; LAS bf16* Pj = BC;
    const int L = F.lane, lr = L & 15, kg = L >> 4;
    const float* mu = I.rw_shift_mu + l * 960;
    for (int uu_ = F.gw; uu_ < reps * 64 * RW_NCH; uu_ += F.NGW) {
        const int u = uu_ % (64 * RW_NCH);
        const int chain = u / RW_NCH, ck = u % RW_NCH, dir = chain >> 5, b = (chain >> 2) & 7, h = chain & 3;
        const int c = h * 64 + L;
        int rowbase, tbase, len;
        if (ck < 16) { len = TC; tbase = dir ? TC - 1 - ck * 16 : ck * 16; rowbase = b * TC; }
        else { len = T; tbase = dir ? T - 1 - (ck - 16) * 16 : (ck - 16) * 16; rowbase = NCX + b * T; }
        const int tlo = dir ? tbase - 15 : tbase;
        const bf16* zb = Z + (size_t)(rowbase + tlo - 1) * NPAD + ZRW;
        const bool lo_ok = tlo > 0, hi_ok = tlo + 16 < len;
        const bf16* lora = (const bf16*)(F.ws + WS_LORA);
        if (dir == 0) {
            const float mug = ((const GAS float*)mu)[896 + L];
            float zg[18];
#pragma unroll
            for (int r = 0; r < 18; ++r) zg[r] = ((r == 0 && !lo_ok) || (r == 17 && !hi_ok)) ? 0.f : bf2f(zb[(size_t)r * NPAD + 896 + L]);
#pragma unroll
            for (int i = 0; i < 16; ++i) RH[i * 72 + L] = (bf16)f2bf(sigmoidf_(zg[i + 1] + mug * (0.5f * (zg[i] + zg[i + 2]) - zg[i + 1])));
            WAVE_LDS_SYNC();
            const bf16x8 ga0 = lds_frag(RH + lr * 72 + kg * 8), ga1 = lds_frag(RH + lr * 72 + 32 + kg * 8);
            WAVE_LDS_SYNC();
#pragma unroll
            for (int nt = 0; nt < 4; ++nt) { const bf16* gp = lora + LORA_G2T + ((size_t)(l * 256 + h * 64 + 16 * nt + lr)) * 64 + kg * 8;
                f32x4 acc = {0.f, 0.f, 0.f, 0.f};
                acc = __builtin_amdgcn_mfma_f32_16x16x32_bf16(ga0, *(const GAS bf16x8*)gp, acc, 0, 0, 0);
                acc = __builtin_amdgcn_mfma_f32_16x16x32_bf16(ga1, *(const GAS bf16x8*)(gp + 32), acc, 0, 0, 0);
#pragma unroll
                for (int r = 0; r < 4; ++r) RG[(size_t)(rowbase + tlo + 4 * kg + r) * 256 + h * 64 + 16 * nt + lr] = acc[r]; }
        }
        {
            const float w0c = ((const GAS float*)I.rw_w0)[(l * 2 + dir) * 256 + c], a0c = ((const GAS float*)I.rw_a0)[(l * 2 + dir) * 256 + c];
            const float kkc = ((const GAS float*)I.rw_k_k)[l * 256 + c], kac = ((const GAS float*)I.rw_k_a)[l * 256 + c], rkc = ((const GAS float*)I.rw_r_k)[l * 256 + c];
            const float mur = ((const GAS float*)mu)[c], muk = ((const GAS float*)mu)[256 + c], muv = ((const GAS float*)mu)[512 + c];
            const int lcol = (L < 32) ? (768 + dir * 32 + L) : (832 + dir * 32 + (L - 32));
            const float mul = ((const GAS float*)mu)[lcol];
            { float zr[18], zk[18], zv[18], zl[18];
#pragma unroll
              for (int r = 0; r < 18; ++r) { const bool ok = !((r == 0 && !lo_ok) || (r == 17 && !hi_ok)); const bf16* zp_ = zb + (size_t)r * NPAD;
                  zr[r] = ok ? bf2f(zp_[c]) : 0.f; zk[r] = ok ? bf2f(zp_[256 + c]) : 0.f; zv[r] = ok ? bf2f(zp_[512 + c]) : 0.f; zl[r] = ok ? bf2f(zp_[lcol]) : 0.f; }
#pragma unroll
              for (int i = 0; i < 16; ++i) {
                  const int s = dir ? 15 - i : i;
                  RH[s * 72 + L] = (bf16)f2bf(zr[i + 1] + mur * (0.5f * (zr[i] + zr[i + 2]) - zr[i + 1]));
                  KH[s * 72 + L] = (bf16)f2bf(zk[i + 1] + muk * (0.5f * (zk[i] + zk[i + 2]) - zk[i + 1]));
                  VS[s * 64 + L] = (bf16)f2bf(zv[i + 1] + muv * (0.5f * (zv[i] + zv[i + 2]) - zv[i + 1]));
                  const float lv = zl[i + 1] + mul * (0.5f * (zl[i] + zl[i + 2]) - zl[i + 1]);
                  BC[s * 72 + L] = (bf16)f2bf((L < 32) ? (1.0f - 2.0f * __builtin_amdgcn_rcpf(1.0f + __builtin_amdgcn_exp2f(2.8853900817779268f * lv))) : lv); } }
            WAVE_LDS_SYNC();
            { const bf16x8 fw_ = lds_frag(BC + lr * 72 + kg * 8), fa_ = lds_frag(BC + lr * 72 + 32 + kg * 8);
              WAVE_LDS_SYNC();
#pragma unroll
              for (int nt = 0; nt < 4; ++nt) { const size_t wrow = ((size_t)((l * 2 + dir) * 256 + h * 64 + 16 * nt + lr)) * 32 + kg * 8;
                  f32x4 aw_ = {0.f, 0.f, 0.f, 0.f}, aa_ = {0.f, 0.f, 0.f, 0.f};
                  aw_ = __builtin_amdgcn_mfma_f32_16x16x32_bf16(fw_, *(const GAS bf16x8*)(lora + wrow), aw_, 0, 0, 0);
                  aa_ = __builtin_amdgcn_mfma_f32_16x16x32_bf16(fa_, *(const GAS bf16x8*)(lora + LORA_A2T + wrow), aa_, 0, 0, 0);
#pragma unroll
                  for (int r = 0; r < 4; ++r) { KC[(4 * kg + r) * 72 + 16 * nt + lr] = (bf16)f2bf(aw_[r]); BC[(4 * kg + r) * 72 + 16 * nt + lr] = (bf16)f2bf(aa_[r]); } } }
            WAVE_LDS_SYNC();
            float E = 1.0f;
#pragma unroll 1
            for (int s = 0; s < 16; ++s) {
                const int i = dir ? 15 - s : s;
                const int row = rowbase + tlo + i;
                const float rr = bf2f(RH[s * 72 + L]), kq = bf2f(KH[s * 72 + L]), vv = bf2f(VS[s * 64 + L]);
                const float wp = w0c + bf2f(KC[s * 72 + L]), ap = a0c + bf2f(BC[s * 72 + L]);
                const float dec = __expf(-0.606531f * sigmoidf_(wp));
                const float a = sigmoidf_(ap);
                float kk = kq * kkc; const float nrm = __builtin_amdgcn_sqrtf(wave_sum(kk * kk)); kk = kk * __builtin_amdgcn_rcpf(fmaxf(nrm, 1e-12f));
                const float km = kq * (1.0f + (a - 1.0f) * kac);
                const float bb = kk * a;
                const float bsum = wave_sum(rr * rkc * km);
                if (L == 0) RBS[(size_t)row * 8 + dir * 4 + h] = bsum;
                if (dir == 0) RV[(size_t)row * 256 + c] = vv;
                const float Em1 = E; E *= dec; const float iE = __builtin_amdgcn_rcpf(E);
                KH[s * 72 + L] = (bf16)f2bf(kk * Em1); RH[s * 72 + L] = (bf16)f2bf(rr * E); BC[s * 72 + L] = (bf16)f2bf(bb * iE); KC[s * 72 + L] = (bf16)f2bf(km * iE);
            }
            EC[L] = E;
            WAVE_LDS_SYNC();
            { unsigned pb[8], pv[8];
#pragma unroll
              for (int q = 0; q < 8; ++q) { pb[q] = pk2(bf2f(BC[(2 * q) * 72 + L]) * E, bf2f(BC[(2 * q + 1) * 72 + L]) * E); pv[q] = (unsigned)VS[(2 * q) * 64 + L] | ((unsigned)VS[(2 * q + 1) * 64 + L] << 16); }
              *(LAS v4u*)(BTj + L * 16) = (v4u){pb[0], pb[1], pb[2], pb[3]}; *(LAS v4u*)(BTj + L * 16 + 8) = (v4u){pb[4], pb[5], pb[6], pb[7]};
              bf16* vt = RWC + (size_t)u * RWC_EL + RWC_VT + L * 16;
              *(GAS v4u*)vt = (v4u){pv[0], pv[1], pv[2], pv[3]}; *(GAS v4u*)(vt + 8) = (v4u){pv[4], pv[5], pv[6], pv[7]}; }
            WAVE_LDS_SYNC();
            f32x4 aab = {0.f, 0.f, 0.f, 0.f}, aak = aab, bab = aab, bak = aab;
            { bf16x8 fkh[2], frh[2], fbc[2], fkc[2];
#pragma unroll
              for (int ks = 0; ks < 2; ++ks) { fkh[ks] = lds_frag(KH + lr * 72 + ks * 32 + kg * 8); frh[ks] = lds_frag(RH + lr * 72 + ks * 32 + kg * 8); fbc[ks] = lds_frag(BC + lr * 72 + ks * 32 + kg * 8); fkc[ks] = lds_frag(KC + lr * 72 + ks * 32 + kg * 8); }
#pragma unroll
              for (int ks = 0; ks < 2; ++ks) { aab = __builtin_amdgcn_mfma_f32_16x16x32_bf16(fkh[ks], fbc[ks], aab, 0, 0, 0); aak = __builtin_amdgcn_mfma_f32_16x16x32_bf16(fkh[ks], fkc[ks], aak, 0, 0, 0);
                  bab = __builtin_amdgcn_mfma_f32_16x16x32_bf16(frh[ks], fbc[ks], bab, 0, 0, 0); bak = __builtin_amdgcn_mfma_f32_16x16x32_bf16(frh[ks], fkc[ks], bak, 0, 0, 0); } }
#pragma unroll
            for (int r = 0; r < 4; ++r) { const int t = 4 * kg + r; const bool st = lr < t, le = lr <= t;
                aab[r] = st ? aab[r] : 0.f; aak[r] = st ? aak[r] : 0.f; bab[r] = le ? bab[r] : 0.f; bak[r] = le ? bak[r] : 0.f;
                Aab[t * 17 + lr] = aab[r]; Bak[t * 17 + lr] = bak[r]; }
            { unsigned pk_[8];
#pragma unroll
              for (int s = 0; s < 16; ++s) KC[s * 72 + L] = (bf16)f2bf(bf2f(KC[s * 72 + L]) * E);
#pragma unroll
              for (int q = 0; q < 8; ++q) pk_[q] = (unsigned)KH[(2 * q) * 72 + L] | ((unsigned)KH[(2 * q + 1) * 72 + L] << 16);
              WAVE_LDS_SYNC();
              *(LAS v4u*)(KHj + L * 16) = (v4u){pk_[0], pk_[1], pk_[2], pk_[3]}; *(LAS v4u*)(KHj + L * 16 + 8) = (v4u){pk_[4], pk_[5], pk_[6], pk_[7]}; }
            { v2u w; w.x = pk2(aak[0], aak[1]); w.y = pk2(aak[2], aak[3]); *(LAS v2u*)(AakT + lr * 16 + 4 * kg) = w;
#pragma unroll
              for (int r = 0; r < 4; ++r) Bab[(4 * kg + r) * 16 + lr] = (bf16)f2bf(bab[r]); }
            WAVE_LDS_SYNC();
            { float Tc[16];
#pragma unroll
              for (int s = 15; s >= 0; --s) { float acc = (s == lr) ? 1.f : 0.f;
#pragma unroll
                  for (int uu = s + 1; uu < 16; ++uu) acc -= Aab[uu * 17 + s] * Tc[uu];
                  Tc[s] = acc; }
              if (kg == 0) { unsigned p[8];
#pragma unroll
                  for (int q = 0; q < 8; ++q) p[q] = pk2(Tc[2 * q], Tc[2 * q + 1]);
                  *(LAS v4u*)(TT + lr * 16) = (v4u){p[0], p[1], p[2], p[3]}; *(LAS v4u*)(TT + lr * 16 + 8) = (v4u){p[4], p[5], p[6], p[7]}; } }
            WAVE_LDS_SYNC();
            { const bf16x8 ftt = frag16(TT, lr, kg);
              bf16x8 fk[4];
#pragma unroll
              for (int mt = 0; mt < 4; ++mt) fk[mt] = frag16(KHj + mt * 256, lr, kg);
              const bf16x8 fa = frag16(AakT, lr, kg);
              WAVE_LDS_SYNC();
              f32x4 pa[4];
#pragma unroll
              for (int mt = 0; mt < 4; ++mt) { pa[mt] = (f32x4){0.f, 0.f, 0.f, 0.f}; pa[mt] = __builtin_amdgcn_mfma_f32_16x16x32_bf16(fk[mt], ftt, pa[mt], 0, 0, 0); }
              f32x4 wa = {0.f, 0.f, 0.f, 0.f}; wa = __builtin_amdgcn_mfma_f32_16x16x32_bf16(fa, ftt, wa, 0, 0, 0);
#pragma unroll
              for (int mt = 0; mt < 4; ++mt)
#pragma unroll
                  for (int r = 0; r < 4; ++r) Pj[(16 * mt + 4 * kg + r) * 16 + lr] = (bf16)f2bf(pa[mt][r]);
#pragma unroll
              for (int r = 0; r < 4; ++r) Ws[(4 * kg + r) * 16 + lr] = (bf16)f2bf(wa[r]); }
            WAVE_LDS_SYNC();
            { bf16* rec = RWC + (size_t)u * RWC_EL;
              bf16x8 fp[4], fb[4];
#pragma unroll
              for (int q = 0; q < 4; ++q) { fp[q] = frag16(Pj + q * 256, lr, kg); fb[q] = frag16(BTj + q * 256, lr, kg); }
              const bf16x8 fw = frag16(Ws, lr, kg), fbab = frag16(Bab, lr, kg);
#pragma unroll
              for (int mt = 0; mt < 4; ++mt)
#pragma unroll
                  for (int nt = 0; nt < 4; ++nt) { f32x4 acc = {0.f, 0.f, 0.f, 0.f}; acc = __builtin_amdgcn_mfma_f32_16x16x32_bf16(fp[mt], fb[nt], acc, 0, 0, 0);
                      float o[4];
#pragma unroll
                      for (int r = 0; r < 4; ++r) o[r] = ((mt == nt) && (4 * kg + r == lr) ? EC[16 * nt + lr] : 0.f) - acc[r];
                      v2u w; w.x = pk2(o[0], o[1]); w.y = pk2(o[2], o[3]); *(GAS v2u*)(rec + (16 * nt + lr) * 64 + 16 * mt + 4 * kg) = w; }
#pragma unroll
              for (int nt = 0; nt < 4; ++nt) { f32x4 acc = {0.f, 0.f, 0.f, 0.f}; acc = __builtin_amdgcn_mfma_f32_16x16x32_bf16(fw, fb[nt], acc, 0, 0, 0);
                  float o[4];
#pragma unroll
                  for (int r = 0; r < 4; ++r) o[r] = bf2f(KC[(4 * kg + r) * 72 + 16 * nt + lr]) - acc[r];
                  v2u w; w.x = pk2(o[0], o[1]); w.y = pk2(o[2], o[3]); *(GAS v2u*)(rec + RWC_PSI + (16 * nt + lr) * 16 + 4 * kg) = w; }
#pragma unroll
              for (int mt = 0; mt < 4; ++mt) { f32x4 acc = {0.f, 0.f, 0.f, 0.f}; acc = __builtin_amdgcn_mfma_f32_16x16x32_bf16(fp[mt], fbab, acc, 0, 0, 0);
                  float o[4];
#pragma unroll
                  for (int r = 0; r < 4; ++r) o[r] = bf2f(RH[lr * 72 + 16 * mt + 4 * kg + r]) - acc[r];
                  v2u w; w.x = pk2(o[0], o[1]); w.y = pk2(o[2], o[3]); *(GAS v2u*)(rec + RWC_RP + lr * 64 + 16 * mt + 4 * kg) = w; }
              { f32x4 acc = {0.f, 0.f, 0.f, 0.f}; acc = __builtin_amdgcn_mfma_f32_16x16x32_bf16(fw, fbab, acc, 0, 0, 0);
                  float o[4];
#pragma unroll
                  for (int r = 0; r < 4; ++r) o[r] = Bak[lr * 17 + 4 * kg + r] - acc[r];
                  v2u w; w.x = pk2(o[0], o[1]); w.y = pk2(o[2], o[3]); *(GAS v2u*)(rec + RWC_OM + lr * 16 + 4 * kg) = w; } }
            WAVE_LDS_SYNC();
        }
    }
}

__device__ __forceinline__ void p3_mlstate(Frame& F, const Inputs& I, int l) {
    const bf16* Z = (const bf16*)(F.ws + WS_Z);
    float* DC = (float*)(F.ws + WS_DC); float* DN = (float*)(F.ws + WS_DN); float* BT = DN + 64 * 34 * 64;
    LAS bf16* KT = (LAS bf16*)(F.lds);
    LAS bf16* VT = (LAS bf16*)(F.lds + 64 * MLS * 2);
    LAS float* gb = (LAS float*)(F.lds + 2 * 64 * MLS * 2);
    LAS float* gi = gb + 128;
    LAS float* sc = gi + 128;
    for (int u = F.vcu; u < 64 * 34; u += F.G) {
        const int chain = u / 34, cc = u % 34, dir = chain >> 5, b = (chain >> 2) & 7, h = chain & 3;
        int row0, t0, len; ml_chunk_rows(dir, b, cc, row0, t0, len);
        __syncthreads();
        ml_gates(F, I, l, dir, h, row0, gb, gi);
        if (F.tid < 128) sc[F.tid] = __expf(gb[127] - gb[F.tid] + gi[F.tid]);
        __syncthreads();
        { const int s = F.tid & 127, dg = F.tid >> 7, tau = dir ? 127 - s : s; const int row = row0 + tau, t = t0 + tau;
          float kv[16]; ml_conv16(Z, I, l, row, t, len, 256 + h * 64 + dg * 16, 0.125f, kv);
          const bf16* zv = Z + (size_t)row * NPAD + ZML + 512 + h * 64 + dg * 16;
          float vv[16]; { const v4u w0 = *(const GAS v4u*)zv, w1 = *(const GAS v4u*)(zv + 8); unpack8(w0, vv); unpack8(w1, vv + 8); }
          const float scs = sc[s];
#pragma unroll
          for (int e = 0; e < 16; ++e) { KT[(dg * 16 + e) * MLS + s] = (bf16)f2bf(kv[e]); VT[(dg * 16 + e) * MLS + s] = (bf16)f2bf(vv[e] * scs); } }
        __syncthreads();
        { const int te = F.wave >> 1, td0 = (F.wave & 1) * 2; const int lr = F.lane & 15, kg = F.lane >> 4;
          f32x4 acc[2] = {(f32x4){0.f, 0.f, 0.f, 0.f}, (f32x4){0.f, 0.f, 0.f, 0.f}};
#pragma unroll
          for (int ks = 0; ks < 4; ++ks) { const bf16x8 a = lds_frag(VT + (te * 16 + lr) * MLS + ks * 32 + kg * 8);
#pragma unroll
              for (int j = 0; j < 2; ++j) { const bf16x8 bb = lds_frag(KT + ((td0 + j) * 16 + lr) * MLS + ks * 32 + kg * 8);
                  acc[j] = __builtin_amdgcn_mfma_f32_16x16x32_bf16(a, bb, acc[j], 0, 0, 0); } }
          float* dc = DC + ((size_t)chain * 34 + cc) * 4096;
#pragma unroll
          for (int j = 0; j < 2; ++j)
#pragma unroll
              for (int r = 0; r < 4; ++r) dc[(te * 16 + 4 * kg + r) * 64 + (td0 + j) * 16 + lr] = acc[j][r]; }
        if (F.tid < 64) { float a = 0.f; for (int s = 0; s < 128; ++s) a += bf2f(KT[F.tid * MLS + s]) * sc[s]; DN[((size_t)chain * 34 + cc) * 64 + F.tid] = a; }
        if (F.tid == 0) BT[chain * 34 + cc] = gb[127];
    }
    __syncthreads();
}


__device__ __forceinline__ void cv_load(const float* W, int idx, int lane, float (&tv)[32]) {
    const GAS float* w_ = (const GAS float*)W + (size_t)(64 * (idx >> 5) + (lane >> 5)) * 1024 + 32 * (idx & 31) + (lane & 31);
#pragma unroll
    for (int i = 0; i < 32; ++i) tv[i] = w_[(size_t)(2 * i) * 1024];
}
__device__ __forceinline__ void cv_fin(bf16* WT, int K, bool rmap, LAS float* scr, int idx, int lane, const float (&tv)[32]) {
    const int k0 = 64 * (idx >> 5), n0 = 32 * (idx & 31);
#pragma unroll
    for (int i = 0; i < 32; ++i) scr[(2 * i + (lane >> 5)) * 33 + (lane & 31)] = tv[i];
    asm volatile("s_waitcnt lgkmcnt(0)" ::: "memory");
    const int c = lane & 7;
#pragma unroll
    for (int j = 0; j < 4; ++j) { const int n = (lane >> 3) + 8 * j; const LAS float* s_ = scr + (8 * c) * 33 + n;
        v4u o; o.x = pk2(s_[0 * 33], s_[1 * 33]); o.y = pk2(s_[2 * 33], s_[3 * 33]); o.z = pk2(s_[4 * 33], s_[5 * 33]); o.w = pk2(s_[6 * 33], s_[7 * 33]);
        int nn = n0 + n;
        if (rmap) nn = (nn < 512) ? ((nn >> 7) * 256 + (nn & 127)) : ((((nn - 512) >> 7) * 256) + 128 + ((nn - 512) & 127));
        *(GAS v4u*)(WT + (size_t)nn * K + k0 + 8 * c) = o; }
    asm volatile("s_waitcnt lgkmcnt(0)" ::: "memory");
}
constexpr int CONV_PER_CHAIN = 24576 / 64, CONV_PER_WAVE = CONV_PER_CHAIN / 8;
#define LDS_BARRIER() asm volatile("s_waitcnt lgkmcnt(0)\n\ts_barrier" ::: "memory")
template <bool CONV>
__device__ __forceinline__ void rwkv_seq(Frame& F, int chain, const float* cgu, const float* cdn, int convL) {
    const int dir = chain >> 5, b = (chain >> 2) & 7, h = chain & 3;
    const bf16* RWC = (const bf16*)(F.ws + WS_RWC) + (size_t)chain * RW_NCH * RWC_EL;
    float* RYS = (float*)(F.ws + WS_RYS);
    constexpr int CBUF = 16128;
    LAS unsigned char* cb0 = F.lds; LAS bf16* Sb = (LAS bf16*)(F.lds + 2 * CBUF);
    const int w = F.wave, mt = w >> 1, nt0 = (w & 1) * 2, lr = F.lane & 15, kg = F.lane >> 4;
    auto lds_off = [](int q) -> int { const int e = q * 8;
        if (e < 4096) return ((e >> 6) * 72 + (e & 63)) * 2;
        if (e < 5120) return 9216 + (e - 4096) * 2;
        if (e < 6144) { const int e2 = e - 5120; return 11264 + ((e2 >> 6) * 72 + (e2 & 63)) * 2; }
        if (e < 7168) return 13568 + (e - 6144) * 2;
        return 15616 + (e - 7168) * 2; };
    const int q0 = F.tid, q1 = F.tid + 512; const bool has1 = q1 < RWC_EL / 8;
    const int o0 = lds_off(q0), o1 = lds_off(has1 ? q1 : q0), q1c = has1 ? q1 : q0;
    v4u r0[8], r1[8];
    f32x4 S[2] = {(f32x4){0.f, 0.f, 0.f, 0.f}, (f32x4){0.f, 0.f, 0.f, 0.f}};
    __syncthreads();
    { const v4u a0 = *(const GAS v4u*)(RWC + q0 * 8); const v4u a1 = *(const GAS v4u*)(RWC + q1c * 8);
      *(LAS v4u*)(cb0 + o0) = a0; if (has1) *(LAS v4u*)(cb0 + o1) = a1; }
#pragma unroll
    for (int r = 1; r <= 8; ++r) { const bf16* nx = RWC + (size_t)r * RWC_EL; r0[r & 7] = *(const GAS v4u*)(nx + q0 * 8); r1[r & 7] = *(const GAS v4u*)(nx + q1c * 8); }
    LAS float* cscr = (LAS float*)(F.lds + 49152 + F.wave * 8448);
    float ta[32], tb[32]; int cvn = 0;
    bf16* aWT = nullptr; bf16* bWT = nullptr; int aK = D, bK = D, aidx = 0, bidx = 0; bool arm = true, brm = true, aon = false, bon = false;
#define CV_PICK(WT_, K_, IDX_, RM_, ON_, T_) do { ON_ = cvn < CONV_PER_WAVE; if (CONV) { const int it = chain * CONV_PER_CHAIN + ((cvn < CONV_PER_WAVE) ? cvn : CONV_PER_WAVE - 1) * 8 + F.wave; ++cvn; const float* cW;   \
        if (it < 16384) { const int le = convL * NEXP + (it >> 9); IDX_ = it & 511; cW = cgu + (size_t)le * D * 1024; WT_ = (bf16*)(F.ws + WS_WGU) + (size_t)le * 1024 * D; K_ = D; RM_ = true; }                  \
        else { const int i2 = it - 16384; const int le = convL * NEXP + (i2 >> 8); IDX_ = i2 & 255; cW = cdn + (size_t)le * EH * D; WT_ = (bf16*)(F.ws + WS_WDN) + (size_t)le * D * EH; K_ = EH; RM_ = false; } \
        cv_load(cW, IDX_, F.lane, T_); } } while (0)
#pragma unroll 1
    for (int ckb = 0; ckb < RW_NCH; ckb += 8) {
#pragma unroll
      for (int j = 0; j < 8; ++j) {
        const int ck = ckb + j;
        LAS unsigned char* cb = cb0 + (j & 1) * CBUF; LAS unsigned char* cbn = cb0 + ((j + 1) & 1) * CBUF;
#pragma unroll
        for (int jj = 0; jj < 2; ++jj)
#pragma unroll
            for (int r = 0; r < 4; ++r) Sb[(16 * mt + 4 * kg + r) * 72 + 16 * (nt0 + jj) + lr] = (bf16)f2bf(S[jj][r]);
        LDS_BARRIER();
        const LAS bf16* PhiT = (const LAS bf16*)cb; const LAS bf16* PsiT = (const LAS bf16*)(cb + 9216); const LAS bf16* RpT = (const LAS bf16*)(cb + 11264);
        const LAS bf16* VT = (const LAS bf16*)(cb + 13568); const LAS bf16* OmT = (const LAS bf16*)(cb + 15616);
        bf16x8 sA[2]; sA[0] = lds_frag(Sb + (16 * mt + lr) * 72 + kg * 8); sA[1] = lds_frag(Sb + (16 * mt + lr) * 72 + 32 + kg * 8);
        const bf16x8 vA = frag16(VT + mt * 256, lr, kg);
#pragma unroll
        for (int jj = 0; jj < 2; ++jj) { const int nt = nt0 + jj; f32x4 acc = {0.f, 0.f, 0.f, 0.f};
            acc = __builtin_amdgcn_mfma_f32_16x16x32_bf16(sA[0], lds_frag(PhiT + (16 * nt + lr) * 72 + kg * 8), acc, 0, 0, 0);
            acc = __builtin_amdgcn_mfma_f32_16x16x32_bf16(sA[1], lds_frag(PhiT + (16 * nt + lr) * 72 + 32 + kg * 8), acc, 0, 0, 0);
            acc = __builtin_amdgcn_mfma_f32_16x16x32_bf16(vA, frag16(PsiT + nt * 256, lr, kg), acc, 0, 0, 0);
            S[jj] = acc; }
        if ((w & 1) == 0) { f32x4 y = {0.f, 0.f, 0.f, 0.f};
            y = __builtin_amdgcn_mfma_f32_16x16x32_bf16(sA[0], lds_frag(RpT + lr * 72 + kg * 8), y, 0, 0, 0);
            y = __builtin_amdgcn_mfma_f32_16x16x32_bf16(sA[1], lds_frag(RpT + lr * 72 + 32 + kg * 8), y, 0, 0, 0);
            y = __builtin_amdgcn_mfma_f32_16x16x32_bf16(vA, frag16(OmT, lr, kg), y, 0, 0, 0);
            const int stp = ck * 16 + lr; int row;
            if (stp < TC) { const int t = dir ? TC - 1 - stp : stp; row = b * TC + t; } else { const int s2 = stp - TC; const int t = dir ? T - 1 - s2 : s2; row = NCX + b * T + t; }
            *(GAS f32x4*)(RYS + ((size_t)dir * NT + row) * 256 + h * 64 + 16 * mt + 4 * kg) = y; }
        if (ck + 1 < RW_NCH) { *(LAS v4u*)(cbn + o0) = r0[(j + 1) & 7]; if (has1) *(LAS v4u*)(cbn + o1) = r1[(j + 1) & 7]; }
        { const int rn = (ck + 9 < RW_NCH) ? ck + 9 : RW_NCH - 1; const bf16* nx = RWC + (size_t)rn * RWC_EL; r0[(j + 1) & 7] = *(const GAS v4u*)(nx + q0 * 8); r1[(j + 1) & 7] = *(const GAS v4u*)(nx + q1c * 8); }
        if (CONV) {
        if (j == 1) { if (bon) cv_fin(bWT, bK, brm, cscr, bidx, F.lane, tb); bon = false; }
        if (j == 5) { if (aon) cv_fin(aWT, aK, arm, cscr, aidx, F.lane, ta); aon = false; }
        if (j == 0) CV_PICK(aWT, aK, aidx, arm, aon, ta);
        if (j == 4) CV_PICK(bWT, bK, bidx, brm, bon, tb); }
        LDS_BARRIER();
      }
    }
    if (CONV) { if (bon) cv_fin(bWT, bK, brm, cscr, bidx, F.lane, tb);
        if (aon) cv_fin(aWT, aK, arm, cscr, aidx, F.lane, ta); }
#undef CV_PICK
}
__device__ __forceinline__ void ml_prefix(Frame& F, int chain) {
    const float* DC = (const float*)(F.ws + WS_DC); const float* DN = (const float*)(F.ws + WS_DN); const float* BT = DN + 64 * 34 * 64;
    float* CS = (float*)(F.ws + WS_CS); float* NS = (float*)(F.ws + WS_NS);
    f32x4 c0 = (f32x4){0.f, 0.f, 0.f, 0.f}, c1 = c0; float n = 0.f;
    for (int cc = 0; cc < 34; ++cc) {
        const size_t base = ((size_t)chain * 34 + cc) * 4096;
        *(GAS f32x4*)(CS + base + F.tid * 8) = c0; *(GAS f32x4*)(CS + base + F.tid * 8 + 4) = c1;
        if (F.tid < 64) NS[((size_t)chain * 34 + cc) * 64 + F.tid] = n;
        const float dec = __expf(BT[chain * 34 + cc]);
        const f32x4 d0 = *(const GAS f32x4*)(DC + base + F.tid * 8), d1 = *(const GAS f32x4*)(DC + base + F.tid * 8 + 4);
        c0 = c0 * dec + d0; c1 = c1 * dec + d1;
        if (F.tid < 64) n = n * dec + DN[((size_t)chain * 34 + cc) * 64 + F.tid];
    }
}

namespace att {
constexpr int QBLK = 32, KVBLK = 64;
constexpr float SCALE = 0.125f;
constexpr float THR = 8.f;
constexpr int SHM_V = KVBLK * 128 * 2, SHM_K = KVBLK * 64 * 2;
#define KSWZ(row, colB) ((row) * 128 + ((colB) ^ (((((row) & 7) ^ ((((row) >> 3) & 1) << 2))) << 4)))
#define SBAR() __builtin_amdgcn_sched_barrier(0)
__device__ __forceinline__ int crow(int r, int hi) { return (r & 3) + 8 * (r >> 2) + 4 * hi; }
__device__ __forceinline__ unsigned cvtpk(float lo, float hi) { unsigned r; asm volatile("v_cvt_pk_bf16_f32 %0, %1, %2" : "=v"(r) : "v"(lo), "v"(hi)); return r; }
__device__ __forceinline__ void partialSM(f32x16& p0, f32x16& p1) {
#pragma unroll
  for (int r = 0; r < 16; ++r) p0[r] = __builtin_amdgcn_exp2f(p0[r]);
}
__device__ __forceinline__ void finishSM(f32x16& p0, f32x16& p1, float& l_reg, bf16x8& pa0, bf16x8& pa1, bf16x8& pa2, bf16x8& pa3) {
#pragma unroll
  for (int r = 0; r < 16; ++r) p1[r] = __builtin_amdgcn_exp2f(p1[r]);
  float ps = 0;
#pragma unroll
  for (int r = 0; r < 16; ++r) ps += p0[r];
#pragma unroll
  for (int r = 0; r < 16; ++r) ps += p1[r];
  { auto rr = __builtin_amdgcn_permlane32_swap(__float_as_uint(ps), __float_as_uint(ps), false, false);
    ps = __uint_as_float(rr[0]) + __uint_as_float(rr[1]); }
  l_reg += ps;
#define PK4(P, BASE, OUT) do { v4u w = {cvtpk(P[BASE + 0], P[BASE + 1]), cvtpk(P[BASE + 2], P[BASE + 3]), cvtpk(P[BASE + 4], P[BASE + 5]), cvtpk(P[BASE + 6], P[BASE + 7])}; \
    OUT = *reinterpret_cast<bf16x8*>(&w); } while (0)
  PK4(p0, 0, pa0); PK4(p0, 8, pa1); PK4(p1, 0, pa2); PK4(p1, 8, pa3);
#undef PK4
}
__device__ __forceinline__ void qkt(f32x16& p0, f32x16& p1, const LAS char* Ks, const bf16x8* qr, int r32, int hi) {
  p0 = f32x16{}; p1 = f32x16{};
#pragma unroll
  for (int d0 = 0; d0 < 4; ++d0) { const int cb = (d0 * 16 + hi * 8) * 2;
    const bf16x8 b0 = *(const LAS bf16x8*)(Ks + KSWZ(r32, cb));
    const bf16x8 b1 = *(const LAS bf16x8*)(Ks + KSWZ(32 + r32, cb));
    p0 = __builtin_amdgcn_mfma_f32_32x32x16_bf16(b0, qr[d0], p0, 0, 0, 0);
    p1 = __builtin_amdgcn_mfma_f32_32x32x16_bf16(b1, qr[d0], p1, 0, 0, 0); }
}
__device__ __forceinline__ int v_st(int k, int c) { const int kk = (k & ~0xC) | ((k & 4) << 1) | ((k & 8) >> 1); return ((kk >> 3) * 4 + (c >> 5)) * 512 + ((kk & 7) * 32 + (c & 31)) * 2; }
__device__ __forceinline__ int v_rd_base(int lane) { return ((lane & 3) << 3) | (((lane >> 2) & 3) << 6) | (((lane >> 4) & 1) << 5) | (((lane >> 5) & 1) << 8); }
constexpr int v_rd_off(int d0, int ks, int half) { return d0 * 512 + ks * 4096 + half * 2048; }
template <int OFF> __device__ __forceinline__ s16x4 tr_read(int vb) {
  s16x4 r; asm volatile("ds_read_b64_tr_b16 %0, %1 offset:%2" : "=&v"(r) : "v"(vb), "i"(OFF) : "memory"); return r;
}
template <int D0> __device__ __forceinline__ void pv_one(f32x16& od, int vb, bf16x8 pa0, bf16x8 pa1, bf16x8 pa2, bf16x8 pa3) {
  const s16x4 l0 = tr_read<v_rd_off(D0, 0, 0)>(vb), h0 = tr_read<v_rd_off(D0, 0, 1)>(vb), l1 = tr_read<v_rd_off(D0, 1, 0)>(vb), h1 = tr_read<v_rd_off(D0, 1, 1)>(vb);
  const s16x4 l2 = tr_read<v_rd_off(D0, 2, 0)>(vb), h2 = tr_read<v_rd_off(D0, 2, 1)>(vb), l3 = tr_read<v_rd_off(D0, 3, 0)>(vb), h3 = tr_read<v_rd_off(D0, 3, 1)>(vb);
  asm volatile("s_waitcnt lgkmcnt(0)" ::: "memory"); SBAR();
#define PK(L, H) (bf16x8){L[0], L[1], L[2], L[3], H[0], H[1], H[2], H[3]}
  od = __builtin_amdgcn_mfma_f32_32x32x16_bf16(pa0, PK(l0, h0), od, 0, 0, 0);
  od = __builtin_amdgcn_mfma_f32_32x32x16_bf16(pa1, PK(l1, h1), od, 0, 0, 0);
  od = __builtin_amdgcn_mfma_f32_32x32x16_bf16(pa2, PK(l2, h2), od, 0, 0, 0);
  od = __builtin_amdgcn_mfma_f32_32x32x16_bf16(pa3, PK(l3, h3), od, 0, 0, 0);
#undef PK
}
__device__ __forceinline__ void pv_d0(f32x16* o, int vb, bf16x8 pa0, bf16x8 pa1, bf16x8 pa2, bf16x8 pa3) {
  pv_one<0>(o[0], vb, pa0, pa1, pa2, pa3); pv_one<1>(o[1], vb, pa0, pa1, pa2, pa3); pv_one<2>(o[2], vb, pa0, pa1, pa2, pa3); pv_one<3>(o[3], vb, pa0, pa1, pa2, pa3);
}
__device__ __forceinline__ void attn_unit(const bf16* __restrict__ Qb, const bf16* __restrict__ Kh, const bf16* __restrict__ Vh, float* __restrict__ Ob, int ldo, int seq, LAS char* lds) {
  int tid = threadIdx.x; asm volatile("" : "+v"(tid));
  const int wid = tid >> 6, lane = tid & 63, r32 = lane & 31, hi = lane >> 5;
  LAS char* V_lds = lds; LAS char* K_lds = lds + 2 * SHM_V;
  LAS float* ws = (LAS float*)(lds + 2 * SHM_V + 2 * SHM_K) + wid * 64; LAS float* li_l = ws; LAS float* al_l = ws + 32;
  float l_reg = 0; f32x16 o[4] = {}; bf16x8 qr[4];
  const bf16* Qw = Qb + (long)(wid * QBLK + r32) * 64 + hi * 8;
#pragma unroll
  for (int d0 = 0; d0 < 4; ++d0) qr[d0] = *(const GAS bf16x8*)(Qw + d0 * 16);
  const int sr = tid >> 4, sc = (tid & 15) * 8, vst0 = v_st(sr, sc), vst1 = v_st(32 + sr, sc);
  const int kr = tid >> 3, kc = (tid & 7) * 8; const int kst = KSWZ((kr & ~0xC) | ((kr & 4) << 1) | ((kr & 8) >> 1), kc * 2);
  const int vb0 = (int)(unsigned)(size_t)V_lds + v_rd_base(lane);
  bf16x8 vsA0, vsA1, ksA, vsB0, vsB1, ksB;
#define SLOADA(k0) do { vsA0 = *(const GAS bf16x8*)&Vh[(long)((k0) + sr) * 128 + sc]; vsA1 = *(const GAS bf16x8*)&Vh[(long)((k0) + 32 + sr) * 128 + sc]; ksA = *(const GAS bf16x8*)&Kh[(long)((k0) + kr) * 64 + kc]; } while (0)
#define SLOADB(k0) do { vsB0 = *(const GAS bf16x8*)&Vh[(long)((k0) + sr) * 128 + sc]; vsB1 = *(const GAS bf16x8*)&Vh[(long)((k0) + 32 + sr) * 128 + sc]; ksB = *(const GAS bf16x8*)&Kh[(long)((k0) + kr) * 64 + kc]; } while (0)
#define SWRITEA(b) do { *(LAS bf16x8*)(V_lds + (b) * SHM_V + vst0) = vsA0; *(LAS bf16x8*)(V_lds + (b) * SHM_V + vst1) = vsA1; *(LAS bf16x8*)(K_lds + (b) * SHM_K + kst) = ksA; } while (0)
#define SWRITEB(b) do { *(LAS bf16x8*)(V_lds + (b) * SHM_V + vst0) = vsB0; *(LAS bf16x8*)(V_lds + (b) * SHM_V + vst1) = vsB1; *(LAS bf16x8*)(K_lds + (b) * SHM_K + kst) = ksB; } while (0)
#define SWAIT() asm volatile("s_waitcnt vmcnt(3)" ::: "memory")
#define RESC(a) do { if (__any((a) < 1.f)) { if (hi == 0) al_l[r32] = (a); asm volatile("s_waitcnt lgkmcnt(0)" ::: "memory"); \
    _Pragma("unroll") for (int d = 0; d < 4; ++d) _Pragma("unroll") for (int r = 0; r < 16; ++r) o[d][r] *= al_l[crow(r, hi)]; } } while (0)
  f32x16 pA0, pA1, pB0, pB1; bf16x8 pa0, pa1, pa2, pa3; const int NTL = seq / KVBLK;
  __syncthreads();
  SLOADA(0); asm volatile("s_waitcnt vmcnt(0)" ::: "memory"); SWRITEA(0); __syncthreads();
  qkt(pA0, pA1, K_lds, qr, r32, hi); partialSM(pA0, pA1);
  SLOADB(KVBLK); if (2 < NTL) SLOADA(2 * KVBLK);
  SWAIT(); SWRITEB(1); __syncthreads();
  for (int j = 1; j + 1 < NTL; j += 2) {
    SBAR(); qkt(pB0, pB1, K_lds + SHM_K, qr, r32, hi);
    finishSM(pA0, pA1, l_reg, pa0, pa1, pa2, pa3); SBAR();
    SLOADB((j + 2) * KVBLK); SBAR();
    pv_d0(o, vb0, pa0, pa1, pa2, pa3); partialSM(pB0, pB1);
    __syncthreads(); SWAIT(); SWRITEA(0);
    __syncthreads();
    SBAR(); qkt(pA0, pA1, K_lds, qr, r32, hi);
    finishSM(pB0, pB1, l_reg, pa0, pa1, pa2, pa3); SBAR();
    if (j + 3 < NTL) SLOADA((j + 3) * KVBLK); SBAR();
    pv_d0(o, vb0 + SHM_V, pa0, pa1, pa2, pa3); partialSM(pA0, pA1);
    __syncthreads(); SWAIT(); SWRITEB(1);
    __syncthreads();
  }
  SBAR(); qkt(pB0, pB1, K_lds + SHM_K, qr, r32, hi);
  finishSM(pA0, pA1, l_reg, pa0, pa1, pa2, pa3); SBAR();
  pv_d0(o, vb0, pa0, pa1, pa2, pa3); partialSM(pB0, pB1);
  __syncthreads();
  finishSM(pB0, pB1, l_reg, pa0, pa1, pa2, pa3); SBAR();
  pv_d0(o, vb0 + SHM_V, pa0, pa1, pa2, pa3);
  if (hi == 0) li_l[r32] = l_reg; asm volatile("s_waitcnt lgkmcnt(0)" ::: "memory");
  float rli[16];
#pragma unroll
  for (int r = 0; r < 16; ++r) rli[r] = __builtin_amdgcn_rcpf(li_l[crow(r, hi)]);
  float* Ow = Ob + (long)(wid * QBLK) * ldo;
#pragma unroll
  for (int r = 0; r < 16; ++r) { const int orow = crow(r, hi);
#pragma unroll
    for (int d0 = 0; d0 < 4; ++d0) Ow[(long)orow * ldo + d0 * 32 + r32] = o[d0][r] * rli[r]; }
  asm volatile("s_waitcnt vmcnt(0)" ::: "memory");
#undef SLOADA
#undef SLOADB
#undef SWRITEA
#undef SWRITEB
#undef SWAIT
#undef RESC
}
__device__ __forceinline__ void attn_unit2(const bf16* __restrict__ Q0, const bf16* __restrict__ K0, const bf16* __restrict__ Vh, bf16* __restrict__ Ob, int seq, size_t qmap_stride, size_t kmap_stride,
                                           float lam, float post_scale, const float* __restrict__ gsub, LAS char* lds) {
  int tid = threadIdx.x; asm volatile("" : "+v"(tid));
  const int wid = tid >> 6, lane = tid & 63, r32 = lane & 31, hi = lane >> 5, map = wid >> 2, wq = wid & 3;
  LAS char* V_lds = lds; LAS char* K_lds = lds + 3 * SHM_V;
  LAS float* ws = (LAS float*)(lds + 3 * SHM_V + 6 * SHM_K) + wid * 64; LAS float* li_l = ws;
  LAS float* EX = (LAS float*)lds;
  float l_reg = 0; f32x16 o[4] = {}; bf16x8 qr[4];
  const bf16* Qw = Q0 + (size_t)map * qmap_stride + (long)(wq * QBLK + r32) * 64 + hi * 8;
#pragma unroll
  for (int d0 = 0; d0 < 4; ++d0) qr[d0] = *(const GAS bf16x8*)(Qw + d0 * 16);
  const int sr = tid >> 4, sc = (tid & 15) * 8, vst0 = v_st(sr, sc), vst1 = v_st(32 + sr, sc);
  const int kr = tid >> 3, kc = (tid & 7) * 8; const int kst = KSWZ((kr & ~0xC) | ((kr & 4) << 1) | ((kr & 8) >> 1), kc * 2);
  const bf16* K1 = K0 + kmap_stride;
  const int vb0 = (int)(unsigned)(size_t)V_lds + v_rd_base(lane);
  const LAS char* Kmine = K_lds + map * SHM_K;
  bf16x8 vsA0, vsA1, ksA0, ksA1, vsB0, vsB1, ksB0, ksB1;
#define SLOADA(k0) do { vsA0 = *(const GAS bf16x8*)&Vh[(long)((k0) + sr) * 128 + sc]; vsA1 = *(const GAS bf16x8*)&Vh[(long)((k0) + 32 + sr) * 128 + sc]; ksA0 = *(const GAS bf16x8*)&K0[(long)((k0) + kr) * 64 + kc]; ksA1 = *(const GAS bf16x8*)&K1[(long)((k0) + kr) * 64 + kc]; } while (0)
#define SLOADB(k0) do { vsB0 = *(const GAS bf16x8*)&Vh[(long)((k0) + sr) * 128 + sc]; vsB1 = *(const GAS bf16x8*)&Vh[(long)((k0) + 32 + sr) * 128 + sc]; ksB0 = *(const GAS bf16x8*)&K0[(long)((k0) + kr) * 64 + kc]; ksB1 = *(const GAS bf16x8*)&K1[(long)((k0) + kr) * 64 + kc]; } while (0)
#define SWRITEA(b) do { *(LAS bf16x8*)(V_lds + (b) * SHM_V + vst0) = vsA0; *(LAS bf16x8*)(V_lds + (b) * SHM_V + vst1) = vsA1; *(LAS bf16x8*)(K_lds + ((b) * 2) * SHM_K + kst) = ksA0; *(LAS bf16x8*)(K_lds + ((b) * 2 + 1) * SHM_K + kst) = ksA1; } while (0)
#define SWRITEB(b) do { *(LAS bf16x8*)(V_lds + (b) * SHM_V + vst0) = vsB0; *(LAS bf16x8*)(V_lds + (b) * SHM_V + vst1) = vsB1; *(LAS bf16x8*)(K_lds + ((b) * 2) * SHM_K + kst) = ksB0; *(LAS bf16x8*)(K_lds + ((b) * 2 + 1) * SHM_K + kst) = ksB1; } while (0)
#define SWAIT() asm volatile("s_waitcnt vmcnt(4)" ::: "memory")
  f32x16 pA0, pA1, pB0, pB1; bf16x8 pa0, pa1, pa2, pa3; const int NTL = seq / KVBLK;
  __syncthreads();
  SLOADA(0); asm volatile("s_waitcnt vmcnt(0)" ::: "memory"); SWRITEA(0); __syncthreads();
  qkt(pA0, pA1, Kmine, qr, r32, hi); partialSM(pA0, pA1);
  SLOADB(KVBLK); if (2 < NTL) SLOADA(2 * KVBLK);
  SWAIT(); SWRITEB(1); __syncthreads();
  int b_prev = 0, b_cur = 1, b_nxt = 2;
  for (int j = 1; j + 1 < NTL; j += 2) {
    SBAR(); qkt(pB0, pB1, Kmine + b_cur * 2 * SHM_K, qr, r32, hi);
    finishSM(pA0, pA1, l_reg, pa0, pa1, pa2, pa3); SBAR();
    SLOADB((j + 2) * KVBLK); SBAR();
    pv_d0(o, vb0 + b_prev * SHM_V, pa0, pa1, pa2, pa3); partialSM(pB0, pB1);
    SWAIT(); SWRITEA(b_nxt);
    __syncthreads();
    { const int t_ = b_prev; b_prev = b_cur; b_cur = b_nxt; b_nxt = t_; }
    SBAR(); qkt(pA0, pA1, Kmine + b_cur * 2 * SHM_K, qr, r32, hi);
    finishSM(pB0, pB1, l_reg, pa0, pa1, pa2, pa3); SBAR();
    if (j + 3 < NTL) SLOADA((j + 3) * KVBLK); SBAR();
    pv_d0(o, vb0 + b_prev * SHM_V, pa0, pa1, pa2, pa3); partialSM(pA0, pA1);
    SWAIT(); SWRITEB(b_nxt);
    __syncthreads();
    { const int t_ = b_prev; b_prev = b_cur; b_cur = b_nxt; b_nxt = t_; }
  }
  SBAR(); qkt(pB0, pB1, Kmine + b_cur * 2 * SHM_K, qr, r32, hi);
  finishSM(pA0, pA1, l_reg, pa0, pa1, pa2, pa3); SBAR();
  pv_d0(o, vb0 + b_prev * SHM_V, pa0, pa1, pa2, pa3); partialSM(pB0, pB1);
  finishSM(pB0, pB1, l_reg, pa0, pa1, pa2, pa3); SBAR();
  pv_d0(o, vb0 + b_cur * SHM_V, pa0, pa1, pa2, pa3);
  if (hi == 0) li_l[r32] = l_reg; asm volatile("s_waitcnt lgkmcnt(0)" ::: "memory");
  float rli[16];
#pragma unroll
  for (int r = 0; r < 16; ++r) rli[r] = __builtin_amdgcn_rcpf(li_l[crow(r, hi)]);
  __syncthreads();
  if (map == 1) {
#pragma unroll
    for (int d0 = 0; d0 < 4; ++d0)
#pragma unroll
      for (int r = 0; r < 16; ++r) EX[((wq * 4 + d0) * 16 + r) * 64 + lane] = o[d0][r] * (rli[r] * lam);
  }
  __syncthreads();
  if (map == 0) {
    float ss[16];
#pragma unroll
    for (int r = 0; r < 16; ++r) ss[r] = 0.f;
#pragma unroll
    for (int d0 = 0; d0 < 4; ++d0)
#pragma unroll
      for (int r = 0; r < 16; ++r) { const float v = o[d0][r] * rli[r] - EX[((wq * 4 + d0) * 16 + r) * 64 + lane]; o[d0][r] = v; ss[r] += v * v; }
    float gv[4];
#pragma unroll
    for (int d0 = 0; d0 < 4; ++d0) gv[d0] = gsub[d0 * 32 + r32] * post_scale;
#pragma unroll
    for (int r = 0; r < 16; ++r) { float t = row16_sum(ss[r]); t += __shfl_xor(t, 16); ss[r] = __builtin_amdgcn_rsqf(t * (1.f / 128.f) + 1e-6f); }
    bf16* Ow = Ob + (long)(wq * QBLK) * 1024;
#pragma unroll
    for (int r = 0; r < 16; ++r) { const int orow = crow(r, hi);
#pragma unroll
      for (int d0 = 0; d0 < 4; ++d0) Ow[(long)orow * 1024 + d0 * 32 + r32] = (bf16)f2bf(o[d0][r] * ss[r] * gv[d0]); }
  }
  asm volatile("s_waitcnt vmcnt(0)" ::: "memory");
#undef SLOADA
#undef SLOADB
#undef SWRITEA
#undef SWRITEB
#undef SWAIT
}
}

__device__ __forceinline__ void p5_att(Frame& F, const Inputs& I, int l, int row_lo) {
    const float* AO = (const float*)(F.ws + WS_ATTO); bf16* MIX = (bf16*)(F.ws + WS_MIX);
    const float lam = ((const float*)(F.ws + WS_MOD))[MOD_LAM + l];
    const float lam_init = 0.8f - 0.6f * expf(-0.3f * (float)l);
    const int L = F.lane, h = L >> 4, off = (L & 15) * 8;
    const f32x4 g0 = *(const GAS f32x4*)(I.da_subln_g + l * 128 + off), g1 = *(const GAS f32x4*)(I.da_subln_g + l * 128 + off + 4);
    for (int row = row_lo + F.gw; row < NT; row += F.NGW) {
        const float* p0 = AO + (size_t)row * 1024 + h * 256 + off; const float* p1 = p0 + 128;
        const f32x4 a0 = *(const GAS f32x4*)p0, a1 = *(const GAS f32x4*)(p0 + 4), b0 = *(const GAS f32x4*)p1, b1 = *(const GAS f32x4*)(p1 + 4);
        const f32x4 o0 = a0 - b0 * lam, o1 = a1 - b1 * lam;
        float ss = (o0.x * o0.x + o0.y * o0.y) + (o0.z * o0.z + o0.w * o0.w) + (o1.x * o1.x + o1.y * o1.y) + (o1.z * o1.z + o1.w * o1.w);
        ss = row16_sum(ss);
        const float sc = (1.0f / sqrtf(ss * (1.f / 128.f) + NORM_EPS)) * (1.0f - lam_init);
        const f32x4 y0 = o0 * g0 * sc, y1 = o1 * g1 * sc;
        v4u w; w.x = pk2(y0.x, y0.y); w.y = pk2(y0.z, y0.w); w.z = pk2(y1.x, y1.y); w.w = pk2(y1.z, y1.w);
        *(GAS v4u*)(MIX + (size_t)row * D + h * 128 + off) = w;
    }
}
__device__ __forceinline__ void p5_rwkv(Frame& F, const Inputs& I, int l, int row_begin, int row_end, int row_step) {
    const float* RYS = (const float*)(F.ws + WS_RYS); const float* RV = (const float*)(F.ws + WS_RV); const float* RG = (const float*)(F.ws + WS_RG); const float* RBS = (const float*)(F.ws + WS_RBS);
    bf16* MIX = (bf16*)(F.ws + WS_MIX);
    const int L = F.lane, c0 = 4 * L, h = L >> 4;
    const f32x4 lg = *(const GAS f32x4*)(I.rw_ln_g + l * 256 + c0), lb = *(const GAS f32x4*)(I.rw_ln_b + l * 256 + c0);
#pragma unroll 4
    for (int row = row_begin; row < row_end; row += row_step) {
        const f32x4 y = *(const GAS f32x4*)(RYS + (size_t)row * 256 + c0) + *(const GAS f32x4*)(RYS + ((size_t)NT + row) * 256 + c0);
        float s = (y.x + y.y) + (y.z + y.w);
        s = row16_sum(s);
        const float mu = s * (1.f / 64.f);
        const f32x4 d = y - mu;
        float q = (d.x * d.x + d.y * d.y) + (d.z * d.z + d.w * d.w);
        q = row16_sum(q);
        const float rstd = __builtin_amdgcn_rsqf(q * (1.f / 64.f) + 64e-5f);
        const f32x4 v = *(const GAS f32x4*)(RV + (size_t)row * 256 + c0);
        const f32x4 g = *(const GAS f32x4*)(RG + (size_t)row * 256 + c0);
        const float bs = RBS[(size_t)row * 8 + h] + RBS[(size_t)row * 8 + 4 + h];
        const f32x4 o = ((d * rstd) * lg + lb + v * bs) * g;
        v2u w; w.x = pk2(o.x, o.y); w.y = pk2(o.z, o.w);
        *(GAS v2u*)(MIX + (size_t)row * D + 512 + c0) = w;
    }
}
__device__ __forceinline__ void p5_mlout(Frame& F, const Inputs& I, int l, int u) {
    const bf16* Z = (const bf16*)(F.ws + WS_Z);
    const float* CS = (const float*)(F.ws + WS_CS); const float* NS = (const float*)(F.ws + WS_NS);
    bf16* MIX = (bf16*)(F.ws + WS_MIX);
    LAS bf16* QL = (LAS bf16*)(F.lds);
    LAS bf16* KL = (LAS bf16*)(F.lds + 18432);
    LAS bf16* VT = (LAS bf16*)(F.lds + 36864);
    LAS bf16* PL = (LAS bf16*)(F.lds + 54272);
    LAS bf16* CB = (LAS bf16*)(F.lds + 89088);
    LAS float* HL = (LAS float*)(F.lds + 100608);
    LAS float* gb = (LAS float*)(F.lds + 135424);
    LAS float* gi = gb + 128;
    const int w = F.wave;
    {
        int tid_ = threadIdx.x; asm volatile("" : "+v"(tid_));
        const int lane_ = tid_ & 63, lr = lane_ & 15, kg = lane_ >> 4;
        int b, j, h, row0, len;
        if (u < 64) { b = u >> 3; j = (u >> 2) & 1; h = u & 3; row0 = b * TC + j * 128; len = TC; }
        else { const int u2 = u - 64; b = u2 >> 7; j = (u2 >> 2) & 31; h = u2 & 3; row0 = NCX + b * T + j * 128; len = T; }
        const int t0 = j * 128;
        __syncthreads();
        { const int s = tid_ & 127, dg = tid_ >> 7; const int row = row0 + s, t = t0 + s;
          { float qv[16]; ml_conv16(Z, I, l, row, t, len, h * 64 + dg * 16, 1.0f, qv);
            v4u a, c;
            a.x = pk2(qv[0], qv[1]); a.y = pk2(qv[2], qv[3]); a.z = pk2(qv[4], qv[5]); a.w = pk2(qv[6], qv[7]);
            c.x = pk2(qv[8], qv[9]); c.y = pk2(qv[10], qv[11]); c.z = pk2(qv[12], qv[13]); c.w = pk2(qv[14], qv[15]);
            *(LAS v4u*)(QL + s * MLD + dg * 16) = a; *(LAS v4u*)(QL + s * MLD + dg * 16 + 8) = c; }
          asm volatile("" ::: "memory");
          { float kv[16]; ml_conv16(Z, I, l, row, t, len, 256 + h * 64 + dg * 16, 0.125f, kv);
            v4u a, c;
            a.x = pk2(kv[0], kv[1]); a.y = pk2(kv[2], kv[3]); a.z = pk2(kv[4], kv[5]); a.w = pk2(kv[6], kv[7]);
            c.x = pk2(kv[8], kv[9]); c.y = pk2(kv[10], kv[11]); c.z = pk2(kv[12], kv[13]); c.w = pk2(kv[14], kv[15]);
            *(LAS v4u*)(KL + s * MLD + dg * 16) = a; *(LAS v4u*)(KL + s * MLD + dg * 16 + 8) = c; }
          asm volatile("" ::: "memory");
          float vv[16];
          const bf16* zv = Z + (size_t)row * NPAD + ZML + 512 + h * 64 + dg * 16;
          { const v4u w0 = *(const GAS v4u*)zv, w1 = *(const GAS v4u*)(zv + 8); unpack8(w0, vv); unpack8(w1, vv + 8); }
#pragma unroll
          for (int e = 0; e < 16; ++e) VT[(dg * 16 + e) * MLS + s] = (bf16)f2bf(vv[e]); }
#pragma unroll 1
        for (int dir = 0; dir < 2; ++dir) {
            const int chain = dir * 32 + b * 4 + h;
            const int cc = (u < 64) ? (dir ? 1 - j : j) : 2 + (dir ? 31 - j : j);
            __syncthreads();
            const float* cs = CS + ((size_t)chain * 34 + cc) * 4096; const int e = tid_ >> 3, d0 = (tid_ & 7) * 8;
            const f32x4 x0 = *(const GAS f32x4*)(cs + e * 64 + d0), x1 = *(const GAS f32x4*)(cs + e * 64 + d0 + 4);
            const float nsv = ((const GAS float*)NS)[((size_t)chain * 34 + cc) * 64 + (tid_ & 63)];
            ml_gates(F, I, l, dir, h, row0, gb, gi);
            {
              v4u o; o.x = pk2(x0.x, x0.y); o.y = pk2(x0.z, x0.w); o.z = pk2(x1.x, x1.y); o.w = pk2(x1.z, x1.w);
              *(LAS v4u*)(CB + e * MLD + d0) = o;
              if (tid_ < 64) CB[64 * MLD + tid_] = (bf16)f2bf(nsv);
              for (int i = tid_; i < 15 * 64; i += 512) CB[(65 + (i >> 6)) * MLD + (i & 63)] = 0; }
            __syncthreads();
            bf16x8 qa[2];
#pragma unroll
            for (int ks = 0; ks < 2; ++ks) qa[ks] = lds_frag(QL + (16 * w + lr) * MLD + ks * 32 + kg * 8);
            float bt[4], den[4];
#pragma unroll
            for (int r = 0; r < 4; ++r) { const int tq = 16 * w + 4 * kg + r; bt[r] = gb[dir ? 127 - tq : tq]; den[r] = 0.f; }
#pragma unroll 1
            for (int hf = 0; hf < 2; ++hf) {
                f32x4 sacc[4];
#pragma unroll
                for (int tc = 0; tc < 4; ++tc) sacc[tc] = (f32x4){0.f, 0.f, 0.f, 0.f};
#pragma unroll
                for (int tc = 0; tc < 4; ++tc)
#pragma unroll
                    for (int ks = 0; ks < 2; ++ks) sacc[tc] = __builtin_amdgcn_mfma_f32_16x16x32_bf16(qa[ks], lds_frag(KL + (16 * (hf * 4 + tc) + lr) * MLD + ks * 32 + kg * 8), sacc[tc], 0, 0, 0);
#pragma unroll
                for (int tc = 0; tc < 4; ++tc) { const int s = 16 * (hf * 4 + tc) + lr; const int sg = dir ? 127 - s : s; const float bs = gb[sg], is = gi[sg];
#pragma unroll
                    for (int r = 0; r < 4; ++r) { const int t = 16 * w + 4 * kg + r;
                        const float p = (dir ? (s >= t) : (s <= t)) ? sacc[tc][r] * __expf(bt[r] - bs + is) : 0.f;
                        den[r] += p; PL[t * MLS + s] = (bf16)f2bf(p); } }
            }
#pragma unroll
            for (int r = 0; r < 4; ++r) den[r] = row16_sum(den[r]);
            __syncthreads();
            f32x4 nacc[4], iacc[5];
#pragma unroll
            for (int te = 0; te < 4; ++te) nacc[te] = (f32x4){0.f, 0.f, 0.f, 0.f};
#pragma unroll
            for (int te = 0; te < 5; ++te) iacc[te] = (f32x4){0.f, 0.f, 0.f, 0.f};
#pragma unroll
            for (int ks = 0; ks < 4; ++ks) { const bf16x8 pa = lds_frag(PL + (16 * w + lr) * MLS + ks * 32 + kg * 8);
#pragma unroll
                for (int te = 0; te < 4; ++te) nacc[te] = __builtin_amdgcn_mfma_f32_16x16x32_bf16(pa, lds_frag(VT + (16 * te + lr) * MLS + ks * 32 + kg * 8), nacc[te], 0, 0, 0); }
#pragma unroll
            for (int ks = 0; ks < 2; ++ks)
#pragma unroll
                for (int te = 0; te < 5; ++te) iacc[te] = __builtin_amdgcn_mfma_f32_16x16x32_bf16(qa[ks], lds_frag(CB + (16 * te + lr) * MLD + ks * 32 + kg * 8), iacc[te], 0, 0, 0);
#pragma unroll
            for (int r = 0; r < 4; ++r) {
                const float et = __expf(bt[r]);
                const float qn = __shfl(iacc[4][r], lane_ & 48);
                const float dn = den[r] + et * qn;
                const float inv = __builtin_amdgcn_rcpf(fmaxf(fabsf(dn), 1.0f));
                const int tau = 16 * w + 4 * kg + r;
#pragma unroll
                for (int te = 0; te < 4; ++te) { const float hv = (nacc[te][r] + et * iacc[te][r]) * inv; LAS float* hp = HL + tau * 68 + 16 * te + lr;
                    if (dir == 0) *hp = hv; else *hp += hv; }
            }
        }
        __syncthreads();
        { const int tok = tid_ >> 2, q4 = tid_ & 3; const int row = row0 + tok;
          float y[16]; float s = 0.f;
#pragma unroll
          for (int e = 0; e < 16; ++e) { y[e] = HL[tok * 68 + q4 * 16 + e]; s += y[e]; }
          s = quad_sum(s);
          const float mu = s * (1.f / 64.f); float q = 0.f;
#pragma unroll
          for (int e = 0; e < 16; ++e) { y[e] -= mu; q += y[e] * y[e]; }
          q = quad_sum(q);
          const float rstd = __builtin_amdgcn_rsqf(q * (1.f / 64.f) + NORM_EPS);
          const bf16* zo = Z + (size_t)row * NPAD + ZML + 768 + h * 64 + q4 * 16;
          float og[16]; { const v4u w0 = *(const GAS v4u*)zo, w1 = *(const GAS v4u*)(zo + 8); unpack8(w0, og); unpack8(w1, og + 8); }
          int l2_ = l; asm volatile("" : "+s"(l2_));
          const float* ng = I.ml_norm_g + l2_ * 256 + h * 64 + q4 * 16;
          float o[16];
#pragma unroll
          for (int e = 0; e < 16; ++e) o[e] = sigmoidf_(og[e]) * (y[e] * rstd * ng[e]);
          v4u a, c;
          a.x = pk2(o[0], o[1]); a.y = pk2(o[2], o[3]); a.z = pk2(o[4], o[5]); a.w = pk2(o[6], o[7]);
          c.x = pk2(o[8], o[9]); c.y = pk2(o[10], o[11]); c.z = pk2(o[12], o[13]); c.w = pk2(o[14], o[15]);
          bf16* mp = MIX + (size_t)row * D + 768 + h * 64 + q4 * 16;
          *(GAS v4u*)mp = a; *(GAS v4u*)(mp + 8) = c; }
    }
    __syncthreads();
}

__device__ __forceinline__ void build_wm(Frame& F, const Inputs& I, int l) {
    const float* mod = (const float*)(F.ws + WS_MOD); float* WM = (float*)(F.ws + WS_WM);
    bf16* WMh = (bf16*)(F.ws + WS_WM + WMB_HI); bf16* WMl = (bf16*)(F.ws + WS_WM + WMB_LO);
    const float* we = I.router_we + (size_t)l * D * 32; const float* wg = I.router_wg + (size_t)l * D * 4;
    for (int i = F.gw * 64 + F.lane; i < 9 * 48 * 1024; i += F.NGW * 64) {
        const int k = i & 1023, n = (i >> 10) % 48, s = i / (48 * 1024);
        const float G = I.norm2_g[l * D + k] * (1.0f + mod[(size_t)(l * 9 + s) * 6144 + 4096 + k]);
        const float w = (n < 32) ? we[k * 32 + n] : ((n < 36) ? wg[k * 4 + (n - 32)] : 0.f);
        const float v = G * w; const unsigned hi = f2bf(v); const float r = v - bf2f((unsigned short)hi);
        WMh[i] = (bf16)hi; WMl[i] = (bf16)f2bf(r);
    }
    for (int p = F.gw; p < 9 * 36; p += F.NGW) {
        const int s = p / 36, n = p % 36; const float* sh = mod + (size_t)(l * 9 + s) * 6144 + 3072;
        float a = 0.f;
        for (int k = F.lane; k < D; k += 64) a += sh[k] * ((n < 32) ? we[k * 32 + n] : wg[k * 4 + (n - 32)]);
        a = wave_sum(a);
        if (F.lane == 0) WM[WM_CB + s * 48 + n] = a + ((n < 32) ? I.router_be[l * 32 + n] : I.router_bg[l * 4 + (n - 32)]);
    }
}
template <bool DRY, bool KONLY = false>
__device__ __forceinline__ void p7_route(Frame& F, const Inputs& I, int l, int row_lo) {
    const bf16* xs = (const bf16*)(F.ws + WS_XS); const float* WM = (const float*)(F.ws + WS_WM);
    const bf16* WMh = (const bf16*)(F.ws + WS_WM + WMB_HI); const bf16* WMl = (const bf16*)(F.ws + WS_WM + WMB_LO);
    int* route = (int*)(F.ws + WS_ROUTE);
    unsigned* cnt = (unsigned*)(F.ctl + CW_CNT + 64 * l);
    LAS float* XL = (LAS float*)(F.lds + F.wave * 16640);
    LAS float* LG = XL;
    LAS float* rs = LG + 16 * 49;
    LAS unsigned* lc = (LAS unsigned*)(F.lds + 133120);
    LAS unsigned* gbase = lc + 32;
    const int L = F.lane, lr = L & 15, kg = L >> 4;
    const int nunits = (NT - row_lo) / 16; const int nfull = (nunits >= 8 * F.G) ? 8 * F.G : 0;
    const int nextra = nunits - nfull;
    int nxr = 0; for (int r_ = nextra; r_ > 0; r_ -= 8 * F.G) ++nxr;
    const int niter = 1 + ((nextra > 0) ? ((nextra <= F.G) ? 1 : nxr) : 0);
    for (int it = 0; it < niter; ++it) {
        if (F.tid < 32) lc[F.tid] = 0u;
        __syncthreads();
        const bool shared_it = (it > 0) && (nextra <= F.G);
        int u; bool have;
        if (it == 0) { u = F.vcu * 8 + F.wave; have = u < nfull; }
        else if (shared_it) { u = nfull + F.vcu; have = F.vcu < nextra; }
        else { u = nfull + ((it - 1) * F.G + F.vcu) * 8 + F.wave; have = u < nunits; }
        if (!have) u = 0;
        const int row0 = row_lo + u * 16; const int s = row_seq(row0);
        const int hs0 = shared_it ? F.wave : 0, nhs = shared_it ? 1 : 8;
        const bf16* xrow = xs + (size_t)(row0 + (L >> 4)) * D + 8 * (L & 15);
        const bf16* bh = WMh + ((size_t)s * 48 + lr) * 1024 + 8 * kg; const bf16* bl = WMl + ((size_t)s * 48 + lr) * 1024 + 8 * kg;
        f32x4 acc[3] = {(f32x4){0.f, 0.f, 0.f, 0.f}, (f32x4){0.f, 0.f, 0.f, 0.f}, (f32x4){0.f, 0.f, 0.f, 0.f}};
        float ssq = 0.f;
        v4u pre[4];
#pragma unroll
        for (int jj = 0; jj < 4; ++jj) pre[jj] = *(const GAS v4u*)(xrow + (size_t)(4 * jj) * D + hs0 * 128);
#define ROUTE_KSTEP(FBH, FBL) do {                                                                                                                            \
                const f32x4 a0 = *(const LAS f32x4*)(XL + lr * 132 + ks * 32 + 8 * kg), a1 = *(const LAS f32x4*)(XL + lr * 132 + ks * 32 + 8 * kg + 4);                  \
                ssq += (a0.x * a0.x + a0.y * a0.y) + (a0.z * a0.z + a0.w * a0.w) + (a1.x * a1.x + a1.y * a1.y) + (a1.z * a1.z + a1.w * a1.w);                          \
                const float xv[8] = {a0.x, a0.y, a0.z, a0.w, a1.x, a1.y, a1.z, a1.w};                                                                                    \
                unsigned hh[4], ll[4];                                                                                                                                    \
                _Pragma("unroll") for (int q = 0; q < 4; ++q) hh[q] = (__builtin_bit_cast(unsigned, xv[2 * q]) >> 16) | (__builtin_bit_cast(unsigned, xv[2 * q + 1]) & 0xffff0000u);   \
                (void)ll; const v4u hv = {hh[0], hh[1], hh[2], hh[3]};                         \
                const bf16x8 fah = __builtin_bit_cast(bf16x8, hv);                                                                                                        \
                _Pragma("unroll") for (int nt = 0; nt < 3; ++nt) {                                                                                                        \
                    acc[nt] = __builtin_amdgcn_mfma_f32_16x16x32_bf16(fah, FBH[nt], acc[nt], 0, 0, 0);                                                                    \
                    acc[nt] = __builtin_amdgcn_mfma_f32_16x16x32_bf16(fah, FBL[nt], acc[nt], 0, 0, 0); } } while (0)
        if (!shared_it) {
            LAS unsigned char* Bb = F.lds + 8448;
            const int uw = (it == 0) ? F.vcu * 8 : nfull + ((it - 1) * F.G + F.vcu) * 8;
            const int sB = row_seq(row_lo + ((uw < nunits) ? uw : 0) * 16);
            const bf16* gsrc[3]; int ldst[3]; v4u bc[3];
#pragma unroll
            for (int q = 0; q < 3; ++q) { const int c = F.tid + 512 * q, wh = (c >= 768) ? 1 : 0, cc = c - 768 * wh, n = cc >> 4, kc = cc & 15;
                gsrc[q] = (wh ? WMl : WMh) + ((size_t)sB * 48 + n) * 1024 + kc * 8; const int R = wh * 48 + n; ldst[q] = (R >> 4) * 16640 + (R & 15) * 272 + kc * 16;
                bc[q] = *(const GAS v4u*)(gsrc[q]); }
            const int fro = lr * 272 + kg * 16;
#pragma unroll 1
            for (int hq = 0; hq < 8; ++hq) {
                asm volatile("s_waitcnt lgkmcnt(0)\n\ts_barrier" ::: "memory");
#pragma unroll
                for (int q = 0; q < 3; ++q) *(LAS v4u*)(Bb + ldst[q]) = bc[q];
#pragma unroll
                for (int jj = 0; jj < 4; ++jj) { float f_[8]; unpack8(pre[jj], f_); LAS float* dst_ = XL + (4 * jj + (L >> 4)) * 132 + 8 * (L & 15);
                    *(LAS f32x4*)dst_ = (f32x4){f_[0], f_[1], f_[2], f_[3]}; *(LAS f32x4*)(dst_ + 4) = (f32x4){f_[4], f_[5], f_[6], f_[7]}; }
                if (hq + 1 < 8) {
#pragma unroll
                    for (int q = 0; q < 3; ++q) bc[q] = *(const GAS v4u*)(gsrc[q] + (hq + 1) * 128);
#pragma unroll
                    for (int jj = 0; jj < 4; ++jj) pre[jj] = *(const GAS v4u*)(xrow + (size_t)(4 * jj) * D + (hq + 1) * 128); }
                asm volatile("s_waitcnt lgkmcnt(0)\n\ts_barrier" ::: "memory");
#pragma unroll
                for (int ks = 0; ks < 4; ++ks) {
                    bf16x8 fbh[3], fbl[3];
#pragma unroll
                    for (int nt = 0; nt < 3; ++nt) { fbh[nt] = *(const LAS bf16x8*)(Bb + fro + nt * 16640 + ks * 64); fbl[nt] = *(const LAS bf16x8*)(Bb + fro + (3 + nt) * 16640 + ks * 64); }
                    ROUTE_KSTEP(fbh, fbl);
                }
            }
            WAVE_LDS_SYNC();
        } else {
#pragma unroll 1
        for (int hq = 0; hq < nhs; ++hq) {
            const int hs = hs0 + hq;
#pragma unroll
            for (int jj = 0; jj < 4; ++jj) { float f_[8]; unpack8(pre[jj], f_); LAS float* dst_ = XL + (4 * jj + (L >> 4)) * 132 + 8 * (L & 15);
                    *(LAS f32x4*)dst_ = (f32x4){f_[0], f_[1], f_[2], f_[3]}; *(LAS f32x4*)(dst_ + 4) = (f32x4){f_[4], f_[5], f_[6], f_[7]}; }
            if (hq + 1 < nhs) {
#pragma unroll
                for (int jj = 0; jj < 4; ++jj) pre[jj] = *(const GAS v4u*)(xrow + (size_t)(4 * jj) * D + (hs + 1) * 128); }
            WAVE_LDS_SYNC();
#pragma unroll
            for (int ks = 0; ks < 4; ++ks) {
                const int kk = hs * 128 + ks * 32;
                bf16x8 fbh[3], fbl[3];
#pragma unroll
                for (int nt = 0; nt < 3; ++nt) { fbh[nt] = *(const GAS bf16x8*)(bh + (size_t)nt * 16 * 1024 + kk); fbl[nt] = *(const GAS bf16x8*)(bl + (size_t)nt * 16 * 1024 + kk); }
                ROUTE_KSTEP(fbh, fbl);
            }
            WAVE_LDS_SYNC();
        }
        }
#undef ROUTE_KSTEP
        if (shared_it) {
            LAS float* PA = (LAS float*)(F.lds + F.wave * 16640);
#pragma unroll
            for (int nt = 0; nt < 3; ++nt)
#pragma unroll
                for (int r = 0; r < 4; ++r) PA[(nt * 4 + r) * 64 + L] = acc[nt][r];
            PA[12 * 64 + L] = ssq;
            __syncthreads();
            if (F.wave == 0) {
#pragma unroll 1
                for (int w2 = 1; w2 < 8; ++w2) { const LAS float* PB = (const LAS float*)(F.lds + w2 * 16640);
#pragma unroll
                    for (int nt = 0; nt < 3; ++nt)
#pragma unroll
                        for (int r = 0; r < 4; ++r) acc[nt][r] += PB[(nt * 4 + r) * 64 + L];
                    ssq += PB[12 * 64 + L]; } }
            __syncthreads();
            have = have && (F.wave == 0);
        }
        ssq += __shfl_xor(ssq, 16); ssq += __shfl_xor(ssq, 32);
        const float rstd = __builtin_amdgcn_rsqf(ssq * (1.f / D) + NORM_EPS);
        if (KONLY) { if (L == 0 && have) ((float*)(route + (size_t)NT * 8))[u & 1023] = acc[0][0] + acc[1][1] + acc[2][2] + rstd; }
        if (kg == 0) rs[lr] = rstd;
        WAVE_LDS_SYNC();
#pragma unroll
        for (int nt = 0; nt < 3; ++nt)
#pragma unroll
            for (int r = 0; r < 4; ++r) { const int i = 4 * kg + r; LG[i * 49 + nt * 16 + lr] = rs[i] * acc[nt][r] + WM[WM_CB + s * 48 + nt * 16 + lr]; }
        WAVE_LDS_SYNC();
        int e0 = 0, e1 = 0; unsigned lp0 = 0u, lp1 = 0u; float w0 = 0.f, w1 = 0.f;
        if (L < 16 && !KONLY && have) {
            const LAS float* lg = LG + L * 49;
            float gl[4];
#pragma unroll
            for (int q = 0; q < 4; ++q) gl[q] = lg[32 + q];
            int gs = 0; float gm = gl[0];
#pragma unroll
            for (int q = 1; q < 4; ++q) { const bool gt = gl[q] > gm; gm = gt ? gl[q] : gm; gs = gt ? q : gs; }
            float gsum = 0.f;
#pragma unroll
            for (int q = 0; q < 4; ++q) gsum += __expf(gl[q] - gm);
            const float gw_ = 1.0f / gsum;
            float el[8];
#pragma unroll
            for (int e = 0; e < 8; ++e) el[e] = lg[gs * 8 + e];
            int i0 = 0; float m0 = el[0];
#pragma unroll
            for (int e = 1; e < 8; ++e) { const bool gt = el[e] > m0; m0 = gt ? el[e] : m0; i0 = gt ? e : i0; }
            int i1 = -1; float m1 = -3.0e38f;
#pragma unroll
            for (int e = 0; e < 8; ++e) { const bool gt = (e != i0) && (el[e] > m1); m1 = gt ? el[e] : m1; i1 = gt ? e : i1; }
            const float p1 = __expf(m1 - m0);
            w0 = gw_ / (1.0f + p1); w1 = gw_ * p1 / (1.0f + p1);
            e0 = gs * 8 + i0; e1 = gs * 8 + i1;
            lp0 = atomicAdd((unsigned*)(lc + e0), 1u); lp1 = atomicAdd((unsigned*)(lc + e1), 1u);
        }
        __syncthreads();
        if (F.tid < 32) { const unsigned c = lc[F.tid]; gbase[F.tid] = (c && !DRY) ? atomicAdd(cnt + F.tid, c) : 0u; }
        __syncthreads();
        if (L < 16 && !KONLY && have) {
            const int row = row0 + L;
            int* rp = DRY ? (route + (size_t)NT * 8 + (size_t)(row & 1023) * 8) : (route + (size_t)row * 8);
            rp[0] = e0; rp[1] = e1; rp[2] = (int)(gbase[e0] + lp0); rp[3] = (int)(gbase[e1] + lp1); rp[4] = __builtin_bit_cast(int, w0); rp[5] = __builtin_bit_cast(int, w1);
            if (!DRY) ((float*)(route + ROUTE_RSTD))[row] = rs[L];
        }
        __syncthreads();
    }
}
__device__ __forceinline__ void p8_scatter(Frame& F, const Inputs& I, int l, int row_lo) {
    const bf16* xs = (const bf16*)(F.ws + WS_XS); const float* mod = (const float*)(F.ws + WS_MOD);
    int* route = (int*)(F.ws + WS_ROUTE); bf16* xsrt = (bf16*)(F.ws + WS_XSORT);
    const unsigned* cnt = (const unsigned*)(F.ctl + CW_CNT + 64 * l);
    int blocks = 0; if (F.lane < 32) blocks = (int)((__hip_atomic_load(cnt + F.lane, RLX_AGENT) + 255u) >> 8);
    int inc = blocks;
#pragma unroll
    for (int o = 1; o < 32; o <<= 1) { const int n = __shfl_up(inc, o); if (F.lane >= o) inc += n; }
    const int padoff = (inc - blocks) * 256;
    const GAS f32x4* ng = (const GAS f32x4*)(I.norm2_g + l * D) + F.lane;
    v2u xa[4], xb[4];
    auto ld = [&](int row, v2u (&x)[4]) { const int r_ = row < NT ? row : NT - 1; const GAS v2u* xr = (const GAS v2u*)(xs + (size_t)r_ * D) + F.lane;
#pragma unroll
        for (int j = 0; j < 4; ++j) x[j] = xr[64 * j]; };
    auto fin = [&](int row, const v2u (&x)[4]) { if (row >= NT) return;
        int* rp = route + (size_t)row * 8;
        const int e0 = rp[0], e1 = rp[1], q0 = rp[2], q1 = rp[3];
        const int d0 = __shfl(padoff, e0) + q0, d1 = __shfl(padoff, e1) + q1;
        const float rstd = ((const float*)(route + ROUTE_RSTD))[row];
        const int s = row_seq(row);
        const GAS f32x4* sh = (const GAS f32x4*)(mod + (size_t)(l * 9 + s) * 6144 + 3072) + F.lane;
        const GAS f32x4* sc = (const GAS f32x4*)(mod + (size_t)(l * 9 + s) * 6144 + 4096) + F.lane;
        GAS v2u* p0 = (GAS v2u*)(xsrt + (size_t)d0 * D) + F.lane; GAS v2u* p1 = (GAS v2u*)(xsrt + (size_t)d1 * D) + F.lane;
#pragma unroll
        for (int j = 0; j < 4; ++j) { const f32x4 xv = {bflo(x[j].x), bfhi(x[j].x), bflo(x[j].y), bfhi(x[j].y)};
            const f32x4 y = (xv * rstd * ng[64 * j]) * (sc[64 * j] + 1.0f) + sh[64 * j];
            v2u w; w.x = pk2(y.x, y.y); w.y = pk2(y.z, y.w); p0[64 * j] = w; p1[64 * j] = w; }
        if (F.lane == 0) { rp[6] = d0; rp[7] = d1; } };
    if (F.G == 256) {
        struct SRow { v2u x[4]; int e0, e1, q0, q1; float rstd; };
        const int rpw = (NT - row_lo) >> 11, r0 = row_lo + F.gw * rpw;
        f32x4 pg[4], ph[4], pc[4]; int cur_s = -1;
        auto lp = [&](int s_) { const GAS f32x4* sh = (const GAS f32x4*)(mod + (size_t)(l * 9 + s_) * 6144 + 3072) + F.lane; const GAS f32x4* sc = (const GAS f32x4*)(mod + (size_t)(l * 9 + s_) * 6144 + 4096) + F.lane;
#pragma unroll
            for (int j = 0; j < 4; ++j) { ph[j] = sh[64 * j]; pc[j] = sc[64 * j]; } };
#pragma unroll
        for (int j = 0; j < 4; ++j) pg[j] = ng[64 * j];
        cur_s = row_seq(r0); lp(cur_s);
        auto ldr = [&](int k, SRow& R) { const int row = r0 + ((k < rpw) ? k : rpw - 1); const GAS v2u* xr = (const GAS v2u*)(xs + (size_t)row * D) + F.lane;
#pragma unroll
            for (int j = 0; j < 4; ++j) R.x[j] = xr[64 * j];
            const GAS int* rp = (const GAS int*)route + (size_t)row * 8; R.e0 = rp[0]; R.e1 = rp[1]; R.q0 = rp[2]; R.q1 = rp[3];
            R.rstd = ((const GAS float*)(route + ROUTE_RSTD))[row]; };
        auto fnr = [&](int k, const SRow& R) { const int row = r0 + k; const int s_ = row_seq(row); if (s_ != cur_s) { cur_s = s_; lp(s_); }
            const int d0 = __shfl(padoff, R.e0) + R.q0, d1 = __shfl(padoff, R.e1) + R.q1;
            GAS v2u* p0 = (GAS v2u*)(xsrt + (size_t)d0 * D) + F.lane; GAS v2u* p1 = (GAS v2u*)(xsrt + (size_t)d1 * D) + F.lane;
#pragma unroll
            for (int j = 0; j < 4; ++j) { const f32x4 xv = {bflo(R.x[j].x), bfhi(R.x[j].x), bflo(R.x[j].y), bfhi(R.x[j].y)};
                const f32x4 y = (xv * R.rstd * pg[j]) * (pc[j] + 1.0f) + ph[j];
                v2u w; w.x = pk2(y.x, y.y); w.y = pk2(y.z, y.w); p0[64 * j] = w; p1[64 * j] = w; }
            if (F.lane == 0) { int* rp = route + (size_t)row * 8; rp[6] = d0; rp[7] = d1; } };
        SRow A, B;
        ldr(0, A);
#pragma unroll 1
        for (int k = 0; k < rpw; k += 2) {
            ldr(k + 1, B); fnr(k, A);
            ldr(k + 2, A); if (k + 1 < rpw) fnr(k + 1, B);
        }
        return;
    }
    ld(row_lo + F.gw, xa);
    for (int row = row_lo + F.gw; row < NT; row += 2 * F.NGW) {
        ld(row + F.NGW, xb); fin(row, xa);
        ld(row + 2 * F.NGW, xa); fin(row + F.NGW, xb);
    }
}
__device__ __forceinline__ void moe_table(Frame& F, int l, volatile LAS int* blkend) {
    const unsigned* cnt = (const unsigned*)(F.ctl + CW_CNT + 64 * l);
    if (F.wave == 0) {
        int blocks = 0; if (F.lane < 32) blocks = (int)((__hip_atomic_load(cnt + F.lane, RLX_AGENT) + 255u) >> 8);
        int inc = blocks;
#pragma unroll
        for (int o = 1; o < 32; o <<= 1) { const int n = __shfl_up(inc, o); if (F.lane >= o) inc += n; }
        if (F.lane < 32) blkend[F.lane] = inc;
    }
    __syncthreads();
}

constexpr int PH_PER_LAYER = 10, PH_FINAL = 1 + DEPTH * PH_PER_LAYER, N_PHASES = PH_FINAL + 1;
constexpr int MOE_TAB_OFF = 131072;
constexpr int N_ATT_X = NB * 4 * 32, N_ATT_C = NB * 4 * 2;

__global__ void __launch_bounds__(NWAVES * 64, 2) mk_fwd(Args args) {
    extern __shared__ __attribute__((aligned(16))) unsigned char lds[];
    Frame F;
    F.lds = (LAS unsigned char*)lds;
    F.MISC = (volatile LAS unsigned*)(F.lds + MISC_OFF);
    F.tid = threadIdx.x; F.lane = F.tid & 63; F.wave = __builtin_amdgcn_readfirstlane(F.tid >> 6);
    F.G = gridDim.x; { const int bx = blockIdx.x; F.vcu = (F.G % 8 == 0) ? (bx % 8) * (F.G / 8) + bx / 8 : bx; }
    F.gw = F.vcu * NWAVES + F.wave; F.NGW = F.G * NWAVES;
    F.ws = args.ws; F.ctl = (gu32*)(args.ws + WS_CTL);
    const float* const volatile* kp_ = (const float* const volatile*)__builtin_amdgcn_kernarg_segment_ptr();
    for (int u = F.tid; u < (LDS_BYTES - LDSCTL_OFF) / 4; u += NWAVES * 64) ((LAS unsigned*)(F.lds + LDSCTL_OFF))[u] = 0u;
    __syncthreads();
    XcdBarrier bar; bar.bar = (unsigned*)(F.ctl + CW_BAR); bar.x = 0; bar.st = nullptr;
    const int lo = args.ph_lo, hi = args.ph_hi;
    const bool fused = (hi - lo) > 1;
    if (fused) bar = xcd_barrier_post((unsigned*)(F.ctl + CW_BAR), F.MISC + 8);
#ifndef PH_ENABLE
#define PH_ENABLE 0xFFFFu
#endif
#ifndef REP_PH
#define REP_PH -1
#endif
#ifndef REP_N
#define REP_N 2
#endif
#define NREP(p) ((p) == (REP_PH) ? (REP_N) : 1)
#define REPEAT(p) _Pragma("unroll") for (int rep_ = 0; rep_ < NREP(p); ++rep_)
#define EN(p) (((PH_ENABLE) >> (p)) & 1)
#define IN(k) (lo <= (k) && (k) < hi)
#define SEAM(k) do { if (IN(k) && IN((k) + 1)) xcd_barrier(bar); } while (0)
    float* mod = (float*)(F.ws + WS_MOD);
    volatile LAS int* blkend = (volatile LAS int*)(F.lds + MOE_TAB_OFF);

#define PHASE_BEGIN() frame_refresh(F); Inputs I; I.x = uni_ptr(kp_[0]); I.c = uni_ptr(kp_[1]); I.ctx = uni_ptr(kp_[2]); I.c_ctx = uni_ptr(kp_[3]); I.ada_w = uni_ptr(kp_[4]); I.ada_b = uni_ptr(kp_[5]); I.norm1_g = uni_ptr(kp_[6]); I.norm2_g = uni_ptr(kp_[7]); I.w_in = uni_ptr(kp_[8]); I.w_out = uni_ptr(kp_[9]); I.da_lambda = uni_ptr(kp_[10]); I.da_subln_g = uni_ptr(kp_[11]); I.rw_shift_mu = uni_ptr(kp_[12]); I.rw_w0 = uni_ptr(kp_[13]); I.rw_w2 = uni_ptr(kp_[14]); I.rw_a0 = uni_ptr(kp_[15]); I.rw_a2 = uni_ptr(kp_[16]); I.rw_g2 = uni_ptr(kp_[17]); I.rw_k_k = uni_ptr(kp_[18]); I.rw_k_a = uni_ptr(kp_[19]); I.rw_r_k = uni_ptr(kp_[20]); I.rw_ln_g = uni_ptr(kp_[21]); I.rw_ln_b = uni_ptr(kp_[22]); I.ml_conv_w = uni_ptr(kp_[23]); I.ml_conv_b = uni_ptr(kp_[24]); I.ml_gate_b = uni_ptr(kp_[25]); I.ml_norm_g = uni_ptr(kp_[26]); I.router_wg = uni_ptr(kp_[27]); I.router_bg = uni_ptr(kp_[28]); I.router_we = uni_ptr(kp_[29]); I.router_be = uni_ptr(kp_[30]); I.exp_w_gu = uni_ptr(kp_[31]); I.exp_w_down = uni_ptr(kp_[32]); I.final_g = uni_ptr(kp_[33]);
    if (EN(10) && IN(0)) { PHASE_BEGIN(); REPEAT(10) p0_prologue(F, I); SEAM(0); }
#pragma unroll 1
    for (int l = 0; l < DEPTH; ++l) {
        const int pb = 1 + l * PH_PER_LAYER;
        const bool last = (l == DEPTH - 1);
        if (EN(0) && IN(pb + 0)) { PHASE_BEGIN(); if (l == 0) p_norm1<0>(F, I, l, args.out); else p_norm1<1>(F, I, l, args.out);
            if (NREP(0) > 1) p_norm1<0>(F, I, l, args.out, NREP(0) - 1);
            build_wm(F, I, l);
            if (fused && NREP(50) > 1) { for (int rb_ = 0; rb_ < 10; ++rb_) xcd_barrier(bar); }
            SEAM(pb + 0); }
        if (EN(1) && IN(pb + 1)) { PHASE_BEGIN();
            pg8::Gemm g{(const bf16*)(F.ws + WS_H1), (const bf16*)(F.ws + WS_WIN) + (size_t)l * NPAD * D, D};
            StaticOrderT<NPAD / 256> S; S.init(NT, NPAD, F.G, F.vcu);
            EpiZ E{(bf16*)(F.ws + WS_Z), NPAD, F.ws};
            REPEAT(1) pg8::gemm_phase<EpiZ, StaticOrderT<NPAD / 256>>(F.lds, g, S, E);
            SEAM(pb + 1);
        }
        if (EN(2) && IN(pb + 2)) { PHASE_BEGIN(); rwkv_chunk_pre(F, I, l, NREP(21)); REPEAT(22) p3_mlstate(F, I, l);
            asm volatile("s_waitcnt vmcnt(0)" ::: "memory"); __syncthreads();
            if (F.tid == 0) { __builtin_amdgcn_fence(__ATOMIC_RELEASE, "agent"); asm volatile("s_waitcnt vmcnt(0)" ::: "memory");
                __hip_atomic_fetch_add((unsigned*)(F.ctl + CW_PREP + 64 * l), 1u, RLX_AGENT); }
        }
        if (EN(3) && IN(pb + 3)) { PHASE_BEGIN();
            if (F.vcu < 128) {
                if (F.tid == 0) { unsigned* p = (unsigned*)(F.ctl + CW_PREP + 64 * l); unsigned sp = 0;
                    while (__hip_atomic_load(p, RLX_AGENT) < (unsigned)F.G) { __builtin_amdgcn_s_sleep(2);
                        if (++sp > (1u << 22)) { atomicAdd((unsigned*)(F.ctl + CW_BAR) + XB_TMO, 1u); break; } }
                    __builtin_amdgcn_fence(__ATOMIC_ACQUIRE, "agent"); asm volatile("s_waitcnt vmcnt(0)" ::: "memory"); }
                __syncthreads();
            }
            for (int ch = F.vcu; ch < 64; ch += F.G) { if (last) rwkv_seq<false>(F, ch, I.exp_w_gu, I.exp_w_down, 0); else rwkv_seq<true>(F, ch, I.exp_w_gu, I.exp_w_down, l + 1); publish_done(F, CW_FLAG + (l * 128 + ch) * 64); }
            for (int ch = F.vcu; ch < 128; ch += F.G) if (ch >= 64) { ml_prefix(F, ch - 64); publish_done(F, CW_FLAG + (l * 128 + ch) * 64); }
            const int n_att = last ? N_ATT_X : N_ATT_X + N_ATT_C;
            constexpr int N_CONV = 384; const int n_conv = 0;
            REPEAT(32)
            for (;;) {
                __syncthreads();
                if (F.tid == 0) F.MISC[0] = __hip_atomic_fetch_add((unsigned*)(F.ctl + CW_QUEUE + 64 * l + 8 * rep_), 1u, RLX_AGENT);
                __syncthreads();
                int u = __builtin_amdgcn_readfirstlane((int)F.MISC[0]);
                if (u >= n_att + n_conv) break;
                if (n_conv) {
                    const int j = u / 3;
                    if (u - 3 * j == 2 && j < N_CONV) { conv_unit(F, I, l + 1, j); continue; }
                    const int nc = (u + 1) / 3; u -= (nc < N_CONV) ? nc : N_CONV;
                }
                const bf16 *Qp, *Kp, *Vp; bf16* Op; int seq; size_t qstr;
                if (u < N_ATT_X) { const int b = u >> 7, h = (u >> 5) & 3, qb = u & 31;
                    Qp = (const bf16*)(F.ws + WS_QB) + ((size_t)(b * 8 + h * 2) * T + qb * 128) * 64; qstr = (size_t)T * 64;
                    Kp = (const bf16*)(F.ws + WS_KB) + (size_t)(b * 8 + h * 2) * TK * 64;
                    Vp = (const bf16*)(F.ws + WS_VB) + (size_t)(b * 4 + h) * TK * 128;
                    Op = (bf16*)(F.ws + WS_MIX) + (size_t)(NCX + b * T + qb * 128) * 1024 + h * 128; seq = TK; }
                else { const int u2 = u - N_ATT_X, b = u2 >> 3, h = (u2 >> 1) & 3, qb = u2 & 1;
                    Qp = (const bf16*)(F.ws + WS_QC) + ((size_t)(b * 8 + h * 2) * TC + qb * 128) * 64; qstr = (size_t)TC * 64;
                    Kp = (const bf16*)(F.ws + WS_KB) + (size_t)(b * 8 + h * 2) * TK * 64;
                    Vp = (const bf16*)(F.ws + WS_VB) + (size_t)(b * 4 + h) * TK * 128;
                    Op = (bf16*)(F.ws + WS_MIX) + (size_t)(b * TC + qb * 128) * 1024 + h * 128; seq = TC; }
                att::attn_unit2(Qp, Kp, Vp, Op, seq, qstr, (size_t)TK * 64, mod[MOD_LAM + l], 1.0f - (0.8f - 0.6f * __expf(-0.3f * (float)l)), I.da_subln_g + l * 128, (LAS char*)F.lds);
            }
            { PHASE_BEGIN();
            wait_all_done(F, CW_FLAG + l * 128 * 64);
            { const int u_lo = last ? 64 : 0, n_ml = 1088 - u_lo;
              for (;;) {
                __syncthreads();
                if (F.tid == 0) F.MISC[0] = __hip_atomic_fetch_add((unsigned*)(F.ctl + CW_QUEUE + 64 * l + 16), 1u, RLX_AGENT);
                __syncthreads();
                const int u = (int)F.MISC[0];
                if (u >= n_ml) break;
                p5_mlout(F, I, l, u_lo + u);
              } }
            { const int r_lo = last ? NCX : 0, n_rw = (NT - r_lo) / 128;
              for (;;) {
                __syncthreads();
                if (F.tid == 0) F.MISC[0] = __hip_atomic_fetch_add((unsigned*)(F.ctl + CW_QUEUE + 64 * l + 32), 1u, RLX_AGENT);
                __syncthreads();
                const int u = (int)F.MISC[0];
                if (u >= n_rw) break;
                const int rb = r_lo + u * 128 + F.wave * 16;
                p5_rwkv(F, I, l, rb, rb + 16, 1);
              } }
            }
            SEAM(pb + 3);
        }
        if (EN(5) && IN(pb + 5)) { PHASE_BEGIN();
            pg8::Gemm g{(const bf16*)(F.ws + WS_MIX), (const bf16*)(F.ws + WS_WOUT) + (size_t)l * D * D, D};
            StaticOrderT<D / 256> S; if (last) S.init(NXR, D, F.G, F.vcu, NCX / 256); else S.init(NT, D, F.G, F.vcu);
            EpiResid E{(bf16*)(F.ws + WS_XS), mod + (size_t)l * 9 * 6144 + 2048, (l == 0) ? I.ctx : nullptr, (l == 0) ? I.x : nullptr};
            pg8::gemm_phase<EpiResid, StaticOrderT<D / 256>>(F.lds, g, S, E);
            REPEAT(5) { if (rep_ > 0) { EpiF32 E2{(float*)(F.ws + WS_YS)}; pg8::gemm_phase<EpiF32, StaticOrderT<D / 256>>(F.lds, g, S, E2); } }
            SEAM(pb + 5);
        }
        if (EN(6) && IN(pb + 6)) { PHASE_BEGIN(); p7_route<false>(F, I, l, last ? NCX : 0); REPEAT(6) { if (rep_ > 0) p7_route<true>(F, I, l, 0); } REPEAT(61) { if (rep_ > 0) p7_route<true, true>(F, I, l, 0); } SEAM(pb + 6); }
        if (EN(7) && IN(pb + 7)) { PHASE_BEGIN(); REPEAT(7) p8_scatter(F, I, l, last ? NCX : 0); SEAM(pb + 7); }
        if (EN(8) && IN(pb + 8)) { PHASE_BEGIN();
            moe_table(F, l, blkend);
            pg8::Gemm g{(const bf16*)(F.ws + WS_XSORT), (const bf16*)(F.ws + WS_WGU) + (size_t)l * NEXP * 1024 * D, D};
            MoeOrder S{blkend, F.G, F.vcu, (size_t)1024 * D * 2};
            EpiSwiGLU E{(bf16*)(F.ws + WS_ACT)};
            REPEAT(8) pg8::gemm_phase<EpiSwiGLU, MoeOrder>(F.lds, g, S, E);
            SEAM(pb + 8);
        }
        if (EN(9) && IN(pb + 9)) { PHASE_BEGIN();
            moe_table(F, l, blkend);
            pg8::Gemm g{(const bf16*)(F.ws + WS_ACT), (const bf16*)(F.ws + WS_WDN) + (size_t)l * NEXP * D * EH, EH};
            MoeOrder S{blkend, F.G, F.vcu, (size_t)D * EH * 2};
            EpiY16 E{(bf16*)(F.ws + WS_YS)};
            REPEAT(9) pg8::gemm_phase<EpiY16, MoeOrder>(F.lds, g, S, E);
            SEAM(pb + 9);
        }
    }
    if (EN(11) && IN(PH_FINAL)) { PHASE_BEGIN(); p_norm1<2>(F, I, DEPTH, args.out); }
#undef IN
#undef SEAM
}

extern "C" void kernel_launch(void* const* d_in, const int* in_sizes, int n_in, void* d_out, int out_size, void* d_ws, size_t ws_size, hipStream_t stream) {
    static int grid = 0;
    if (grid == 0) {
        if (n_in != 34 || in_sizes[0] != NXR * D || out_size != NXR * D || ws_size < WS_END) {
            fprintf(stderr, "kernel_launch: unexpected shapes: n_in %d in0 %d out %d ws %zu (need %zu)\n", n_in, n_in > 0 ? in_sizes[0] : -1, out_size, ws_size, (size_t)WS_END); grid = -1; return; }
        int dev = 0, cus = 0, per_cu = 0;
        if (hipGetDevice(&dev) != hipSuccess || hipDeviceGetAttribute(&cus, hipDeviceAttributeMultiprocessorCount, dev) != hipSuccess) { grid = -1; return; }
        if (hipFuncSetAttribute((const void*)mk_fwd, hipFuncAttributeMaxDynamicSharedMemorySize, LDS_BYTES) != hipSuccess) { fprintf(stderr, "kernel_launch: hipFuncSetAttribute failed\n"); grid = -1; return; }
        if (hipOccupancyMaxActiveBlocksPerMultiprocessor(&per_cu, (const void*)mk_fwd, NWAVES * 64, LDS_BYTES) != hipSuccess || per_cu < 1)
            fprintf(stderr, "kernel_launch: occupancy query reports %d blocks per CU\n", per_cu);
        (void)hipGetLastError();
        grid = cus;
    }
    if (grid < 0) return;
    if (hipMemsetAsync((char*)d_ws + WS_CTL, 0, CTL_ZERO_BYTES, stream) != hipSuccess) return;
    Args a{};
    const float** ip = (const float**)&a.in;
    for (int i = 0; i < 34; ++i) ip[i] = (const float*)d_in[i];
    a.out = (float*)d_out; a.ws = (unsigned char*)d_ws;
#if MK_N_LAUNCHES == 1
    a.ph_lo = 0; a.ph_hi = N_PHASES;
    hipLaunchKernelGGL(mk_fwd, dim3(grid), dim3(NWAVES * 64), LDS_BYTES, stream, a);
#else
    for (int p = 0; p < N_PHASES; ++p) { a.ph_lo = p; a.ph_hi = p + 1;
        hipLaunchKernelGGL(mk_fwd, dim3(grid), dim3(NWAVES * 64), LDS_BYTES, stream, a); }
#endif
    const hipError_t le = hipPeekAtLastError();
    if (le != hipSuccess) fprintf(stderr, "kernel_launch: launch failed: %s\n", hipGetErrorName(le));
}
```
